# Optimizing an MI355X kernel written in HIP

```python
import jax
import jax.numpy as jnp
from jax import lax
import numpy as np

D_MODEL = 1024
BATCH = 4
SEQ = 4096
DEPTH = 4

GRID_W = 64
CTX_LEN = 256
HEAD_DIM = 64
ATTN_HEADS = 8
ATTN_KV_HEADS = 2
ATTN_GROUP = ATTN_HEADS // ATTN_KV_HEADS
ATTN_W = ATTN_HEADS * HEAD_DIM
ATTN_KV_W = ATTN_KV_HEADS * HEAD_DIM
RWKV_HEADS = 4
RWKV_W = RWKV_HEADS * HEAD_DIM
DECAY_RANK = 64
ICLR_RANK = 64
GATE_RANK = 128
CONV_GROUPS = 4
CONV_W = CONV_GROUPS * 64
MIX_W = ATTN_W + RWKV_W + CONV_W
ATTN_IN = ATTN_W + 2 * ATTN_KV_W
RWKV_IN = 3 * RWKV_W + 2 * DECAY_RANK + 2 * ICLR_RANK + GATE_RANK
CONV_IN = 3 * CONV_W
N_IN = ATTN_IN + RWKV_IN + CONV_IN
RWKV_SPLITS = (RWKV_W, 2 * RWKV_W, 3 * RWKV_W, 3 * RWKV_W + 2 * DECAY_RANK, 3 * RWKV_W + 2 * DECAY_RANK + 2 * ICLR_RANK)
D_FF = 2816
Q_BLOCK = 128
ROPE_THETA = 10000.0
ROPE_AXIS_PAIRS = HEAD_DIM // 4
DECAY_SCALE = 0.606531
NORM_EPS = 1e-6
GN_EPS = 64e-5
N_MOD = 6

kernel_name = 'hybrid_diffusion_trunk'


def rmsnorm(x, g):
    xf = x.astype(jnp.float32)
    y = xf * lax.rsqrt(jnp.mean(xf * xf, axis=-1, keepdims=True) + NORM_EPS)
    return (y * g.astype(jnp.float32)).astype(x.dtype)


def modulate(h, shift, scale):
    return h * (1 + scale[:, None, :]) + shift[:, None, :]


def neighbours(z):
    zp = jnp.pad(z, ((0, 0), (1, 1), (0, 0)))
    return zp[:, :-2], zp[:, 2:]


def dwconv3(z, w):
    prev, nxt = neighbours(z)
    return prev * w[0] + z * w[1] + nxt * w[2]


def token_shift(z, mu):
    prev, nxt = neighbours(z)
    return z + mu[0] * (prev - z) + mu[1] * (nxt - z)


def axial_angles(T):
    rows = T // GRID_W
    row = jnp.broadcast_to(jnp.arange(rows)[:, None], (rows, GRID_W)).reshape(-1).astype(jnp.float32)
    col = jnp.broadcast_to(jnp.arange(GRID_W)[None, :], (rows, GRID_W)).reshape(-1).astype(jnp.float32)
    inv = ROPE_THETA ** (-jnp.arange(ROPE_AXIS_PAIRS, dtype=jnp.float32) / ROPE_AXIS_PAIRS)
    ang = jnp.concatenate([row[:, None] * inv, col[:, None] * inv], axis=-1)
    return jnp.cos(ang), jnp.sin(ang)


def rope_2d(x, cos, sin):
    xf = x.astype(jnp.float32)
    half = HEAD_DIM // 2
    x1, x2 = xf[..., :half], xf[..., half:]
    cs, sn = cos[None, :, None, :], sin[None, :, None, :]
    return jnp.concatenate([x1 * cs - x2 * sn, x2 * cs + x1 * sn], axis=-1).astype(x.dtype)


def attn_heads(z, q_norm, k_norm):
    B, T, _ = z.shape
    q, k, v = jnp.split(z, [ATTN_W, ATTN_W + ATTN_KV_W], axis=-1)
    q = rmsnorm(q.reshape(B, T, ATTN_HEADS, HEAD_DIM), q_norm)
    k = rmsnorm(k.reshape(B, T, ATTN_KV_HEADS, HEAD_DIM), k_norm)
    v = v.reshape(B, T, ATTN_KV_HEADS, HEAD_DIM)
    return q, k, v


def gqa(q, k, v):
    B, Tq = q.shape[:2]
    qg = q.reshape(B, Tq, ATTN_KV_HEADS, ATTN_GROUP, HEAD_DIM)
    s = jnp.einsum('bqkgd,bskd->bkgqs', qg, k).astype(jnp.float32) * (HEAD_DIM ** -0.5)
    p = jax.nn.softmax(s, axis=-1).astype(v.dtype)
    o = jnp.einsum('bkgqs,bskd->bqkgd', p, v)
    return o.reshape(B, Tq, ATTN_W)


def gqa_blocked(q, k, v):
    B, T = q.shape[:2]
    nb = T // Q_BLOCK
    qb = q.reshape(B, nb, Q_BLOCK, ATTN_HEADS, HEAD_DIM).swapaxes(0, 1)
    o = lax.map(lambda qi: gqa(qi, k, v), qb)
    return o.swapaxes(0, 1).reshape(B, T, ATTN_W)


def rwkv_heads(z):
    return z.reshape(*z.shape[:-1], RWKV_HEADS, HEAD_DIM)


def rwkv_inputs(z, mu, w0, w_up, a0, a_up, g_up, k_k, k_a):
    B, T, _ = z.shape
    z = token_shift(z, mu).astype(jnp.float32)
    r, k, v, wd, ad, gd = jnp.split(z, list(RWKV_SPLITS), axis=-1)
    wd = wd.reshape(B, T, 2, DECAY_RANK)
    ad = ad.reshape(B, T, 2, ICLR_RANK)
    w = jnp.exp(-DECAY_SCALE * jax.nn.sigmoid(w0[:, None, None, :] + jnp.einsum('btdr,drc->dbtc', jnp.tanh(wd), w_up)))
    a = jax.nn.sigmoid(a0[:, None, None, :] + jnp.einsum('btdr,drc->dbtc', ad, a_up))
    g = jax.nn.sigmoid(gd) @ g_up
    kk = rwkv_heads(k * k_k)
    kk = kk * lax.rsqrt(jnp.maximum(jnp.sum(kk * kk, axis=-1, keepdims=True), 1e-12))
    k_eff = k[None] * (1 + (a - 1) * k_a)
    kka = kk[None] * rwkv_heads(a)
    return (rwkv_heads(r), rwkv_heads(w), rwkv_heads(k_eff), rwkv_heads(v), kk, kka, g)


def dir_stack(x):
    x = jnp.stack([x[0], jnp.flip(x[1], axis=1)])
    return jnp.moveaxis(x, 2, 0)


def shared_stack(x):
    return dir_stack(jnp.stack([x, x]))


def dir_merge(y):
    y = jnp.moveaxis(y, 0, 2)
    return y[0] + jnp.flip(y[1], axis=1)


def scan_pack(r, w, k, v, kk, kka):
    return (shared_stack(r), dir_stack(w), dir_stack(k), shared_stack(v), shared_stack(kk), dir_stack(kka))


def rwkv_scan(s0, r, w, k, v, kk, kka):
    def step(S, inp):
        r_t, w_t, k_t, v_t, kk_t, kka_t = inp
        S = (S * w_t[..., None, :]
             - jnp.einsum('...vk,...k->...v', S, kk_t)[..., :, None] * kka_t[..., None, :]
             + v_t[..., :, None] * k_t[..., None, :])
        return S, jnp.einsum('...vk,...k->...v', S, r_t)
    return lax.scan(step, s0, (r, w, k, v, kk, kka))


def rwkv_output(y, r, k_eff, v, g, r_k, lnx_w, lnx_b):
    B, T = y.shape[:2]
    mean = jnp.mean(y, axis=-1, keepdims=True)
    var = jnp.mean(jnp.square(y - mean), axis=-1, keepdims=True)
    yn = ((y - mean) * lax.rsqrt(var + GN_EPS)).reshape(B, T, RWKV_W) * lnx_w + lnx_b
    bonus = (jnp.sum(r[None] * k_eff * r_k, axis=-1, keepdims=True).sum(0) * v).reshape(B, T, RWKV_W)
    return (yn + bonus) * g


def short_conv(z, w):
    bg, cg, xc = jnp.split(z, 3, axis=-1)
    return bg * dwconv3(cg * xc, w)


def conv_ffn(h, w_up, w_conv, w_down):
    u = dwconv3(h @ w_up, w_conv)
    ga, up = jnp.split(u, 2, axis=-1)
    return (jax.nn.silu(ga) * up) @ w_down


def setup_inputs(seed: int = 0) -> dict:
    key = jax.random.key(seed)
    ks = jax.random.split(key, 32)
    L, D = DEPTH, D_MODEL
    f32 = jnp.float32

    def nrm(k, shape, scale):
        return jax.random.normal(k, shape, f32) * scale

    def gain(k, shape):
        return 1.0 + 0.05 * jax.random.normal(k, shape, f32)

    return {
        'x': nrm(ks[0], (BATCH, SEQ, D), 1.0),
        'c': nrm(ks[1], (BATCH, D), 1.0),
        'ctx': nrm(ks[2], (BATCH, CTX_LEN, D), 1.0),
        'c_ctx': nrm(ks[3], (D,), 1.0),
        'ada_w': nrm(ks[4], (L, D, N_MOD * D), 0.5 * D ** -0.5),
        'ada_b': nrm(ks[5], (L, N_MOD * D), 0.01),
        'norm_mix_pre': gain(ks[6], (L, D)),
        'norm_mix_post': gain(ks[7], (L, D)),
        'norm_ffn_pre': gain(ks[8], (L, D)),
        'norm_ffn_post': gain(ks[9], (L, D)),
        'w_in': nrm(ks[10], (L, D, N_IN), D ** -0.5),
        'w_out': nrm(ks[11], (L, MIX_W, D), MIX_W ** -0.5),
        'q_norm': gain(ks[12], (L, HEAD_DIM)),
        'k_norm': gain(ks[13], (L, HEAD_DIM)),
        'rwkv_mu': jax.random.uniform(ks[14], (L, 2, RWKV_IN), f32, 0.0, 0.5),
        'rwkv_w0': nrm(ks[15], (L, 2, RWKV_W), 1.0),
        'rwkv_w_up': nrm(ks[16], (L, 2, DECAY_RANK, RWKV_W), 0.5 * DECAY_RANK ** -0.5),
        'rwkv_a0': nrm(ks[17], (L, 2, RWKV_W), 0.5),
        'rwkv_a_up': nrm(ks[18], (L, 2, ICLR_RANK, RWKV_W), 0.5 * ICLR_RANK ** -0.5),
        'rwkv_g_up': nrm(ks[19], (L, GATE_RANK, RWKV_W), GATE_RANK ** -0.5),
        'rwkv_k_k': 0.85 + nrm(ks[20], (L, RWKV_W), 0.05),
        'rwkv_k_a': gain(ks[21], (L, RWKV_W)),
        'rwkv_r_k': nrm(ks[22], (L, RWKV_HEADS, HEAD_DIM), 0.1),
        'rwkv_lnx_w': gain(ks[23], (L, RWKV_W)),
        'rwkv_lnx_b': nrm(ks[24], (L, RWKV_W), 0.01),
        'sconv_w': nrm(ks[25], (L, 3, CONV_W), 3 ** -0.5),
        'ffn_up': nrm(ks[26], (L, D, 2 * D_FF), D ** -0.5),
        'ffn_conv': nrm(ks[27], (L, 3, 2 * D_FF), 3 ** -0.5),
        'ffn_down': nrm(ks[28], (L, D_FF, D), D_FF ** -0.5),
    }


def reference(x, c, ctx, c_ctx, ada_w, ada_b, norm_mix_pre, norm_mix_post, norm_ffn_pre, norm_ffn_post,
              w_in, w_out, q_norm, k_norm, rwkv_mu, rwkv_w0, rwkv_w_up, rwkv_a0, rwkv_a_up, rwkv_g_up,
              rwkv_k_k, rwkv_k_a, rwkv_r_k, rwkv_lnx_w, rwkv_lnx_b, sconv_w, ffn_up, ffn_conv, ffn_down):
    B, T, _ = x.shape
    cos, sin = axial_angles(T)
    h_ctx = ctx
    s_zero = jnp.zeros((2, B, RWKV_HEADS, HEAD_DIM, HEAD_DIM), jnp.float32)
    for l in range(DEPTH):
        last = l == DEPTH - 1
        m_lat = jnp.split(jax.nn.silu(c) @ ada_w[l] + ada_b[l], N_MOD, axis=-1)
        m_ctx = jnp.split(jax.nn.silu(c_ctx)[None, :] @ ada_w[l] + ada_b[l], N_MOD, axis=-1)

        u_lat = modulate(rmsnorm(x, norm_mix_pre[l]), m_lat[0], m_lat[1]) @ w_in[l]
        u_ctx = modulate(rmsnorm(h_ctx, norm_mix_pre[l]), m_ctx[0], m_ctx[1]) @ w_in[l]
        at_l, rw_l, cv_l = jnp.split(u_lat, [ATTN_IN, ATTN_IN + RWKV_IN], axis=-1)
        at_c, rw_c, cv_c = jnp.split(u_ctx, [ATTN_IN, ATTN_IN + RWKV_IN], axis=-1)

        q_l, k_l, v_l = attn_heads(at_l, q_norm[l], k_norm[l])
        q_c, k_c, v_c = attn_heads(at_c, q_norm[l], k_norm[l])
        q_l = rope_2d(q_l, cos, sin)
        k_l = rope_2d(k_l, cos, sin)
        att_l = gqa_blocked(q_l, jnp.concatenate([k_c, k_l], axis=1), jnp.concatenate([v_c, v_l], axis=1))

        rw_p = (rwkv_mu[l], rwkv_w0[l], rwkv_w_up[l], rwkv_a0[l], rwkv_a_up[l], rwkv_g_up[l], rwkv_k_k[l], rwkv_k_a[l])
        t_c = rwkv_inputs(rw_c, *rw_p)
        t_l = rwkv_inputs(rw_l, *rw_p)
        s_ctx_final, y_c = rwkv_scan(s_zero, *scan_pack(*t_c[:6]))
        _, y_l = rwkv_scan(s_ctx_final, *scan_pack(*t_l[:6]))
        out_p = (rwkv_r_k[l], rwkv_lnx_w[l], rwkv_lnx_b[l])
        rwo_l = rwkv_output(dir_merge(y_l), t_l[0], t_l[2], t_l[3], t_l[6], *out_p).astype(x.dtype)

        sco_l = short_conv(cv_l, sconv_w[l])

        mix_l = jnp.concatenate([att_l, rwo_l, sco_l], axis=-1) @ w_out[l]
        x = x + m_lat[2][:, None, :] * rmsnorm(mix_l, norm_mix_post[l])
        f_l = conv_ffn(modulate(rmsnorm(x, norm_ffn_pre[l]), m_lat[3], m_lat[4]), ffn_up[l], ffn_conv[l], ffn_down[l])
        x = x + m_lat[5][:, None, :] * rmsnorm(f_l, norm_ffn_post[l])

        if not last:
            att_c = gqa(q_c, k_c, v_c)
            rwo_c = rwkv_output(dir_merge(y_c), t_c[0], t_c[2], t_c[3], t_c[6], *out_p).astype(h_ctx.dtype)
            sco_c = short_conv(cv_c, sconv_w[l])
            mix_c = jnp.concatenate([att_c, rwo_c, sco_c], axis=-1) @ w_out[l]
            h_ctx = h_ctx + m_ctx[2][:, None, :] * rmsnorm(mix_c, norm_mix_post[l])
            f_c = conv_ffn(modulate(rmsnorm(h_ctx, norm_ffn_pre[l]), m_ctx[3], m_ctx[4]), ffn_up[l], ffn_conv[l], ffn_down[l])
            h_ctx = h_ctx + m_ctx[5][:, None, :] * rmsnorm(f_c, norm_ffn_post[l])
    return x
```

```cpp
#include <hip/hip_runtime.h>
#include <hip/hip_bf16.h>
#include <hip/hip_cooperative_groups.h>
#include <cstdio>
#include <cstdint>
#include <math.h>
namespace cg = cooperative_groups;

namespace pg8 {
#define PG8_LAS __attribute__((address_space(3)))
typedef unsigned short bf16_t;
typedef short bf16x8 __attribute__((ext_vector_type(8)));
typedef float f32x4 __attribute__((ext_vector_type(4)));
typedef unsigned u32x4 __attribute__((ext_vector_type(4)));
constexpr int BM = 256, BK = 64, HALF = 128, HTB = HALF * BK * 2  , STAGE_BYTES = 8 * HTB, NXCD = 8, WGM = 8;

__host__ __device__ __forceinline__ int lds_byte(int r, int c) { const int st = (r >> 4) * 2 + (c >> 5), rr = r & 15, cc = c & 31, ob = rr * 64 + cc * 2; return st * 1024 + (ob ^ (((ob >> 9) & 1) << 5)); }
__host__ __device__ __forceinline__ void stage_rc(int b, int& R, int& C) { const int st = b / 1024, sb = b % 1024, swz = sb ^ (((sb >> 9) & 1) << 5); R = (st >> 1) * 16 + swz / 64; C = (st & 1) * 32 + (swz % 64) / 2; }
__host__ __device__ __forceinline__ int perm32(int rho) { const int n = rho >> 4, i = rho & 15; return 8 * (i >> 2) + 4 * n + (i & 3); }

struct Unit { int pm, pn; };
struct Gemm { const bf16_t* A; const bf16_t* Bt; int M, N, K; };

struct StaticOrder {
    int nM, nN, nwg, G, c;
    __host__ __device__ void init(int M, int N, int G_, int c_) { nM = M / BM; nN = N / BM; nwg = nM * nN; G = G_; c = c_; }
    __host__ __device__ bool next(int i, Unit& u) const {
        const long L = (long)i * G + c; if (L >= nwg) return false;
        int wgid = (int)L; { const int q = nwg / NXCD, r = nwg % NXCD, xcd = wgid % NXCD, off = wgid / NXCD; wgid = (xcd < r ? xcd * (q + 1) : r * (q + 1) + (xcd - r) * q) + off; }
        const int nig = WGM * nN, gid = wgid / nig, fm = gid * WGM, gsz = (nM - fm) < WGM ? (nM - fm) : WGM;
        u.pm = fm + ((wgid % nig) % gsz); u.pn = (wgid % nig) / gsz; return true;
    }
    __device__ __forceinline__ void a_ready(const Unit&) const {}
    __device__ __forceinline__ void done(const Unit&) const {}
};

__device__ __forceinline__ unsigned cvt_pk_bf16(float lo, float hi) { unsigned r; asm volatile("v_cvt_pk_bf16_f32 %0, %1, %2" : "=v"(r) : "v"(lo), "v"(hi)); return r; }
typedef float f32x2 __attribute__((ext_vector_type(2)));
__device__ __forceinline__ f32x2 gelu_pk(f32x2 v) {
    const f32x2 av = __builtin_elementwise_abs(v), d = av * 0.2316418882f + 1.0f;
    f32x2 t; t.x = __builtin_amdgcn_rcpf(d.x); t.y = __builtin_amdgcn_rcpf(d.y);
    f32x2 q = t * 0.5307027145f + (-0.7265760135f); q = q * t + 0.7107068705f; q = q * t + (-0.142248368f); q = q * t + 0.127414796f; q = q * t;
    const f32x2 s = (v * v) * (-0.72134752044f);
    f32x2 e; e.x = __builtin_amdgcn_exp2f(s.x); e.y = __builtin_amdgcn_exp2f(s.y);
    const f32x2 m = v * (q * e), r = v - m;
    f32x2 o; o.x = v.x < 0.f ? m.x : r.x; o.y = v.y < 0.f ? m.y : r.y; return o;
}

template <int ACT  > struct EpiBf16 {
    static constexpr bool PERM = true, AFTER_DRAIN = false; static_assert(ACT == 0 || ACT == 1, "EpiBf16: ACT is 0 (none) or 1 (gelu_pk)");
    bf16_t* O; int ldc; const float* bias; int split_cols; size_t split_stride; float scale0;
    __device__ __forceinline__ void operator()(const f32x4 (&acc)[2][2][4][2], const Unit& u, int wr, int wc, int fr, int fq) const {
        const int row0 = u.pm * BM + wr * 64 + fr; int colt = u.pn * BM; bf16_t* base = O;
        float sc = 1.f; if (split_cols) { const int t = colt / split_cols; base += (size_t)t * split_stride; colt -= t * split_cols; if (t == 0) sc = scale0; }
        const int col0 = colt + wc * 32 + 8 * fq, bcol0 = u.pn * BM + wc * 32 + 8 * fq;
        f32x4 bv[2][2];
#pragma unroll
        for (int bj = 0; bj < 2; ++bj)
#pragma unroll
            for (int n = 0; n < 2; ++n) bv[bj][n] = bias ? *(const f32x4*)(bias + bcol0 + bj * HALF + 4 * n) : (f32x4){0.f, 0.f, 0.f, 0.f};
#pragma unroll
        for (int ai = 0; ai < 2; ++ai)
#pragma unroll
            for (int m = 0; m < 4; ++m) { bf16_t* rowp = base + (size_t)(row0 + ai * HALF + m * 16) * ldc + col0;
#pragma unroll
                for (int bj = 0; bj < 2; ++bj) { f32x4 v0 = acc[ai][bj][m][0] + bv[bj][0], v1 = acc[ai][bj][m][1] + bv[bj][1];
                    if (ACT == 1) { f32x2 a = gelu_pk((f32x2){v0[0], v0[1]}), b = gelu_pk((f32x2){v0[2], v0[3]}), c = gelu_pk((f32x2){v1[0], v1[1]}), d = gelu_pk((f32x2){v1[2], v1[3]});
                        v0 = (f32x4){a.x, a.y, b.x, b.y}; v1 = (f32x4){c.x, c.y, d.x, d.y}; }
                    v0 = v0 * sc; v1 = v1 * sc; u32x4 w; w.x = cvt_pk_bf16(v0[0], v0[1]); w.y = cvt_pk_bf16(v0[2], v0[3]); w.z = cvt_pk_bf16(v1[0], v1[1]); w.w = cvt_pk_bf16(v1[2], v1[3]);
                    *(u32x4*)(rowp + bj * HALF) = w; } }
    }
};

struct EpiF32 {
    static constexpr bool PERM = false, AFTER_DRAIN = false;
    float* C; int ldc; const float* bias;
    __device__ __forceinline__ void operator()(const f32x4 (&acc)[2][2][4][2], const Unit& u, int wr, int wc, int fr, int fq) const {
        const int row0 = u.pm * BM + wr * 64 + fr, col0 = u.pn * BM + wc * 32 + 4 * fq;
        f32x4 bv[2][2];
#pragma unroll
        for (int bj = 0; bj < 2; ++bj)
#pragma unroll
            for (int n = 0; n < 2; ++n) bv[bj][n] = bias ? *(const f32x4*)(bias + col0 + bj * HALF + n * 16) : (f32x4){0.f, 0.f, 0.f, 0.f};
#pragma unroll
        for (int ai = 0; ai < 2; ++ai)
#pragma unroll
            for (int m = 0; m < 4; ++m) { float* rowp = C + (size_t)(row0 + ai * HALF + m * 16) * ldc + col0;
#pragma unroll
                for (int bj = 0; bj < 2; ++bj)
#pragma unroll
                    for (int n = 0; n < 2; ++n) *(f32x4*)(rowp + bj * HALF + n * 16) = acc[ai][bj][m][n] + bv[bj][n]; }
    }
};
template <class Epi, class Sched, bool ALIGN_EPI = false, bool SP2 = false>
__device__ __forceinline__ void gemm_phase(PG8_LAS unsigned char* lds, const Gemm g, const Sched& S, const Epi& E) {
    const int tid = threadIdx.x, wid = __builtin_amdgcn_readfirstlane(tid >> 6), lane = tid & 63, wr = wid >> 2, wc = wid & 3, fr = lane & 15, fq = lane >> 4;
    const int K = g.K, nt = K / BK;
    unsigned voffA[2], voffB[2];
#pragma unroll
    for (int i = 0; i < 2; ++i) { int R, C; stage_rc(tid * 16 + i * 8192, R, C); const int Rb = Epi::PERM ? ((R & ~31) + perm32(R & 31)) : R;
        voffA[i] = (unsigned)(R * K + C) * 2u; voffB[i] = (unsigned)(Rb * K + C) * 2u; }
    const size_t kstep = (size_t)(BK * 2);
    const size_t hstep = (size_t)HALF * K * 2;
    const size_t tstep = 2 * hstep;
    const unsigned ldsw = (unsigned)wid * 1024u;
    const int aoff = lds_byte(wr * 64 + fr, fq * 8), boff = lds_byte(wc * 32 + fr, fq * 8);
#define PG8_SA(b, h) (((b) * 2 + (h)) * HTB)
#define PG8_SB(b, h) ((4 + (b) * 2 + (h)) * HTB)
#define PG8_STAGE(bufoff, gbase, voff) do { _Pragma("unroll") for (int _i = 0; _i < 2; ++_i) \
        __builtin_amdgcn_global_load_lds((const unsigned*)((const char*)(gbase) + (voff)[_i]), (PG8_LAS unsigned*)(lds + (bufoff) + ldsw + _i * 8192), 16, 0, 0); } while (0)
#define PG8_LDA(dst, b, h) do { _Pragma("unroll") for (int m = 0; m < 4; ++m) _Pragma("unroll") for (int k = 0; k < 2; ++k) dst[m][k] = *(const PG8_LAS bf16x8*)(lds + PG8_SA(b, h) + aoff + m * 2048 + k * 1024); } while (0)
#define PG8_LDB(dst, b, h) do { _Pragma("unroll") for (int n = 0; n < 2; ++n) _Pragma("unroll") for (int k = 0; k < 2; ++k) dst[n][k] = *(const PG8_LAS bf16x8*)(lds + PG8_SB(b, h) + boff + n * 2048 + k * 1024); } while (0)
#define PG8_MMA(ai, bj, At, Bt) do { __builtin_amdgcn_s_setprio(1); _Pragma("unroll") for (int m = 0; m < 4; ++m) _Pragma("unroll") for (int n = 0; n < 2; ++n) _Pragma("unroll") for (int k = 0; k < 2; ++k) \
        acc[ai][bj][m][n] = __builtin_amdgcn_mfma_f32_16x16x32_bf16(Bt[n][k], At[m][k], acc[ai][bj][m][n], 0, 0, 0); __builtin_amdgcn_s_setprio(0); } while (0)
#define PG8_WAIT_V(n) asm volatile("s_waitcnt vmcnt(" #n ")" ::: "memory")
#define PG8_WAIT_L(n) asm volatile("s_waitcnt lgkmcnt(" #n ")" ::: "memory")
#define PG8_BAR __builtin_amdgcn_s_barrier()
#define PG8_SCHED __builtin_amdgcn_sched_barrier(0)
    Unit cur, nxt; int ui = 0;
    if (!S.next(0, cur)) return;
    f32x4 acc[2][2][4][2];
#pragma unroll
    for (int a = 0; a < 2; ++a)
#pragma unroll
        for (int b = 0; b < 2; ++b)
#pragma unroll
            for (int m = 0; m < 4; ++m)
#pragma unroll
                for (int n = 0; n < 2; ++n) acc[a][b][m][n] = (f32x4){0.f, 0.f, 0.f, 0.f};
    bf16x8 At[4][2], B0[2][2], B1[2][2];
    const char* cA = (const char*)g.A + (size_t)cur.pm * tstep; const char* cB = (const char*)g.Bt + (size_t)cur.pn * tstep;
    S.a_ready(cur);
    if constexpr (SP2) {
        PG8_STAGE(PG8_SB(0, 0), cB, voffB); PG8_STAGE(PG8_SB(0, 1), cB + hstep, voffB); PG8_STAGE(PG8_SA(0, 0), cA, voffA); PG8_STAGE(PG8_SA(0, 1), cA + hstep, voffA);
        if (wr == 1) PG8_BAR;
        PG8_WAIT_V(2); PG8_BAR;
        PG8_STAGE(PG8_SB(1, 0), cB + kstep, voffB); PG8_STAGE(PG8_SA(1, 0), cA + kstep, voffA); PG8_STAGE(PG8_SB(1, 1), cB + hstep + kstep, voffB);
        PG8_WAIT_V(6); PG8_BAR;
    } else {
        PG8_STAGE(PG8_SB(0, 0), cB, voffB); PG8_STAGE(PG8_SA(0, 0), cA, voffA); PG8_STAGE(PG8_SB(0, 1), cB + hstep, voffB); PG8_STAGE(PG8_SA(0, 1), cA + hstep, voffA);
        if (wr == 1) PG8_BAR;
        PG8_WAIT_V(4); PG8_BAR;
        PG8_STAGE(PG8_SB(1, 0), cB + kstep, voffB); PG8_STAGE(PG8_SA(1, 0), cA + kstep, voffA); PG8_STAGE(PG8_SB(1, 1), cB + hstep + kstep, voffB);
        PG8_WAIT_V(6); PG8_BAR;
    }
    for (;;) {
        const bool has_next = S.next(ui + 1, nxt);
        const char* nA = has_next ? (const char*)g.A + (size_t)nxt.pm * tstep : cA; const char* nB = has_next ? (const char*)g.Bt + (size_t)nxt.pn * tstep : cB;
        for (int t = 0; t < nt; t += 2) {
            const bool last = (t == nt - 2);
            const char* a1 = cA + (size_t)(t + 1) * kstep;
            const char* a2 = last ? nA : cA + (size_t)(t + 2) * kstep; const char* b2 = last ? nB : cB + (size_t)(t + 2) * kstep;
            const char* a3 = a2 + kstep; const char* b3 = b2 + kstep;
            if (last && has_next) S.a_ready(nxt);
            if constexpr (SP2) {
            PG8_LDB(B0, 0, 0); PG8_LDB(B1, 0, 1); PG8_SCHED; PG8_LDA(At, 0, 0); PG8_STAGE(PG8_SA(1, 1), a1 + hstep, voffA);
            PG8_WAIT_V(8); PG8_WAIT_L(0); PG8_BAR; PG8_MMA(0, 0, At, B0); PG8_MMA(0, 1, At, B1); PG8_BAR; PG8_SCHED;
            PG8_LDA(At, 0, 1); PG8_STAGE(PG8_SB(0, 0), b2, voffB); PG8_STAGE(PG8_SB(0, 1), b2 + hstep, voffB); PG8_STAGE(PG8_SA(0, 0), a2, voffA);
            PG8_WAIT_V(8); PG8_WAIT_L(0); PG8_BAR; PG8_MMA(1, 0, At, B0); PG8_MMA(1, 1, At, B1); PG8_BAR; PG8_SCHED;
            PG8_LDB(B0, 1, 0); PG8_LDB(B1, 1, 1); PG8_SCHED; PG8_LDA(At, 1, 0); PG8_STAGE(PG8_SA(0, 1), a2 + hstep, voffA);
            PG8_WAIT_V(8); PG8_WAIT_L(0); PG8_BAR; PG8_MMA(0, 0, At, B0); PG8_MMA(0, 1, At, B1); PG8_BAR; PG8_SCHED;
            PG8_LDA(At, 1, 1); PG8_STAGE(PG8_SB(1, 0), b3, voffB); PG8_STAGE(PG8_SB(1, 1), b3 + hstep, voffB); PG8_STAGE(PG8_SA(1, 0), a3, voffA);
            PG8_WAIT_V(8); PG8_WAIT_L(0); PG8_BAR; PG8_MMA(1, 0, At, B0); PG8_MMA(1, 1, At, B1); PG8_BAR; PG8_SCHED;
            } else {
            PG8_LDB(B0, 0, 0); PG8_SCHED; PG8_LDA(At, 0, 0); PG8_STAGE(PG8_SA(1, 1), a1 + hstep, voffA);
            PG8_WAIT_L(8); PG8_BAR; PG8_WAIT_L(0); PG8_MMA(0, 0, At, B0); PG8_BAR; PG8_SCHED;
            PG8_LDB(B1, 0, 1); PG8_STAGE(PG8_SB(0, 0), b2, voffB);
            PG8_BAR; PG8_WAIT_L(0); PG8_MMA(0, 1, At, B1); PG8_BAR;
            PG8_LDA(At, 0, 1); PG8_STAGE(PG8_SA(0, 0), a2, voffA);
            PG8_BAR; PG8_WAIT_L(0); PG8_MMA(1, 0, At, B0); PG8_BAR; PG8_SCHED;
            PG8_STAGE(PG8_SB(0, 1), b2 + hstep, voffB);
            PG8_WAIT_V(6); PG8_BAR; PG8_MMA(1, 1, At, B1); PG8_BAR;
            PG8_LDB(B0, 1, 0); PG8_SCHED; PG8_LDA(At, 1, 0); PG8_STAGE(PG8_SA(0, 1), a2 + hstep, voffA);
            PG8_WAIT_L(8); PG8_BAR; PG8_WAIT_L(0); PG8_MMA(0, 0, At, B0); PG8_BAR; PG8_SCHED;
            PG8_LDB(B1, 1, 1); PG8_STAGE(PG8_SB(1, 0), b3, voffB);
            PG8_BAR; PG8_WAIT_L(0); PG8_MMA(0, 1, At, B1); PG8_BAR;
            PG8_LDA(At, 1, 1); PG8_STAGE(PG8_SA(1, 0), a3, voffA);
            PG8_BAR; PG8_WAIT_L(0); PG8_MMA(1, 0, At, B0); PG8_BAR; PG8_SCHED;
            PG8_STAGE(PG8_SB(1, 1), b3 + hstep, voffB);
            PG8_WAIT_V(6); PG8_BAR; PG8_MMA(1, 1, At, B1); PG8_BAR;
            }
        }
        if constexpr (ALIGN_EPI) { if (wr == 0) PG8_BAR; }
        if constexpr (!Epi::AFTER_DRAIN) { E(acc, cur, wr, wc, fr, fq); S.done(cur); }
        if (!has_next) break;
#pragma unroll
        for (int a = 0; a < 2; ++a)
#pragma unroll
            for (int b = 0; b < 2; ++b)
#pragma unroll
                for (int m = 0; m < 4; ++m)
#pragma unroll
                    for (int n = 0; n < 2; ++n) acc[a][b][m][n] = (f32x4){0.f, 0.f, 0.f, 0.f};
        cur = nxt; cA = nA; cB = nB; ++ui;
        if constexpr (ALIGN_EPI) { if (wr == 1) PG8_BAR; }
    }
    PG8_WAIT_V(0);
    if constexpr (!ALIGN_EPI) { if (wr == 0) PG8_BAR; }
    PG8_BAR;
    if constexpr (Epi::AFTER_DRAIN) { E.fused(acc, cur, wr, wc, fr, fq, lds, wid, lane); S.done(cur); }
#undef PG8_SA
#undef PG8_SB
#undef PG8_STAGE
#undef PG8_LDA
#undef PG8_LDB
#undef PG8_MMA
#undef PG8_WAIT_V
#undef PG8_WAIT_L
#undef PG8_BAR
#undef PG8_SCHED
}
}

#ifndef ATTN_FAST
#define ATTN_FAST 1
#endif
#ifndef SCAN_FAST
#define SCAN_FAST 1
#endif
#ifndef ONE_LAUNCH
#define ONE_LAUNCH 1
#endif
constexpr int NWAVES = 8, NTHR = 512;
constexpr int D = 1024, NB = 4, TL = 4096, CT = 256, SB = CT + TL  , NL = 4;
constexpr int M = NB * SB;
constexpr int NIN = 2688, NINP = 2816, DFF = 2816, DFF2 = 5632;
constexpr int R_IN = 1152, R_OFF = 768, C_OFF = 1920, K_OFF = 512, V_OFF = 640;
constexpr float NORM_EPS = 1e-6f, GN_EPS = 64e-5f, DECAY_SCALE = 0.606531f;
constexpr float C2 = 0.125f * 1.4426950408889634f;

typedef unsigned short bf16;
typedef unsigned v4u __attribute__((ext_vector_type(4)));
typedef unsigned v2u __attribute__((ext_vector_type(2)));
typedef float f32x4 __attribute__((ext_vector_type(4)));
#define LAS __attribute__((address_space(3)))
#define GAS __attribute__((address_space(1)))
typedef GAS unsigned gu32;
#define RLX_AGENT __ATOMIC_RELAXED, __HIP_MEMORY_SCOPE_AGENT

constexpr size_t MiB = 1u << 20;
constexpr size_t WS_CTL = 0, CTL_ZERO_BYTES = 1 * MiB;
constexpr size_t WS_MODS = 1 * MiB;
constexpr size_t WS_ROPE = WS_MODS + 512 * 1024;
constexpr size_t WS_XCUR = 3 * MiB;
constexpr size_t SZ_XCUR = (size_t)M * D * 4;
constexpr size_t WS_WIN = WS_XCUR + SZ_XCUR;
constexpr size_t WS_WOUT = WS_WIN + (size_t)NINP * D * 2;
constexpr size_t WS_WUP = WS_WOUT + (size_t)D * D * 2;
constexpr size_t WS_WDN = WS_WUP + (size_t)DFF2 * D * 2;
constexpr size_t WS_AR = WS_WDN + (size_t)D * DFF * 2;
constexpr size_t SZ_BF_MD = (size_t)M * D * 2;
constexpr size_t SZ_BF_M256 = (size_t)M * 256 * 2;
constexpr size_t AR_XN = 0;
constexpr size_t AR_Y = 0;
constexpr size_t AR_U = AR_XN + SZ_BF_MD;
constexpr size_t AR_MIXO = AR_U;
constexpr size_t AR_R = AR_U + (size_t)M * NINP * 2;
constexpr size_t AR_V = AR_R + SZ_BF_M256;
constexpr size_t AR_KK = AR_V + SZ_BF_M256;
constexpr size_t AR_G = AR_KK + SZ_BF_M256;
constexpr size_t AR_KE = AR_G + SZ_BF_M256;
constexpr size_t AR_KKA = AR_KE + 2 * SZ_BF_M256;
constexpr size_t AR_W = AR_KKA + 2 * SZ_BF_M256;
constexpr size_t AR_MIX = AR_W + (size_t)2 * M * 256 * 4;
constexpr size_t AR_END1 = AR_MIX + SZ_BF_MD;
constexpr size_t AR_ACT = 0;
constexpr size_t AR_H = AR_ACT + (size_t)M * DFF * 2;
constexpr size_t AR_FO = AR_H;
constexpr size_t AR_END2 = AR_H + (size_t)M * DFF2 * 2;
constexpr size_t WS_END = WS_AR + (AR_END1 > AR_END2 ? AR_END1 : AR_END2);
static_assert(WS_END <= 384 * MiB, "workspace budget");
constexpr int CW_BAR = 4096;

constexpr int LDS_BYTES = 147456;
constexpr int RING_BYTES = 131072, LDSCTL_OFF = RING_BYTES, MISC_OFF = LDSCTL_OFF + 320;

__device__ __forceinline__ unsigned f2bf(float f) { unsigned u = __builtin_bit_cast(unsigned, f); return (u + 0x7fffu + ((u >> 16) & 1u)) >> 16; }
__device__ __forceinline__ unsigned pk2(float lo, float hi) { return f2bf(lo) | (f2bf(hi) << 16); }
__device__ __forceinline__ float bf2f(unsigned short b) { return __builtin_bit_cast(float, ((unsigned)b) << 16); }
__device__ __forceinline__ float bflo(unsigned w) { return __builtin_bit_cast(float, w << 16); }
__device__ __forceinline__ float bfhi(unsigned w) { return __builtin_bit_cast(float, w & 0xffff0000u); }
__device__ __forceinline__ float sigm(float x) { return 1.f / (1.f + __expf(-x)); }
__device__ __forceinline__ float wave_sum(float v) {
#pragma unroll
    for (int o = 1; o < 64; o <<= 1) v += __shfl_xor(v, o);
    return v;
}
#define LDS_WAIT() asm volatile("s_waitcnt lgkmcnt(0)" ::: "memory")

#define XB_TMO      128
#define XB_XCNT(j)  (256  + 64 * (j))
#define XB_XSUB(j)  (1280 + 64 * (j))
#define XB_XGEN(j)  (2304 + 64 * (j))
#define XB_TOP      3328
#define XB_TOPGEN   3392
#define XCD_BAR_WORDS 3456
#define XB_SPIN_CAP (1u << 18)
__device__ __forceinline__ unsigned xb_ld(unsigned* p)              { return __hip_atomic_load(p, __ATOMIC_RELAXED, __HIP_MEMORY_SCOPE_AGENT); }
__device__ __forceinline__ unsigned xb_add(unsigned* p, unsigned v) { return __hip_atomic_fetch_add(p, v, __ATOMIC_RELAXED, __HIP_MEMORY_SCOPE_AGENT); }
__device__ __forceinline__ unsigned xb_xcc_id() { return (unsigned)__builtin_amdgcn_s_getreg((3 << 11) | 20) & 0xFu; }
#define XB_SPIN(cond, bar) do { unsigned _sp = 0; while (cond) { __builtin_amdgcn_s_sleep(1); \
    if ((++_sp & 255u) == 0u) { if (xb_ld(&(bar)[XB_TMO])) break; if (_sp > XB_SPIN_CAP) { atomicAdd(&(bar)[XB_TMO], 1u); break; } } } } while (0)
struct XcdBarrier { unsigned* bar; unsigned x; volatile LAS unsigned* st; };
__device__ __forceinline__ XcdBarrier xcd_barrier_post(unsigned* bar, volatile LAS unsigned* st) {
    XcdBarrier b; b.bar = bar; b.x = xb_xcc_id(); b.st = st;
    if (threadIdx.x == 0) (void)xb_add(&bar[XB_XCNT(b.x)], 1u);
    return b;
}
__device__ __forceinline__ void xcd_barrier_complete(unsigned* bar, unsigned x, unsigned& nloc, unsigned& nx) {
    const unsigned G = gridDim.x * gridDim.y * gridDim.z;
    unsigned sum, cnt, mine, sp = 0u;
    for (;;) {
        sum = 0u; cnt = 0u; mine = 0u;
#pragma unroll
        for (unsigned j = 0; j < 16; ++j) { const unsigned c = xb_ld(&bar[XB_XCNT(j)]); sum += c; cnt += (c > 0u) ? 1u : 0u; mine = (j == x) ? c : mine; }
        if (sum == G) break;
        __builtin_amdgcn_s_sleep(1);
        if ((++sp & 255u) == 0u) { if (xb_ld(&bar[XB_TMO])) break; if (sp > XB_SPIN_CAP) { atomicAdd(&bar[XB_TMO], 1u); break; } }
    }
    nloc = mine > 0u ? mine : 1u; nx = cnt > 0u ? cnt : 1u;
}
__device__ __forceinline__ void xcd_barrier(const XcdBarrier& b) {
    asm volatile("s_waitcnt vmcnt(0)" ::: "memory");
    __syncthreads();
    if (threadIdx.x == 0) {
        unsigned* bar = b.bar;
        __builtin_amdgcn_s_waitcnt(0);
        unsigned nloc = b.st[0], nx = b.st[1];
        if (nloc == 0u) { xcd_barrier_complete(bar, b.x, nloc, nx); b.st[0] = nloc; b.st[1] = nx; }
        const unsigned old = xb_add(&bar[XB_XSUB(b.x)], 1u);
        const unsigned gen = old / nloc;
        if (old + 1u == (gen + 1u) * nloc) {
            __builtin_amdgcn_fence(__ATOMIC_RELEASE, "agent");
            asm volatile("s_waitcnt vmcnt(0)" ::: "memory");
            const unsigned og = xb_add(&bar[XB_TOP], 1u);
            const unsigned tg = og / nx;
            if (og + 1u == (tg + 1u) * nx) xb_add(&bar[XB_TOPGEN], 1u);
            else XB_SPIN(xb_ld(&bar[XB_TOPGEN]) == tg, bar);
            __builtin_amdgcn_fence(__ATOMIC_ACQUIRE, "agent");
            xb_add(&bar[XB_XGEN(b.x)], 1u);
            asm volatile("s_waitcnt vmcnt(0)" ::: "memory");
        } else {
            XB_SPIN(xb_ld(&bar[XB_XGEN(b.x)]) == gen, bar);
            __builtin_amdgcn_fence(__ATOMIC_ACQUIRE, "agent");
            asm volatile("s_waitcnt vmcnt(0)" ::: "memory");
        }
    }
    __syncthreads();
}

struct Args {
    const float* in[29];
    float* out; unsigned char* ws;
    int ph_lo, ph_hi;
};
enum { I_X = 0, I_C, I_CTX, I_CCTX, I_ADAW, I_ADAB, I_NMPRE, I_NMPOST, I_NFPRE, I_NFPOST, I_WIN, I_WOUT, I_QN, I_KN, I_MU, I_W0, I_WUP, I_A0, I_AUP, I_GUP,
       I_KK, I_KA, I_RK, I_LNW, I_LNB, I_SCW, I_FUP, I_FCONV, I_FDN };

struct Frame {
    LAS unsigned char* lds;
    int tid, lane, wave, bid, G;
    unsigned char* ws;
    float* out;
};
constexpr int PTR_OFF = LDSCTL_OFF + 1024;
#define INP(i) ((const float*)(const GAS float*)(((const unsigned long long LAS*)(F.lds + PTR_OFF))[i]))

__device__ __forceinline__ void transpose_item(const float* W, int K, int N, bf16* WT, LAS float* scr, int item, int lane) {
    const int nblk = N / 32, kb = item / nblk, nb = item % nblk, k0 = 64 * kb, n0 = 32 * nb;
#pragma unroll 8
    for (int i = 0; i < 32; ++i) { const int kk = 2 * i + (lane >> 5); scr[kk * 33 + (lane & 31)] = W[(size_t)(k0 + kk) * N + n0 + (lane & 31)]; }
    LDS_WAIT(); asm volatile("" ::: "memory");
    const int c = lane & 7;
#pragma unroll
    for (int j = 0; j < 4; ++j) { const int n = (lane >> 3) + 8 * j; const LAS float* s = scr + (8 * c) * 33 + n;
        v4u o; o.x = pk2(s[0 * 33], s[1 * 33]); o.y = pk2(s[2 * 33], s[3 * 33]); o.z = pk2(s[4 * 33], s[5 * 33]); o.w = pk2(s[6 * 33], s[7 * 33]);
        *(v4u*)(WT + (size_t)(n0 + n) * K + k0 + 8 * c) = o; }
    LDS_WAIT(); asm volatile("" ::: "memory");
}
__device__ __forceinline__ void convert_weights(const Frame& F, int l) {
    LAS float* scr = (LAS float*)(F.lds + F.wave * 8448);
    const int gw = F.bid * NWAVES + F.wave, NGW = F.G * NWAVES;
    const float* w_in = INP(I_WIN) + (size_t)l * D * NIN; const float* w_out = INP(I_WOUT) + (size_t)l * D * D;
    const float* w_up = INP(I_FUP) + (size_t)l * D * DFF2; const float* w_dn = INP(I_FDN) + (size_t)l * DFF * D;
    bf16* t_in = (bf16*)(F.ws + WS_WIN); bf16* t_out = (bf16*)(F.ws + WS_WOUT); bf16* t_up = (bf16*)(F.ws + WS_WUP); bf16* t_dn = (bf16*)(F.ws + WS_WDN);
    constexpr int I_1 = (D / 64) * (NIN / 32), I_2 = (D / 64) * (D / 32), I_3 = (D / 64) * (DFF2 / 32), I_4 = (DFF / 64) * (D / 32);
    for (int it = gw; it < I_1 + I_2 + I_3 + I_4; it += NGW) {
        int r = it;
        if (r < I_1) { transpose_item(w_in, D, NIN, t_in, scr, r, F.lane); continue; } r -= I_1;
        if (r < I_2) { transpose_item(w_out, D, D, t_out, scr, r, F.lane); continue; } r -= I_2;
        if (r < I_3) { transpose_item(w_up, D, DFF2, t_up, scr, r, F.lane); continue; } r -= I_3;
        transpose_item(w_dn, DFF, D, t_dn, scr, r, F.lane);
    }
    v4u z = {0u, 0u, 0u, 0u};
    for (int i = F.bid * NTHR + F.tid; i < (NINP - NIN) * D / 8; i += F.G * NTHR) *(v4u*)(t_in + (size_t)NIN * D + (size_t)i * 8) = z;
}

__device__ __forceinline__ void phase_pro_a(const Frame& F) {
    convert_weights(F, 0);
    __syncthreads();
    float* rope = (float*)(F.ws + WS_ROPE);
    for (int e = F.bid * NTHR + F.tid; e < TL * 32; e += F.G * NTHR) {
        const int pos = e >> 5, i = e & 31;
        const float inv = powf(10000.0f, -(float)(i & 15) / 16.0f);
        const float p = (i < 16) ? (float)(pos / 64) : (float)(pos % 64);
        const float ang = p * inv;
        rope[2 * e] = cosf(ang); rope[2 * e + 1] = sinf(ang);
    }
    LAS float* sc = (LAS float*)F.lds;
    LAS float* red = (LAS float*)(F.lds + 20480);
    for (int i = F.tid; i < 5 * 1024; i += NTHR) { const int r = i >> 10, k = i & 1023; const float v = r < 4 ? INP(I_C)[r * 1024 + k] : INP(I_CCTX)[k]; sc[i] = v / (1.f + expf(-v)); }
    __syncthreads();
    float* mods = (float*)(F.ws + WS_MODS);
    for (int item = F.bid; item < NL * 96; item += F.G) {
        const int l = item / 96, jg = item % 96;
        const float* w = INP(I_ADAW) + (size_t)l * 1024 * 6144 + jg * 64 + F.lane;
        float a0 = 0, a1 = 0, a2 = 0, a3 = 0, a4 = 0;
        const int kb = F.wave * 128;
#pragma unroll 8
        for (int k = 0; k < 128; ++k) { const float wv = w[(size_t)(kb + k) * 6144];
            a0 += sc[kb + k] * wv; a1 += sc[1024 + kb + k] * wv; a2 += sc[2048 + kb + k] * wv; a3 += sc[3072 + kb + k] * wv; a4 += sc[4096 + kb + k] * wv; }
        red[(F.wave * 5 + 0) * 64 + F.lane] = a0; red[(F.wave * 5 + 1) * 64 + F.lane] = a1; red[(F.wave * 5 + 2) * 64 + F.lane] = a2;
        red[(F.wave * 5 + 3) * 64 + F.lane] = a3; red[(F.wave * 5 + 4) * 64 + F.lane] = a4;
        __syncthreads();
        if (F.tid < 320) { const int r = F.tid >> 6, j = F.tid & 63; float s = 0.f;
#pragma unroll
            for (int w8 = 0; w8 < 8; ++w8) s += red[(w8 * 5 + r) * 64 + j];
            mods[((size_t)l * 5 + r) * 6144 + jg * 64 + j] = s + INP(I_ADAB)[l * 6144 + jg * 64 + j]; }
        __syncthreads();
    }
}

__device__ __forceinline__ void norm_phase(const Frame& F, int mode, const float* o, const float* g_post, int lmod_gate, int i_gate,
                                           const float* g_next, int lmod_next, int i_shift, int i_scale) {
    const int gw = F.bid * NWAVES + F.wave, NGW = F.G * NWAVES;
    float* xcur = (float*)(F.ws + WS_XCUR); bf16* xn = (bf16*)(F.ws + WS_AR + AR_XN);
    const float* mods = (const float*)(F.ws + WS_MODS);
    for (int m = gw; m < M; m += NGW) {
        const int b = m / SB, s = m % SB; const int mr = s < CT ? 4 : b;
        f32x4 x[4];
        if (mode == 0) {
            const float* src = s < CT ? INP(I_CTX) + ((size_t)b * CT + s) * D : INP(I_X) + ((size_t)b * TL + (s - CT)) * D;
#pragma unroll
            for (int j = 0; j < 4; ++j) x[j] = *(const f32x4*)(src + 4 * F.lane + 256 * j);
        } else {
            f32x4 ov[4]; float ss = 0.f;
#pragma unroll
            for (int j = 0; j < 4; ++j) { ov[j] = *(const f32x4*)(o + (size_t)m * D + 4 * F.lane + 256 * j); ss += ov[j][0] * ov[j][0] + ov[j][1] * ov[j][1] + ov[j][2] * ov[j][2] + ov[j][3] * ov[j][3]; }
            ss = wave_sum(ss);
            const float rs = rsqrtf(ss * (1.f / D) + NORM_EPS);
            const float* gate = mods + ((size_t)lmod_gate * 5 + mr) * 6144 + i_gate * 1024;
#pragma unroll
            for (int j = 0; j < 4; ++j) { const int c0 = 4 * F.lane + 256 * j;
                const f32x4 xv = *(const f32x4*)(xcur + (size_t)m * D + c0); const f32x4 gp = *(const f32x4*)(g_post + c0); const f32x4 gt = *(const f32x4*)(gate + c0);
                x[j] = xv + gt * (ov[j] * rs * gp); }
        }
        if (mode == 2) {
            if (s >= CT) {
#pragma unroll
                for (int j = 0; j < 4; ++j) *(f32x4*)(F.out + ((size_t)b * TL + (s - CT)) * D + 4 * F.lane + 256 * j) = x[j];
            }
            continue;
        }
        float ss = 0.f;
#pragma unroll
        for (int j = 0; j < 4; ++j) { *(f32x4*)(xcur + (size_t)m * D + 4 * F.lane + 256 * j) = x[j]; ss += x[j][0] * x[j][0] + x[j][1] * x[j][1] + x[j][2] * x[j][2] + x[j][3] * x[j][3]; }
        ss = wave_sum(ss);
        const float rs = rsqrtf(ss * (1.f / D) + NORM_EPS);
        const float* mrow = mods + ((size_t)lmod_next * 5 + mr) * 6144;
#pragma unroll
        for (int j = 0; j < 4; ++j) { const int c0 = 4 * F.lane + 256 * j;
            const f32x4 gn = *(const f32x4*)(g_next + c0); const f32x4 sh = *(const f32x4*)(mrow + i_shift * 1024 + c0); const f32x4 scl = *(const f32x4*)(mrow + i_scale * 1024 + c0);
            const f32x4 y = x[j] * rs * gn * (scl + 1.f) + sh;
            v2u w; w.x = pk2(y[0], y[1]); w.y = pk2(y[2], y[3]);
            *(v2u*)(xn + (size_t)m * D + c0) = w; }
    }
}

__device__ __forceinline__ void prep_phase(const Frame& F, int l) {
    LAS float* zs = (LAS float*)F.lds;
    LAS float* th = (LAS float*)(F.lds + 36864);
    LAS float* sg = (LAS float*)(F.lds + 40960);
    bf16* U = (bf16*)(F.ws + WS_AR + AR_U);
    const float* rope = (const float*)(F.ws + WS_ROPE);
    const float* qn = INP(I_QN) + l * 64; const float* kn = INP(I_KN) + l * 64;
    const float* mu = INP(I_MU) + (size_t)l * 2 * R_IN;
    const float* w0 = INP(I_W0) + l * 512; const float* w_up = INP(I_WUP) + (size_t)l * 2 * 64 * 256;
    const float* a0 = INP(I_A0) + l * 512; const float* a_up = INP(I_AUP) + (size_t)l * 2 * 64 * 256;
    const float* g_up = INP(I_GUP) + (size_t)l * 128 * 256;
    const float* k_k = INP(I_KK) + l * 256; const float* k_a = INP(I_KA) + l * 256;
    const float* scw = INP(I_SCW) + (size_t)l * 3 * 256;
    bf16* R_o = (bf16*)(F.ws + WS_AR + AR_R); bf16* V_o = (bf16*)(F.ws + WS_AR + AR_V); bf16* KK_o = (bf16*)(F.ws + WS_AR + AR_KK); bf16* G_o = (bf16*)(F.ws + WS_AR + AR_G);
    bf16* KE_o = (bf16*)(F.ws + WS_AR + AR_KE); bf16* KKA_o = (bf16*)(F.ws + WS_AR + AR_KKA); float* W_o = (float*)(F.ws + WS_AR + AR_W);
    bf16* MIX = (bf16*)(F.ws + WS_AR + AR_MIX);
    for (int item = F.bid; item < M / 8; item += F.G) {
        const int m0 = item * 8, s0 = m0 % SB;
        const bool isctx = s0 < CT; const int seq_lo = isctx ? 0 : CT, seq_hi = isctx ? CT : SB;
        { const int m = m0 + F.wave, s = s0 + F.wave; bf16* ur = U + (size_t)m * NINP;
          float cs = 1.f, sn = 0.f;
          if (!isctx) { const float* rp = rope + ((size_t)(s - CT) * 32 + (F.lane & 31)) * 2; cs = rp[0]; sn = rp[1]; }
          const float gq = qn[F.lane], gk = kn[F.lane];
#pragma unroll
          for (int h = 0; h < 10; ++h) {
              const float x = bf2f(ur[h * 64 + F.lane]);
              const float ss = wave_sum(x * x);
              float y = x * rsqrtf(ss * (1.f / 64.f) + NORM_EPS) * (h < 8 ? gq : gk);
              const float partner = __shfl_xor(y, 32);
              y = (F.lane < 32) ? (y * cs - partner * sn) : (y * cs + partner * sn);
              if (h < 8) y *= C2;
              ur[h * 64 + F.lane] = (bf16)f2bf(y);
          } }
        for (int i = F.tid; i < 8 * R_IN; i += NTHR) {
            const int t = i / R_IN, c = i % R_IN; const int s = s0 + t; const bf16* up = U + (size_t)(m0 + t) * NINP + R_OFF + c;
            const float z = bf2f(up[0]);
            const float pv = s > seq_lo ? bf2f(up[-NINP]) : 0.f;
            const float nx = s < seq_hi - 1 ? bf2f(up[NINP]) : 0.f;
            zs[i] = z + mu[c] * (pv - z) + mu[R_IN + c] * (nx - z);
        }
        __syncthreads();
        for (int i = F.tid; i < 8 * 128; i += NTHR) { const int t = i >> 7, j = i & 127; th[i] = tanhf(zs[t * R_IN + 768 + j]); sg[i] = sigm(zs[t * R_IN + 1024 + j]); }
        __syncthreads();
        { const int c = F.tid & 255, t0 = (F.tid >> 8) * 4;
          float aw[2][4], aa[2][4], ag[4];
#pragma unroll
          for (int t = 0; t < 4; ++t) { ag[t] = 0.f; aw[0][t] = w0[c]; aw[1][t] = w0[256 + c]; aa[0][t] = a0[c]; aa[1][t] = a0[256 + c]; }
#pragma unroll
          for (int d = 0; d < 2; ++d)
              for (int r = 0; r < 64; ++r) { const float wu = w_up[(d * 64 + r) * 256 + c], au = a_up[(d * 64 + r) * 256 + c];
#pragma unroll
                  for (int t = 0; t < 4; ++t) { aw[d][t] += th[(t0 + t) * 128 + d * 64 + r] * wu; aa[d][t] += zs[(t0 + t) * R_IN + 896 + d * 64 + r] * au; } }
          for (int r = 0; r < 128; ++r) { const float gu = g_up[r * 256 + c];
#pragma unroll
              for (int t = 0; t < 4; ++t) ag[t] += sg[(t0 + t) * 128 + r] * gu; }
          const float kkc = k_k[c], kac = k_a[c];
#pragma unroll
          for (int t = 0; t < 4; ++t) {
              const int m = m0 + t0 + t; const size_t o = (size_t)m * 256 + c;
              const float k = zs[(t0 + t) * R_IN + 256 + c];
              const float kkr = k * kkc;
              const float ss = wave_sum(kkr * kkr);
              const float kk = kkr * rsqrtf(fmaxf(ss, 1e-12f));
              R_o[o] = (bf16)f2bf(zs[(t0 + t) * R_IN + c]); V_o[o] = (bf16)f2bf(zs[(t0 + t) * R_IN + 512 + c]); KK_o[o] = (bf16)f2bf(kk); G_o[o] = (bf16)f2bf(ag[t]);
#pragma unroll
              for (int d = 0; d < 2; ++d) {
                  const float w = __expf(-DECAY_SCALE * sigm(aw[d][t])); const float a = sigm(aa[d][t]);
                  const size_t od = (size_t)d * M * 256 + o;
                  W_o[od] = w; KE_o[od] = (bf16)f2bf(k * (1.f + (a - 1.f) * kac)); KKA_o[od] = (bf16)f2bf(kk * a);
              }
          } }
        for (int i = F.tid; i < 8 * 256; i += NTHR) {
            const int t = i >> 8, c = i & 255; const int s = s0 + t; const bf16* u = U + (size_t)(m0 + t) * NINP + C_OFF;
            const float p = bf2f(u[256 + c]) * bf2f(u[512 + c]);
            const float pp = s > seq_lo ? bf2f(u[256 + c - NINP]) * bf2f(u[512 + c - NINP]) : 0.f;
            const float pn = s < seq_hi - 1 ? bf2f(u[256 + c + NINP]) * bf2f(u[512 + c + NINP]) : 0.f;
            MIX[(size_t)(m0 + t) * D + 768 + c] = (bf16)f2bf(bf2f(u[c]) * (pp * scw[c] + p * scw[256 + c] + pn * scw[512 + c]));
        }
        __syncthreads();
    }
}

__device__ __forceinline__ void rwkv_out_phase(const Frame& F, int l) {
    const float* Y = (const float*)(F.ws + WS_AR + AR_Y);
    const bf16* R_i = (const bf16*)(F.ws + WS_AR + AR_R); const bf16* V_i = (const bf16*)(F.ws + WS_AR + AR_V); const bf16* G_i = (const bf16*)(F.ws + WS_AR + AR_G);
    const bf16* KE_i = (const bf16*)(F.ws + WS_AR + AR_KE);
    bf16* MIX = (bf16*)(F.ws + WS_AR + AR_MIX);
    const float* r_k = INP(I_RK) + l * 256; const float* lnw = INP(I_LNW) + l * 256; const float* lnb = INP(I_LNB) + l * 256;
    const int gw = F.bid * NWAVES + F.wave, NGW = F.G * NWAVES;
    for (int it = gw; it < M * 4; it += NGW) {
        const int m = it >> 2, c = (it & 3) * 64 + F.lane; const size_t o = (size_t)m * 256 + c;
        const float y = Y[o] + Y[(size_t)M * 256 + o];
        const float mean = wave_sum(y) * (1.f / 64.f);
        const float dl = y - mean;
        const float var = wave_sum(dl * dl) * (1.f / 64.f);
        const float yn = dl * rsqrtf(var + GN_EPS) * lnw[c] + lnb[c];
        const float t = bf2f(R_i[o]) * (bf2f(KE_i[o]) + bf2f(KE_i[(size_t)M * 256 + o])) * r_k[c];
        const float bonus = wave_sum(t) * bf2f(V_i[o]);
        MIX[(size_t)m * D + 512 + c] = (bf16)f2bf((yn + bonus) * bf2f(G_i[o]));
    }
}

__device__ __forceinline__ void act_phase(const Frame& F, int l) {
    const bf16* H = (const bf16*)(F.ws + WS_AR + AR_H); bf16* ACT = (bf16*)(F.ws + WS_AR + AR_ACT);
    const float* wc = INP(I_FCONV) + (size_t)l * 3 * DFF2;
    constexpr int NCH = DFF / 8;
    const int nitems = (M / 16) * NCH;
    for (int it = F.bid * NTHR + F.tid; it < nitems; it += F.G * NTHR) {
        const int rg = it / NCH, ch = it % NCH, j0 = ch * 8, m0 = rg * 16, s0 = m0 % SB;
        const bool isctx = s0 < CT; const int seq_lo = isctx ? 0 : CT, seq_hi = isctx ? CT : SB;
        float wg[3][8], wu[3][8];
#pragma unroll
        for (int tp = 0; tp < 3; ++tp)
#pragma unroll
            for (int e = 0; e < 8; ++e) { wg[tp][e] = wc[tp * DFF2 + j0 + e]; wu[tp][e] = wc[tp * DFF2 + DFF + j0 + e]; }
        v4u gp, gc, gn, up, uc, un;
        const v4u zero = {0u, 0u, 0u, 0u};
        const bf16* hr = H + (size_t)m0 * DFF2 + j0;
        gp = (s0 > seq_lo) ? *(const v4u*)(hr - DFF2) : zero; up = (s0 > seq_lo) ? *(const v4u*)(hr - DFF2 + DFF) : zero;
        gc = *(const v4u*)hr; uc = *(const v4u*)(hr + DFF);
#pragma unroll 4
        for (int r = 0; r < 16; ++r) {
            const int s = s0 + r;
            const bf16* hn = hr + (size_t)(r + 1) * DFF2;
            if (s < seq_hi - 1) { gn = *(const v4u*)hn; un = *(const v4u*)(hn + DFF); } else { gn = zero; un = zero; }
            v4u o;
#pragma unroll
            for (int q = 0; q < 4; ++q) {
                const float ga0 = bflo(gp[q]) * wg[0][2 * q] + bflo(gc[q]) * wg[1][2 * q] + bflo(gn[q]) * wg[2][2 * q];
                const float ga1 = bfhi(gp[q]) * wg[0][2 * q + 1] + bfhi(gc[q]) * wg[1][2 * q + 1] + bfhi(gn[q]) * wg[2][2 * q + 1];
                const float u0 = bflo(up[q]) * wu[0][2 * q] + bflo(uc[q]) * wu[1][2 * q] + bflo(un[q]) * wu[2][2 * q];
                const float u1 = bfhi(up[q]) * wu[0][2 * q + 1] + bfhi(uc[q]) * wu[1][2 * q + 1] + bfhi(un[q]) * wu[2][2 * q + 1];
                o[q] = pk2(ga0 / (1.f + __expf(-ga0)) * u0, ga1 / (1.f + __expf(-ga1)) * u1);
            }
            *(v4u*)(ACT + (size_t)(m0 + r) * DFF + j0) = o;
            gp = gc; gc = gn; up = uc; uc = un;
        }
    }
}

namespace attn_body {
using bf16=__hip_bfloat16;
using bf16x8=__attribute__((ext_vector_type(8)))short;
using s16x4=__attribute__((ext_vector_type(4)))short;
using f32x16=__attribute__((ext_vector_type(16)))float;
using u32x4=__attribute__((ext_vector_type(4)))unsigned;
constexpr int D=64,QP=2816,OP=1024;
constexpr int NW=8,QBLK=32,QB=QBLK*NW,KVBLK=64;
constexpr int ATTN_UNIT_ROWS=QB;
__device__ __forceinline__ int crow(int r,int hi){return (r&3)+8*(r>>2)+4*hi;}
#define SBAR() __builtin_amdgcn_sched_barrier(0)
constexpr int NSLOT=3, SLOTB=8192;
constexpr int LDS_K=0, LDS_V=NSLOT*SLOTB, LDS_WS=2*NSLOT*SLOTB, LDS_OST=LDS_WS+NW*64*4, LDS_BYTES=LDS_OST+NW*4096;
__device__ __forceinline__ void glds16(const void*gsrc,unsigned lds_dst){unsigned keep;
  asm volatile("s_mov_b32 %0, m0\n\ts_mov_b32 m0, %2\n\ts_nop 0\n\tglobal_load_lds_dwordx4 %1, off\n\ts_mov_b32 m0, %0":"=&s"(keep):"v"(gsrc),"s"(lds_dst):"memory");}
__device__ __forceinline__ float max3f(float a,float b,float c){float r;asm("v_max3_f32 %0, %1, %2, %3":"=v"(r):"v"(a),"v"(b),"v"(c));return r;}
__device__ __forceinline__ float max2f(float a,float b){float r;asm("v_max_f32_e32 %0, %1, %2":"=v"(r):"v"(a),"v"(b));return r;}
__device__ __forceinline__ float fadd_s(float a,float b){float r;asm("v_add_f32_e32 %0, %1, %2":"=v"(r):"v"(a),"v"(b));return r;}
__device__ __forceinline__ float fsub_s(float a,float b){float r;asm("v_sub_f32_e32 %0, %1, %2":"=v"(r):"v"(a),"v"(b));return r;}
typedef float f32x2_t __attribute__((ext_vector_type(2))); typedef __bf16 bf16x2_t __attribute__((ext_vector_type(2)));
__device__ __forceinline__ unsigned cvtpk_s(float lo,float hi){f32x2_t v={lo,hi};bf16x2_t b=__builtin_convertvector(v,bf16x2_t);return __builtin_bit_cast(unsigned,b);}
#define WAIT_BAR(N) asm volatile("s_waitcnt vmcnt(" #N ") lgkmcnt(0)\n\ts_barrier":::"memory")

__device__ __forceinline__ void qkt(f32x16&p0,f32x16&p1,const char*Kslot,const bf16x8*qr,const f32x16&negm,int r32,int hi){
  const char*kb=Kslot+hi*1024+r32*16;
  #pragma unroll
  for(int d0=0;d0<4;++d0){
    const bf16x8 b0=*reinterpret_cast<const bf16x8*>(kb+d0*2048);
    const bf16x8 b1=*reinterpret_cast<const bf16x8*>(kb+d0*2048+512);
    if(d0==0){p0=__builtin_amdgcn_mfma_f32_32x32x16_bf16(b0,qr[0],negm,0,0,0);p1=__builtin_amdgcn_mfma_f32_32x32x16_bf16(b1,qr[0],negm,0,0,0);}
    else{p0=__builtin_amdgcn_mfma_f32_32x32x16_bf16(b0,qr[d0],p0,0,0,0);p1=__builtin_amdgcn_mfma_f32_32x32x16_bf16(b1,qr[d0],p1,0,0,0);}}
}
typedef __attribute__((address_space(3))) const char* lds_cptr;
typedef short v4i16_t __attribute__((ext_vector_type(4)));
__device__ __forceinline__ void kload8(bf16x8*kf,lds_cptr kp){
  kf[0]=*(const __attribute__((address_space(3))) bf16x8*)(kp);      kf[1]=*(const __attribute__((address_space(3))) bf16x8*)(kp+512);
  kf[2]=*(const __attribute__((address_space(3))) bf16x8*)(kp+2048); kf[3]=*(const __attribute__((address_space(3))) bf16x8*)(kp+2560);
  kf[4]=*(const __attribute__((address_space(3))) bf16x8*)(kp+4096); kf[5]=*(const __attribute__((address_space(3))) bf16x8*)(kp+4608);
  kf[6]=*(const __attribute__((address_space(3))) bf16x8*)(kp+6144); kf[7]=*(const __attribute__((address_space(3))) bf16x8*)(kp+6656);
}
__device__ __forceinline__ void kload2(bf16x8*kf,lds_cptr kp,int j){ kf[2*j]=*(const __attribute__((address_space(3))) bf16x8*)(kp+j*2048); kf[2*j+1]=*(const __attribute__((address_space(3))) bf16x8*)(kp+j*2048+512); }
__device__ __forceinline__ s16x4 vtr(lds_cptr p){ return __builtin_bit_cast(s16x4,__builtin_amdgcn_ds_read_tr16_b64_v4i16((__attribute__((address_space(3))) v4i16_t*)p)); }
__device__ __forceinline__ float rowmax(const f32x16&p0,const f32x16&p1){
  float a=max3f(p0[0],p0[1],p1[0]),b=max3f(p0[2],p0[3],p1[1]);a=max3f(a,p1[2],p1[3]);
  #pragma unroll
  for(int r=4;r<16;r+=4){a=max3f(a,p0[r],p0[r+1]);b=max3f(b,p0[r+2],p0[r+3]);a=max3f(a,p1[r],p1[r+1]);b=max3f(b,p1[r+2],p1[r+3]);}
  const float m=max2f(a,b);
  auto rr=__builtin_amdgcn_permlane32_swap(__float_as_uint(m),__float_as_uint(m),false,false);
  return max2f(__uint_as_float(rr[0]),__uint_as_float(rr[1]));
}
__device__ __forceinline__ void pv(f32x16*o,int vb,bf16x8 pa0,bf16x8 pa1,bf16x8 pa2,bf16x8 pa3){
  #pragma unroll
  for(int d0=0;d0<2;++d0){s16x4 lo[4],hi[4];
    #pragma unroll
    for(int ks=0;ks<4;++ks){
      asm volatile("ds_read_b64_tr_b16 %0,%1 offset:%c2":"=&v"(lo[ks]):"v"(vb),"i"(d0*4096+ks*1024):"memory");
      asm volatile("ds_read_b64_tr_b16 %0,%1 offset:%c2":"=&v"(hi[ks]):"v"(vb),"i"(d0*4096+ks*1024+512):"memory");}
    asm volatile("s_waitcnt lgkmcnt(0)":::"memory");SBAR();
    #define PK(k) (bf16x8){lo[k][0],lo[k][1],lo[k][2],lo[k][3],hi[k][0],hi[k][1],hi[k][2],hi[k][3]}
    o[d0]=__builtin_amdgcn_mfma_f32_32x32x16_bf16(pa0,PK(0),o[d0],0,0,0);
    o[d0]=__builtin_amdgcn_mfma_f32_32x32x16_bf16(pa1,PK(1),o[d0],0,0,0);
    o[d0]=__builtin_amdgcn_mfma_f32_32x32x16_bf16(pa2,PK(2),o[d0],0,0,0);
    o[d0]=__builtin_amdgcn_mfma_f32_32x32x16_bf16(pa3,PK(3),o[d0],0,0,0);
    #undef PK
  }
}

#ifndef ATTN_STORE16
#define ATTN_STORE16(p,v) (*(u32x4*)(p)=(v))
#endif
template<int THRL> __device__ __forceinline__ void attn_unit(const bf16*Qu,const bf16*__restrict__ Kh,const bf16*__restrict__ Vh,bf16*Ou,const int NT,char*shm){
  const int tid=threadIdx.x,lane=tid&63,r32=lane&31,hi=lane>>5; const int wid=__builtin_amdgcn_readfirstlane(tid>>6);
  const bf16*Qw=Qu+(long)(wid*QBLK)*QP;
  const unsigned lds0=(unsigned)(uintptr_t)shm;
  float*wsf=(float*)(shm+LDS_WS)+wid*64;
  const bf16*ksrc=Kh+(long)lane*QP+wid*8;
  const bf16*vsrc=Vh+(long)(16*(wid&3)+(lane>>2))*QP+(wid>>2)*32+(lane&3)*8;
  const unsigned kdst=lds0+LDS_K+wid*1024, vdst=lds0+LDS_V+wid*1024;
  #define DMA_K(t,slot) glds16(ksrc+(long)(t)*KVBLK*QP,(unsigned)__builtin_amdgcn_readfirstlane(kdst+(slot)))
  #define DMA_V(t,slot) glds16(vsrc+(long)(t)*KVBLK*QP,(unsigned)__builtin_amdgcn_readfirstlane(vdst+(slot)))
  const int vb0=(int)(lds0+LDS_V)+((lane>>4)&1)*32+(lane&3)*8+(4*hi+((lane&15)>>2))*64;
  const char*Kbase=shm+LDS_K; bf16x8 kf[8];
  const lds_cptr shm3=(lds_cptr)shm; const lds_cptr kp0=shm3+LDS_K+hi*1024+r32*16; const lds_cptr vp0=shm3+LDS_V+((lane>>4)&1)*32+(lane&3)*8+(4*hi+((lane&15)>>2))*64;
  DMA_K(0,0);DMA_V(0,0);DMA_K(1,SLOTB);
  bf16x8 qr[4];
  #pragma unroll
  for(int d0=0;d0<4;++d0)qr[d0]=*reinterpret_cast<const bf16x8*>(&Qw[(long)r32*QP+d0*16+hi*8]);
  float mhat=0.f,l_reg=0.f;f32x16 o[2];o[0]=f32x16{};o[1]=f32x16{};f32x16 negm=f32x16{};asm volatile("":"+v"(negm));
  #define CMASK(P0,P1,t) do{}while(0)
  bool resc=false;
  #define START(P0,P1) do{ const float rm=rowmax(P0,P1); resc=false; \
    { const float dl=rm; mhat=fadd_s(mhat,dl); \
      _Pragma("unroll") for(int r=0;r<16;++r){P0[r]=fsub_s(P0[r],dl);P1[r]=fsub_s(P1[r],dl);} \
      _Pragma("unroll") for(int r=0;r<16;++r)negm[r]=-mhat; asm volatile("":"+v"(negm)); } \
    _Pragma("unroll") for(int r=0;r<16;++r)P0[r]=__builtin_amdgcn_exp2f(P0[r]); }while(0)
  #define RESC() do{ if(resc){ asm volatile("s_waitcnt lgkmcnt(0)":::"memory"); \
      _Pragma("unroll") for(int d_=0;d_<2;++d_) _Pragma("unroll") for(int r=0;r<16;++r)o[d_][r]*=wsf[crow(r,hi)]; } }while(0)
  f32x16 pA0,pA1,pB0,pB1;
  int sl_prev=0,sl_cur=0,sl_next=SLOTB;
  #define ROT() do{sl_prev=sl_cur;sl_cur=sl_next;sl_next=(sl_next==(NSLOT-1)*SLOTB)?0:sl_next+SLOTB;}while(0)
  DMA_K(2,2*SLOTB);
  WAIT_BAR(3);
  qkt(pA0,pA1,Kbase,qr,negm,r32,hi);asm volatile("s_nop 15\n\ts_nop 7":"+v"(pA0),"+v"(pA1));CMASK(pA0,pA1,0);
  START(pA0,pA1);
  _Pragma("unroll") for(int r=0;r<16;++r)pA1[r]=__builtin_amdgcn_exp2f(pA1[r]);
  WAIT_BAR(0);
  DMA_K(3,0);DMA_V(1,SLOTB);
  ROT();
  kload8(kf,kp0+sl_cur);
  WAIT_BAR(2);
  s16x4 vlo[8],vhi[8]; u32x4 pw0,pw1,pw2,pw3;
  #define PKW(P,B) cvtpk_s(P[B],P[B+1])
  #define PAF(k) __builtin_bit_cast(bf16x8,pw##k)
  #define VFR(i) (bf16x8){vlo[i][0],vlo[i][1],vlo[i][2],vlo[i][3],vhi[i][0],vhi[i][1],vhi[i][2],vhi[i][3]}
  #define PIN(x) asm volatile("":"+v"(x))
  #define MX3(a,b,c) __builtin_fmaxf(__builtin_fmaxf((a),(b)),(c))
  #define GAPA(MF,A0,A1,A2,A3,W0,W1,PW) do{ MF; sacc+=A0; sacc+=A1; sacc+=A2; sacc+=A3; PIN(sacc); W0; W1; PIN(PW); SBAR(); }while(0)
  #define EX(v) __builtin_amdgcn_exp2f(v)
  #define GAPB(MF,X,B) do{ MF; X[B]=EX(X[B]); X[B+1]=EX(X[B+1]); X[B+2]=EX(X[B+2]); X[B+3]=EX(X[B+3]); PIN(X); SBAR(); }while(0)
  #define VRD(i) do{ vlo[i]=vtr(vp_+(((i)>>2)*4096+((i)&3)*1024)); vhi[i]=vtr(vp_+(((i)>>2)*4096+((i)&3)*1024+512)); }while(0)
  #define KRD(G,j) do{ if(G){ kload2(kf,kp0+sl_next,j); SBAR(); } }while(0)
  #define STEP(C0,C1,P0,P1,t,GK,GV,GL) do{ SBAR(); \
    const lds_cptr vp_=vp0+sl_prev; \
    VRD(0); SBAR(); float sacc=(P0[0]+P0[1]); \
    GAPA(C0=__builtin_amdgcn_mfma_f32_32x32x16_bf16(kf[0],qr[0],negm,0,0,0), P0[2],P0[3],P0[4],P0[5],     pw0[0]=PKW(P0,0), pw0[1]=PKW(P0,2), pw0); \
    VRD(4); SBAR(); GAPA(C1=__builtin_amdgcn_mfma_f32_32x32x16_bf16(kf[1],qr[0],negm,0,0,0), P0[6],P0[7],P0[8],P0[9],     pw0[2]=PKW(P0,4), pw0[3]=PKW(P0,6), pw0); \
    VRD(1); SBAR(); GAPA(C0=__builtin_amdgcn_mfma_f32_32x32x16_bf16(kf[2],qr[1],C0,0,0,0),   P0[10],P0[11],P0[12],P0[13], pw1[0]=PKW(P0,8), pw1[1]=PKW(P0,10), pw1); \
    VRD(5); SBAR(); GAPA(C1=__builtin_amdgcn_mfma_f32_32x32x16_bf16(kf[3],qr[1],C1,0,0,0),   P0[14],P0[15],P1[0],P1[1],   pw1[2]=PKW(P0,12),pw1[3]=PKW(P0,14), pw1); \
    VRD(2); SBAR(); GAPA(C0=__builtin_amdgcn_mfma_f32_32x32x16_bf16(kf[4],qr[2],C0,0,0,0),   P1[2],P1[3],P1[4],P1[5],     pw2[0]=PKW(P1,0), pw2[1]=PKW(P1,2), pw2); \
    VRD(6); SBAR(); GAPA(C1=__builtin_amdgcn_mfma_f32_32x32x16_bf16(kf[5],qr[2],C1,0,0,0),   P1[6],P1[7],P1[8],P1[9],     pw2[2]=PKW(P1,4), pw2[3]=PKW(P1,6), pw2); \
    VRD(3); SBAR(); GAPA(C0=__builtin_amdgcn_mfma_f32_32x32x16_bf16(kf[6],qr[3],C0,0,0,0),   P1[10],P1[11],P1[12],P1[13], pw3[0]=PKW(P1,8), pw3[1]=PKW(P1,10), pw3); \
    VRD(7); SBAR(); GAPA(C1=__builtin_amdgcn_mfma_f32_32x32x16_bf16(kf[7],qr[3],C1,0,0,0),   P1[14],P1[15],0.f,0.f,       pw3[2]=PKW(P1,12),pw3[3]=PKW(P1,14), pw3); \
    l_reg+=sacc; \
    if(GK){DMA_K((t)+3,sl_cur);} if(GV){DMA_V((t)+1,sl_next);} \
    CMASK(C0,C1,t); \
    { float a=MX3(C0[0],C0[1],C1[0]),b=MX3(C0[2],C0[3],C1[1]); a=MX3(a,C1[2],C1[3]); \
      _Pragma("unroll") for(int r=4;r<16;r+=4){a=MX3(a,C0[r],C0[r+1]);b=MX3(b,C0[r+2],C0[r+3]);a=MX3(a,C1[r],C1[r+1]);b=MX3(b,C1[r+2],C1[r+3]);} \
      float rm=__builtin_fmaxf(a,b); { auto rr=__builtin_amdgcn_permlane32_swap(__float_as_uint(rm),__float_as_uint(rm),false,false); rm=__builtin_fmaxf(__uint_as_float(rr[0]),__uint_as_float(rr[1])); } \
      resc=false; \
      if(__builtin_expect(__any(rm>(float)THRL),0)){ const float dl=__builtin_fmaxf(rm,0.f); mhat+=dl; \
        _Pragma("unroll") for(int r=0;r<16;++r){C0[r]-=dl;C1[r]-=dl;} \
        _Pragma("unroll") for(int r=0;r<16;++r)negm[r]=-mhat; asm volatile("":"+v"(negm)); \
        const float f=__builtin_amdgcn_exp2f(-dl); l_reg*=f; if(hi==0)wsf[r32]=f; resc=true; } } \
    SBAR(); \
    GAPB(o[0]=__builtin_amdgcn_mfma_f32_32x32x16_bf16(PAF(0),VFR(0),o[0],0,0,0), C0,0); \
    GAPB(o[1]=__builtin_amdgcn_mfma_f32_32x32x16_bf16(PAF(0),VFR(4),o[1],0,0,0), C0,4); \
    KRD(GL,0); GAPB(o[0]=__builtin_amdgcn_mfma_f32_32x32x16_bf16(PAF(1),VFR(1),o[0],0,0,0), C0,8); \
    KRD(GL,1); GAPB(o[1]=__builtin_amdgcn_mfma_f32_32x32x16_bf16(PAF(1),VFR(5),o[1],0,0,0), C0,12); \
    KRD(GL,2); GAPB(o[0]=__builtin_amdgcn_mfma_f32_32x32x16_bf16(PAF(2),VFR(2),o[0],0,0,0), C1,0); \
    KRD(GL,3); GAPB(o[1]=__builtin_amdgcn_mfma_f32_32x32x16_bf16(PAF(2),VFR(6),o[1],0,0,0), C1,4); \
    GAPB(o[0]=__builtin_amdgcn_mfma_f32_32x32x16_bf16(PAF(3),VFR(3),o[0],0,0,0), C1,8); \
    GAPB(o[1]=__builtin_amdgcn_mfma_f32_32x32x16_bf16(PAF(3),VFR(7),o[1],0,0,0), C1,12); \
    }while(0)
  int t=1;
  for(;t+5<NT;t+=2){
    STEP(pB0,pB1,pA0,pA1,t,true,true,true);     WAIT_BAR(2); RESC(); ROT();
    STEP(pA0,pA1,pB0,pB1,t+1,true,true,true);   WAIT_BAR(2); RESC(); ROT();
  }
  #define ENDW(tt) do{ if((tt)+3<NT){WAIT_BAR(2);} else if((tt)+2<NT){WAIT_BAR(1);} else {WAIT_BAR(0);} }while(0)
  for(;t+1<NT;t+=2){
    STEP(pB0,pB1,pA0,pA1,t,(t+3<NT),(t+1<NT),(t+1<NT));       ENDW(t);   RESC(); ROT();
    STEP(pA0,pA1,pB0,pB1,t+1,(t+4<NT),(t+2<NT),(t+2<NT));     ENDW(t+1); RESC(); ROT();
  }
  STEP(pB0,pB1,pA0,pA1,NT-1,false,false,false); RESC();
  { float sacc=pB0[0]+pB0[1]; _Pragma("unroll") for(int r=2;r<16;++r)sacc+=pB0[r]; _Pragma("unroll") for(int r=0;r<16;++r)sacc+=pB1[r]; l_reg+=sacc;
    pw0=(u32x4){PKW(pB0,0),PKW(pB0,2),PKW(pB0,4),PKW(pB0,6)};pw1=(u32x4){PKW(pB0,8),PKW(pB0,10),PKW(pB0,12),PKW(pB0,14)};pw2=(u32x4){PKW(pB1,0),PKW(pB1,2),PKW(pB1,4),PKW(pB1,6)};pw3=(u32x4){PKW(pB1,8),PKW(pB1,10),PKW(pB1,12),PKW(pB1,14)};
    SBAR(); pv(o,vb0+sl_cur,PAF(0),PAF(1),PAF(2),PAF(3)); }
  #undef PKW
  #undef PAF
  #undef VFR
  #undef PIN
  #undef MX3
  #undef GAPA
  #undef GAPB
  #undef EX
  #undef VRD
  #undef KRD
  #undef STEP
  #undef ENDW
  {auto rr=__builtin_amdgcn_permlane32_swap(__float_as_uint(l_reg),__float_as_uint(l_reg),false,false);l_reg=__uint_as_float(rr[0])+__uint_as_float(rr[1]);}
  if(hi==0)wsf[32+r32]=l_reg;asm volatile("s_waitcnt lgkmcnt(0)":::"memory");
  float rli[16];
  #pragma unroll
  for(int r=0;r<16;++r)rli[r]=__builtin_amdgcn_rcpf(wsf[32+crow(r,hi)]);
  bf16*Ow=Ou+(long)(wid*QBLK)*OP;
  { bf16*stg=(bf16*)(shm+LDS_OST)+wid*2048;
    #pragma unroll
    for(int r=0;r<16;++r){const int orow=crow(r,hi);
      #pragma unroll
      for(int d0=0;d0<2;++d0)stg[orow*64+d0*32+r32]=__float2bfloat16(o[d0][r]*rli[r]);}
    asm volatile("s_waitcnt lgkmcnt(0)":::"memory");
    #pragma unroll
    for(int i=0;i<4;++i){const int row=i*8+(lane>>3),ch=lane&7; const u32x4 v=*(const u32x4*)(stg+row*64+ch*8); ATTN_STORE16(Ow+(long)row*OP+ch*8,v);} }
  asm volatile("s_waitcnt lgkmcnt(0)\n\ts_barrier":::"memory");
  #undef DMA_K
  #undef DMA_V
  #undef CMASK
  #undef START
  #undef RESC
  #undef ROT
}
constexpr int ATTN_LDS_BYTES=LDS_BYTES;
#undef SBAR
#undef WAIT_BAR
}

__device__ __forceinline__ void attn_phase(const Frame& F, int l) {
    typedef attn_body::bf16 abf;
    const abf* U = (const abf*)(F.ws + WS_AR + AR_U); abf* MIX = (abf*)(F.ws + WS_AR + AR_MIX);
    char* shm = (char*)F.lds;
    for (int u = F.bid; u < 512; u += F.G) {
        const int pair = u & 7, j = u >> 3, b = pair >> 1, kvh = pair & 1, h = kvh * 4 + (j >> 4), qb = j & 15;
        const size_t r0 = (size_t)b * SB, q0 = r0 + CT + (size_t)qb * 256;
        attn_body::attn_unit<8>(U + q0 * NINP + h * 64, U + r0 * NINP + K_OFF + kvh * 64, U + r0 * NINP + V_OFF + kvh * 64, MIX + q0 * D + h * 64, SB / 64, shm);
    }
    if (l + 1 < NL) {
        for (int u = F.bid; u < 32; u += F.G) {
            const int pair = u & 7, b = pair >> 1, kvh = pair & 1, h = kvh * 4 + (u >> 3);
            const size_t r0 = (size_t)b * SB;
            attn_body::attn_unit<8>(U + r0 * NINP + h * 64, U + r0 * NINP + K_OFF + kvh * 64, U + r0 * NINP + V_OFF + kvh * 64, MIX + r0 * D + h * 64, CT / 64, shm);
        }
    }
}

constexpr int SC_STEP_F = 352, SC_CH = 32, SC_BUF_F = SC_CH * SC_STEP_F  , SC_OUT_OFF = 2 * SC_BUF_F * 4  ;
__device__ __forceinline__ float dpp_add(float x, float y_) { return x + y_; }
#define DPP_F(x, ctrl) __builtin_bit_cast(float, __builtin_amdgcn_update_dpp(0, __builtin_bit_cast(int, (x)), (ctrl), 0xF, 0xF, true))
__device__ __forceinline__ float red16(float x) {
    x += DPP_F(x, 0xB1);
    x += DPP_F(x, 0x4E);
    x += DPP_F(x, 0x141);
    x += DPP_F(x, 0x140);
    return x;
}
__device__ __forceinline__ int scan_row(int s, int dir) { return s < CT ? (dir ? CT - 1 - s : s) : (dir ? CT + (TL - 1 - (s - CT)) : s); }
__device__ __forceinline__ void scan_task(const Frame& F, int task) {
    const int x = task & 7, t = task >> 3, bh = 2 * x + (t >> 2), b = bh >> 2, h = bh & 3, dir = (t >> 1) & 1, half = t & 1;
    const size_t rb = (size_t)b * SB, dofs = (size_t)dir * M * 256;
    const int col0 = h * 64;
    const float* Wg = (const float*)(F.ws + WS_AR + AR_W) + dofs;
    const bf16* KKg = (const bf16*)(F.ws + WS_AR + AR_KK); const bf16* KKAg = (const bf16*)(F.ws + WS_AR + AR_KKA) + dofs; const bf16* KEg = (const bf16*)(F.ws + WS_AR + AR_KE) + dofs;
    const bf16* Rg = (const bf16*)(F.ws + WS_AR + AR_R); const bf16* Vg = (const bf16*)(F.ws + WS_AR + AR_V);
    float* Yg = (float*)(F.ws + WS_AR + AR_Y) + dofs;
    LAS float* ring = (LAS float*)F.lds; LAS float* outb = (LAS float*)(F.lds + SC_OUT_OFF);
    constexpr int NCH = SB / SC_CH;
    const bool loader = F.wave >= 4;
    const int lt = F.tid - 256;
    auto load_chunk = [&](int c) {
        LAS float* dst = ring + (c & 1) * SC_BUF_F;
#pragma unroll
        for (int q2 = 0; q2 < 2; ++q2) { const int q = lt + 256 * q2, st = q >> 4, k4 = (q & 15) * 4; const size_t g = (rb + scan_row(c * SC_CH + st, dir)) * 256 + col0 + k4;
            const f32x4 wv = *(const f32x4*)(Wg + g);
            const v2u a1 = *(const v2u*)(KKg + g), a2 = *(const v2u*)(KKAg + g), a3 = *(const v2u*)(KEg + g), a4 = *(const v2u*)(Rg + g);
            LAS float* d = dst + st * SC_STEP_F + k4;
            *(LAS f32x4*)(d) = wv;
            *(LAS f32x4*)(d + 64) = (f32x4){bflo(a1.x), bfhi(a1.x), bflo(a1.y), bfhi(a1.y)};
            *(LAS f32x4*)(d + 128) = (f32x4){bflo(a2.x), bfhi(a2.x), bflo(a2.y), bfhi(a2.y)};
            *(LAS f32x4*)(d + 192) = (f32x4){bflo(a3.x), bfhi(a3.x), bflo(a3.y), bfhi(a3.y)};
            *(LAS f32x4*)(d + 256) = (f32x4){bflo(a4.x), bfhi(a4.x), bflo(a4.y), bfhi(a4.y)}; }
        { const int st = lt >> 3, r4 = (lt & 7) * 4; const size_t g = (rb + scan_row(c * SC_CH + st, dir)) * 256 + col0 + half * 32 + r4;
            const v2u a = *(const v2u*)(Vg + g);
            *(LAS f32x4*)(dst + st * SC_STEP_F + 320 + r4) = (f32x4){bflo(a.x), bfhi(a.x), bflo(a.y), bfhi(a.y)}; }
    };
    auto flush_chunk = [&](int c) {
        const LAS float* src = outb + (c & 1) * (SC_CH * 32);
        const int st = lt >> 3, r4 = (lt & 7) * 4;
        const f32x4 v = *(const LAS f32x4*)(src + st * 32 + r4);
        *(f32x4*)(Yg + (rb + scan_row(c * SC_CH + st, dir)) * 256 + col0 + half * 32 + r4) = v;
    };
    if (loader) load_chunk(0);
    __syncthreads();
    const int i = (F.lane >> 4), j = F.lane & 15, wv = F.wave;
    float S0[4] = {0.f, 0.f, 0.f, 0.f}, S1[4] = {0.f, 0.f, 0.f, 0.f};
    for (int c = 0; c < NCH; ++c) {
        if (loader) {
            if (c + 1 < NCH) load_chunk(c + 1);
            if (c >= 1) flush_chunk(c - 1);
        } else {
            const LAS float* base = ring + (c & 1) * SC_BUF_F + 4 * j;
            LAS float* ob = outb + (c & 1) * (SC_CH * 32) + wv * 8 + 2 * i;
#pragma unroll 8
            for (int s = 0; s < SC_CH; ++s) {
                const LAS float* p = base + s * SC_STEP_F;
                const f32x4 w4 = *(const LAS f32x4*)(p), kk4 = *(const LAS f32x4*)(p + 64), ka4 = *(const LAS f32x4*)(p + 128), ke4 = *(const LAS f32x4*)(p + 192), r4 = *(const LAS f32x4*)(p + 256);
                const float v0 = p[320 - 4 * j + wv * 8 + 2 * i], v1 = p[320 - 4 * j + wv * 8 + 2 * i + 1];
                float sa0 = S0[0] * kk4[0], sa1 = S1[0] * kk4[0];
#pragma unroll
                for (int e = 1; e < 4; ++e) { sa0 += S0[e] * kk4[e]; sa1 += S1[e] * kk4[e]; }
                sa0 = red16(sa0); sa1 = red16(sa1);
                float y0 = 0.f, y1 = 0.f;
#pragma unroll
                for (int e = 0; e < 4; ++e) {
                    S0[e] = S0[e] * w4[e] + (v0 * ke4[e] - sa0 * ka4[e]);
                    S1[e] = S1[e] * w4[e] + (v1 * ke4[e] - sa1 * ka4[e]);
                    y0 += S0[e] * r4[e]; y1 += S1[e] * r4[e];
                }
                y0 = red16(y0); y1 = red16(y1);
                if (j == 0) { ob[s * 32] = y0; ob[s * 32 + 1] = y1; }
            }
        }
        __syncthreads();
    }
    if (loader) flush_chunk(NCH - 1);
    __syncthreads();
}

__device__ __forceinline__ void mixer_phase(const Frame& F, int l) {
    const int g = F.bid >> 3;
    if (F.G == 256 && (g & 3) == 3) { scan_task(F, (g >> 2) * 8 + (F.bid & 7)); return; }
    typedef attn_body::bf16 abf;
    const abf* U = (const abf*)(F.ws + WS_AR + AR_U); abf* MIX = (abf*)(F.ws + WS_AR + AR_MIX);
    char* shm = (char*)F.lds;
    const int pair = F.bid & 7, b = pair >> 1, kvh = pair & 1;
    const size_t r0 = (size_t)b * SB;
    const int a = g - (g >> 2);
    for (int jj = a; jj < 64; jj += 24) {
        const int h = kvh * 4 + (jj >> 4), qb = jj & 15;
        const size_t q0 = r0 + CT + (size_t)qb * 256;
        attn_body::attn_unit<8>(U + q0 * NINP + h * 64, U + r0 * NINP + K_OFF + kvh * 64, U + r0 * NINP + V_OFF + kvh * 64, MIX + q0 * D + h * 64, SB / 64, shm);
    }
    if (l + 1 < NL && a >= 20) {
        const int h = kvh * 4 + (a - 20);
        attn_body::attn_unit<8>(U + r0 * NINP + h * 64, U + r0 * NINP + K_OFF + kvh * 64, U + r0 * NINP + V_OFF + kvh * 64, MIX + r0 * D + h * 64, CT / 64, shm);
    }
}

__global__ void __launch_bounds__(128) k_attn_simple(const bf16* __restrict__ U, bf16* __restrict__ MIX) {
    __shared__ float Ks[64][64];
    __shared__ float Vs[64][64];
    const int qb = blockIdx.x % 34, b = blockIdx.x / 34, h = blockIdx.y, kvh = h >> 2, tid = threadIdx.x;
    const size_t rb = (size_t)b * SB;
    const int row = qb * 128 + tid;
    const int nk = (qb < 2) ? CT : SB;
    float q[64], o[64];
#pragma unroll
    for (int d = 0; d < 64; ++d) { q[d] = bf2f(U[(rb + row) * NINP + h * 64 + d]); o[d] = 0.f; }
    float m = -1e30f, l = 0.f;
    for (int k0 = 0; k0 < nk; k0 += 64) {
        __syncthreads();
        for (int i = tid; i < 64 * 64; i += 128) { const int j = i >> 6, d = i & 63;
            Ks[j][d] = bf2f(U[(rb + k0 + j) * NINP + K_OFF + kvh * 64 + d]);
            Vs[j][d] = bf2f(U[(rb + k0 + j) * NINP + V_OFF + kvh * 64 + d]); }
        __syncthreads();
        for (int j = 0; j < 64; ++j) {
            float s = 0.f;
#pragma unroll
            for (int d = 0; d < 64; ++d) s += q[d] * Ks[j][d];
            const float mn = fmaxf(m, s);
            const float corr = exp2f(m - mn), p = exp2f(s - mn);
            l = l * corr + p; m = mn;
#pragma unroll
            for (int d = 0; d < 64; ++d) o[d] = o[d] * corr + p * Vs[j][d];
        }
    }
    const float il = 1.f / l;
#pragma unroll
    for (int d = 0; d < 64; ++d) MIX[(rb + row) * D + h * 64 + d] = (bf16)f2bf(o[d] * il);
}

__global__ void __launch_bounds__(64) k_scan_simple(const bf16* __restrict__ r_i, const bf16* __restrict__ v_i, const bf16* __restrict__ kk_i,
                                                    const float* __restrict__ w_i, const bf16* __restrict__ ke_i, const bf16* __restrict__ kka_i, float* __restrict__ y_o) {
    __shared__ float sh[16][5][64];
    __shared__ float sv[16][64];
    const int h = blockIdx.x, dir = blockIdx.y, b = blockIdx.z, v = threadIdx.x;
    const size_t dofs = (size_t)dir * M * 256;
    float S[64];
#pragma unroll
    for (int k = 0; k < 64; ++k) S[k] = 0.f;
    for (int s0 = 0; s0 < SB; s0 += 16) {
        __syncthreads();
#pragma unroll
        for (int i = 0; i < 16; ++i) {
            const int s = s0 + i;
            const int sr = s < CT ? (dir == 0 ? s : CT - 1 - s) : (dir == 0 ? s : CT + (TL - 1 - (s - CT)));
            const size_t o = ((size_t)b * SB + sr) * 256 + h * 64 + v;
            sh[i][0][v] = w_i[dofs + o]; sh[i][1][v] = bf2f(kk_i[o]); sh[i][2][v] = bf2f(kka_i[dofs + o]); sh[i][3][v] = bf2f(ke_i[dofs + o]); sh[i][4][v] = bf2f(r_i[o]); sv[i][v] = bf2f(v_i[o]);
        }
        __syncthreads();
        for (int i = 0; i < 16; ++i) {
            const int s = s0 + i;
            const int sr = s < CT ? (dir == 0 ? s : CT - 1 - s) : (dir == 0 ? s : CT + (TL - 1 - (s - CT)));
            float sa = 0.f;
#pragma unroll
            for (int k = 0; k < 64; ++k) sa += S[k] * sh[i][1][k];
            const float vv = sv[i][v];
            float y = 0.f;
#pragma unroll
            for (int k = 0; k < 64; ++k) { S[k] = S[k] * sh[i][0][k] - sa * sh[i][2][k] + vv * sh[i][3][k]; y += S[k] * sh[i][4][k]; }
            y_o[dofs + ((size_t)b * SB + sr) * 256 + h * 64 + v] = y;
        }
    }
}

constexpr int NPHASE = 2 + 10 * NL;
#define PH_IN(k) (lo <= (k) && (k) < hi)
#define PH_SEAM(k) do { if (PH_IN(k) && PH_IN((k) + 1)) xcd_barrier(bar); } while (0)
template <int L> __device__ __forceinline__ void layer_phases(const Frame& F, const int lo, const int hi, const XcdBarrier& bar) {
    constexpr int pb = 2 + 10 * L;
    bf16* XN = (bf16*)(F.ws + WS_AR + AR_XN); bf16* U = (bf16*)(F.ws + WS_AR + AR_U); bf16* MIX = (bf16*)(F.ws + WS_AR + AR_MIX);
    float* MIXO = (float*)(F.ws + WS_AR + AR_MIXO); bf16* H = (bf16*)(F.ws + WS_AR + AR_H); bf16* ACT = (bf16*)(F.ws + WS_AR + AR_ACT); float* FO = (float*)(F.ws + WS_AR + AR_FO);
    bf16* t_in = (bf16*)(F.ws + WS_WIN); bf16* t_out = (bf16*)(F.ws + WS_WOUT); bf16* t_up = (bf16*)(F.ws + WS_WUP); bf16* t_dn = (bf16*)(F.ws + WS_WDN);
    if (PH_IN(pb + 0)) { pg8::Gemm g{XN, t_in, M, NINP, D}; pg8::StaticOrder S; S.init(M, NINP, F.G, F.bid);
        pg8::EpiBf16<0> E{U, NINP, nullptr, 0, 0, 1.f};
        pg8::gemm_phase<pg8::EpiBf16<0>, pg8::StaticOrder, true, true>(F.lds, g, S, E); }
    PH_SEAM(pb + 0);
    if (PH_IN(pb + 1)) prep_phase(F, L);
    PH_SEAM(pb + 1);
    if (PH_IN(pb + 2)) {
#if SCAN_FAST
        mixer_phase(F, L);
#elif ATTN_FAST
        attn_phase(F, L);
#endif
    }
    PH_SEAM(pb + 2);
    if (PH_IN(pb + 3)) rwkv_out_phase(F, L);
    PH_SEAM(pb + 3);
    if (PH_IN(pb + 4)) { pg8::Gemm g{MIX, t_out, M, D, D}; pg8::StaticOrder S; S.init(M, D, F.G, F.bid);
        pg8::EpiF32 E{MIXO, D, nullptr};
        pg8::gemm_phase<pg8::EpiF32, pg8::StaticOrder, true, true>(F.lds, g, S, E); }
    PH_SEAM(pb + 4);
    if (PH_IN(pb + 5)) norm_phase(F, 1, MIXO, INP(I_NMPOST) + L * D, L, 2, INP(I_NFPRE) + L * D, L, 3, 4);
    PH_SEAM(pb + 5);
    if (PH_IN(pb + 6)) { pg8::Gemm g{XN, t_up, M, DFF2, D}; pg8::StaticOrder S; S.init(M, DFF2, F.G, F.bid);
        pg8::EpiBf16<0> E{H, DFF2, nullptr, 0, 0, 1.f};
        pg8::gemm_phase<pg8::EpiBf16<0>, pg8::StaticOrder, true, true>(F.lds, g, S, E); }
    PH_SEAM(pb + 6);
    if (PH_IN(pb + 7)) act_phase(F, L);
    PH_SEAM(pb + 7);
    if (PH_IN(pb + 8)) { pg8::Gemm g{ACT, t_dn, M, D, DFF}; pg8::StaticOrder S; S.init(M, D, F.G, F.bid);
        pg8::EpiF32 E{FO, D, nullptr};
        pg8::gemm_phase<pg8::EpiF32, pg8::StaticOrder, true, true>(F.lds, g, S, E); }
    PH_SEAM(pb + 8);
    if (PH_IN(pb + 9)) {
        if (L + 1 < NL) { norm_phase(F, 1, FO, INP(I_NFPOST) + L * D, L, 5, INP(I_NMPRE) + (L + 1 < NL ? L + 1 : L) * D, L + 1, 0, 1); __syncthreads(); convert_weights(F, L + 1); }
        else norm_phase(F, 2, FO, INP(I_NFPOST) + L * D, L, 5, nullptr, 0, 0, 0);
    }
    if (L + 1 < NL) PH_SEAM(pb + 9);
}
__global__ void __launch_bounds__(NTHR, 2) mk_fwd(Args args) {
    extern __shared__ __attribute__((aligned(16))) unsigned char lds_raw[];
    Frame F;
    F.lds = (LAS unsigned char*)lds_raw;
    F.tid = threadIdx.x; F.lane = F.tid & 63; F.wave = __builtin_amdgcn_readfirstlane(F.tid >> 6);
    F.bid = blockIdx.x; F.G = gridDim.x; F.ws = args.ws; F.out = args.out;
    volatile LAS unsigned* MISC = (volatile LAS unsigned*)(F.lds + MISC_OFF);
    for (int u = F.tid; u < (LDS_BYTES - LDSCTL_OFF) / 4; u += NTHR) ((LAS unsigned*)(F.lds + LDSCTL_OFF))[u] = 0u;
    __syncthreads();
    if (F.tid == 0) {
#pragma unroll
        for (int i = 0; i < 29; ++i) ((unsigned long long LAS*)(F.lds + PTR_OFF))[i] = (unsigned long long)args.in[i];
    }
    __syncthreads();
    const int lo = args.ph_lo, hi = args.ph_hi;
    XcdBarrier bar; bar.bar = (unsigned*)(F.ws + WS_CTL) + CW_BAR; bar.x = 0; bar.st = nullptr;
    if (hi - lo > 1) bar = xcd_barrier_post((unsigned*)(F.ws + WS_CTL) + CW_BAR, MISC + 8);
    if (PH_IN(0)) phase_pro_a(F);
#if ONE_LAUNCH
    if (PH_IN(0) && PH_IN(1)) cg::this_grid().sync();
#else
    PH_SEAM(0);
#endif
    if (PH_IN(1)) norm_phase(F, 0, nullptr, nullptr, 0, 0, INP(I_NMPRE), 0, 0, 1);
    PH_SEAM(1);
    layer_phases<0>(F, lo, hi, bar);
    layer_phases<1>(F, lo, hi, bar);
    layer_phases<2>(F, lo, hi, bar);
    layer_phases<3>(F, lo, hi, bar);
}

extern "C" void kernel_launch(void* const* d_in, const int* in_sizes, int n_in, void* d_out, int out_size, void* d_ws, size_t ws_size, hipStream_t stream) {
    static int grid = 0;
    if (grid == 0) {
        if (n_in != 29 || ws_size < WS_END) { fprintf(stderr, "kernel_launch: unexpected n_in %d or ws %zu < %zu\n", n_in, ws_size, (size_t)WS_END); grid = -1; return; }
        int dev = 0, cus = 0, per_cu = 0;
        hipGetDevice(&dev); hipDeviceGetAttribute(&cus, hipDeviceAttributeMultiprocessorCount, dev);
        hipFuncSetAttribute((const void*)mk_fwd, hipFuncAttributeMaxDynamicSharedMemorySize, LDS_BYTES);
        hipOccupancyMaxActiveBlocksPerMultiprocessor(&per_cu, (const void*)mk_fwd, NTHR, LDS_BYTES);
        if (per_cu < 1) { fprintf(stderr, "kernel_launch: occupancy query says %d blocks per CU\n", per_cu); grid = -1; return; }
        grid = cus;
    }
    if (grid < 0) return;
    hipMemsetAsync((char*)d_ws + WS_CTL, 0, CTL_ZERO_BYTES, stream);
    Args a{};
    for (int i = 0; i < 29; ++i) a.in[i] = (const float*)d_in[i];
    a.out = (float*)d_out; a.ws = (unsigned char*)d_ws;
    unsigned char* ws = (unsigned char*)d_ws;
    auto launch = [&](int lo, int hi) { a.ph_lo = lo; a.ph_hi = hi; hipLaunchKernelGGL(mk_fwd, dim3(grid), dim3(NTHR), LDS_BYTES, stream, a); };
#if ONE_LAUNCH
    { a.ph_lo = 0; a.ph_hi = NPHASE; void* kargs[] = {&a};
      hipLaunchCooperativeKernel((const void*)mk_fwd, dim3(grid), dim3(NTHR), kargs, LDS_BYTES, stream); }
#else
    launch(0, 1); launch(1, 2);
    for (int l = 0; l < NL; ++l) {
        const int pb = 2 + 10 * l;
        launch(pb, pb + 1); launch(pb + 1, pb + 2);
#if ATTN_FAST
        launch(pb + 2, pb + 3);
#else
        k_attn_simple<<<dim3(34 * NB, 8), 128, 0, stream>>>((const bf16*)(ws + WS_AR + AR_U), (bf16*)(ws + WS_AR + AR_MIX));
#endif
#if !SCAN_FAST
        k_scan_simple<<<dim3(4, 2, NB), 64, 0, stream>>>((const bf16*)(ws + WS_AR + AR_R), (const bf16*)(ws + WS_AR + AR_V), (const bf16*)(ws + WS_AR + AR_KK),
                                                       (const float*)(ws + WS_AR + AR_W), (const bf16*)(ws + WS_AR + AR_KE), (const bf16*)(ws + WS_AR + AR_KKA), (float*)(ws + WS_AR + AR_Y));
#endif
        for (int p = 3; p < 10; ++p) launch(pb + p, pb + p + 1);
    }
#endif
}
```

```cpp
#include <hip/hip_runtime.h>
#include <hip/hip_bf16.h>
#include <hip/hip_cooperative_groups.h>
#include <cstdio>
#include <cstdint>
#include <math.h>
namespace cg = cooperative_groups;

namespace pg8 {
#define PG8_LAS __attribute__((address_space(3)))
typedef unsigned short bf16_t;
typedef short bf16x8 __attribute__((ext_vector_type(8)));
typedef float f32x4 __attribute__((ext_vector_type(4)));
typedef unsigned u32x4 __attribute__((ext_vector_type(4)));
constexpr int BM = 256, BK = 64, HALF = 128, HTB = HALF * BK * 2  , STAGE_BYTES = 8 * HTB, NXCD = 8, WGM = 8;

__host__ __device__ __forceinline__ int lds_byte(int r, int c) { const int st = (r >> 4) * 2 + (c >> 5), rr = r & 15, cc = c & 31, ob = rr * 64 + cc * 2; return st * 1024 + (ob ^ (((ob >> 9) & 1) << 5)); }
__host__ __device__ __forceinline__ void stage_rc(int b, int& R, int& C) { const int st = b / 1024, sb = b % 1024, swz = sb ^ (((sb >> 9) & 1) << 5); R = (st >> 1) * 16 + swz / 64; C = (st & 1) * 32 + (swz % 64) / 2; }
__host__ __device__ __forceinline__ int perm32(int rho) { const int n = rho >> 4, i = rho & 15; return 8 * (i >> 2) + 4 * n + (i & 3); }

struct Unit { int pm, pn, k0t, nt, slot; };
struct Gemm { const bf16_t* A; const bf16_t* Bt; int M, N, K; };

struct StaticOrder {
    int nM, nN, nwg, G, c, ntk;
    __host__ __device__ void init(int M, int N, int G_, int c_, int K_ = 0) { nM = M / BM; nN = N / BM; nwg = nM * nN; G = G_; c = c_; ntk = K_ / BK; }
    __host__ __device__ bool next(int i, Unit& u) const {
        const long L = (long)i * G + c; if (L >= nwg) return false;
        int wgid = (int)L; { const int q = nwg / NXCD, r = nwg % NXCD, xcd = wgid % NXCD, off = wgid / NXCD; wgid = (xcd < r ? xcd * (q + 1) : r * (q + 1) + (xcd - r) * q) + off; }
        const int nig = WGM * nN, gid = wgid / nig, fm = gid * WGM, gsz = (nM - fm) < WGM ? (nM - fm) : WGM;
        u.pm = fm + ((wgid % nig) % gsz); u.pn = (wgid % nig) / gsz; u.k0t = 0; u.nt = ntk; u.slot = -1; return true;
    }
    __device__ __forceinline__ void a_ready(const Unit&) const {}
    __device__ __forceinline__ void done(const Unit&) const {}
};

__device__ __forceinline__ unsigned cvt_pk_bf16(float lo, float hi) { unsigned r; asm volatile("v_cvt_pk_bf16_f32 %0, %1, %2" : "=v"(r) : "v"(lo), "v"(hi)); return r; }
typedef float f32x2 __attribute__((ext_vector_type(2)));
__device__ __forceinline__ f32x2 gelu_pk(f32x2 v) {
    const f32x2 av = __builtin_elementwise_abs(v), d = av * 0.2316418882f + 1.0f;
    f32x2 t; t.x = __builtin_amdgcn_rcpf(d.x); t.y = __builtin_amdgcn_rcpf(d.y);
    f32x2 q = t * 0.5307027145f + (-0.7265760135f); q = q * t + 0.7107068705f; q = q * t + (-0.142248368f); q = q * t + 0.127414796f; q = q * t;
    const f32x2 s = (v * v) * (-0.72134752044f);
    f32x2 e; e.x = __builtin_amdgcn_exp2f(s.x); e.y = __builtin_amdgcn_exp2f(s.y);
    const f32x2 m = v * (q * e), r = v - m;
    f32x2 o; o.x = v.x < 0.f ? m.x : r.x; o.y = v.y < 0.f ? m.y : r.y; return o;
}

template <int ACT  > struct EpiBf16 {
    static constexpr bool PERM = true, AFTER_DRAIN = false; static_assert(ACT == 0 || ACT == 1, "EpiBf16: ACT is 0 (none) or 1 (gelu_pk)");
    bf16_t* O; int ldc; const float* bias; int split_cols; size_t split_stride; float scale0;
    __device__ __forceinline__ void operator()(const f32x4 (&acc)[2][2][4][2], const Unit& u, int wr, int wc, int fr, int fq) const {
        const int row0 = u.pm * BM + wr * 64 + fr; int colt = u.pn * BM; bf16_t* base = O;
        float sc = 1.f; if (split_cols) { const int t = colt / split_cols; base += (size_t)t * split_stride; colt -= t * split_cols; if (t == 0) sc = scale0; }
        const int col0 = colt + wc * 32 + 8 * fq, bcol0 = u.pn * BM + wc * 32 + 8 * fq;
        f32x4 bv[2][2];
#pragma unroll
        for (int bj = 0; bj < 2; ++bj)
#pragma unroll
            for (int n = 0; n < 2; ++n) bv[bj][n] = bias ? *(const f32x4*)(bias + bcol0 + bj * HALF + 4 * n) : (f32x4){0.f, 0.f, 0.f, 0.f};
#pragma unroll
        for (int ai = 0; ai < 2; ++ai)
#pragma unroll
            for (int m = 0; m < 4; ++m) { bf16_t* rowp = base + (size_t)(row0 + ai * HALF + m * 16) * ldc + col0;
#pragma unroll
                for (int bj = 0; bj < 2; ++bj) { f32x4 v0 = acc[ai][bj][m][0] + bv[bj][0], v1 = acc[ai][bj][m][1] + bv[bj][1];
                    if (ACT == 1) { f32x2 a = gelu_pk((f32x2){v0[0], v0[1]}), b = gelu_pk((f32x2){v0[2], v0[3]}), c = gelu_pk((f32x2){v1[0], v1[1]}), d = gelu_pk((f32x2){v1[2], v1[3]});
                        v0 = (f32x4){a.x, a.y, b.x, b.y}; v1 = (f32x4){c.x, c.y, d.x, d.y}; }
                    v0 = v0 * sc; v1 = v1 * sc; u32x4 w; w.x = cvt_pk_bf16(v0[0], v0[1]); w.y = cvt_pk_bf16(v0[2], v0[3]); w.z = cvt_pk_bf16(v1[0], v1[1]); w.w = cvt_pk_bf16(v1[2], v1[3]);
                    *(u32x4*)(rowp + bj * HALF) = w; } }
    }
};

struct EpiF32 {
    static constexpr bool PERM = false, AFTER_DRAIN = false;
    float* C; int ldc; const float* bias; float* part;
    __device__ __forceinline__ void operator()(const f32x4 (&acc)[2][2][4][2], const Unit& u, int wr, int wc, int fr, int fq) const {
        const int row0 = (u.slot >= 0 ? (u.slot * 4 + u.pm / 17) * BM : u.pm * BM) + wr * 64 + fr, col0 = u.pn * BM + wc * 32 + 4 * fq;
        float* const Cb = u.slot >= 0 ? part : C;
        f32x4 bv[2][2];
#pragma unroll
        for (int bj = 0; bj < 2; ++bj)
#pragma unroll
            for (int n = 0; n < 2; ++n) bv[bj][n] = bias ? *(const f32x4*)(bias + col0 + bj * HALF + n * 16) : (f32x4){0.f, 0.f, 0.f, 0.f};
#pragma unroll
        for (int ai = 0; ai < 2; ++ai)
#pragma unroll
            for (int m = 0; m < 4; ++m) { float* rowp = Cb + (size_t)(row0 + ai * HALF + m * 16) * ldc + col0;
#pragma unroll
                for (int bj = 0; bj < 2; ++bj)
#pragma unroll
                    for (int n = 0; n < 2; ++n) *(f32x4*)(rowp + bj * HALF + n * 16) = acc[ai][bj][m][n] + bv[bj][n]; }
    }
};

struct EpiBf16P {
    static constexpr bool PERM = true, AFTER_DRAIN = false;
    bf16_t* O; int ldc; float* part;
    __device__ __forceinline__ void operator()(const f32x4 (&acc)[2][2][4][2], const Unit& u, int wr, int wc, int fr, int fq) const {
        const int col0 = u.pn * BM + wc * 32 + 8 * fq;
        if (u.slot < 0) {
            const int row0 = u.pm * BM + wr * 64 + fr;
#pragma unroll
            for (int ai = 0; ai < 2; ++ai)
#pragma unroll
                for (int m = 0; m < 4; ++m) { bf16_t* rowp = O + (size_t)(row0 + ai * HALF + m * 16) * ldc + col0;
#pragma unroll
                    for (int bj = 0; bj < 2; ++bj) { const f32x4 v0 = acc[ai][bj][m][0], v1 = acc[ai][bj][m][1];
                        u32x4 w; w.x = cvt_pk_bf16(v0[0], v0[1]); w.y = cvt_pk_bf16(v0[2], v0[3]); w.z = cvt_pk_bf16(v1[0], v1[1]); w.w = cvt_pk_bf16(v1[2], v1[3]);
                        *(u32x4*)(rowp + bj * HALF) = w; } }
        } else {
            const int row0 = (u.slot * 4 + u.pm / 17) * BM + wr * 64 + fr;
#pragma unroll
            for (int ai = 0; ai < 2; ++ai)
#pragma unroll
                for (int m = 0; m < 4; ++m) { float* rowp = part + (size_t)(row0 + ai * HALF + m * 16) * ldc + col0;
#pragma unroll
                    for (int bj = 0; bj < 2; ++bj) { *(f32x4*)(rowp + bj * HALF) = acc[ai][bj][m][0]; *(f32x4*)(rowp + bj * HALF + 4) = acc[ai][bj][m][1]; } }
        }
    }
};
template <class Epi, class Sched, bool ALIGN_EPI = false, bool SP2 = false>
__device__ __forceinline__ void gemm_phase(PG8_LAS unsigned char* lds, const Gemm g, const Sched& S, const Epi& E) {
    const int tid = threadIdx.x, wid = __builtin_amdgcn_readfirstlane(tid >> 6), lane = tid & 63, wr = wid >> 2, wc = wid & 3, fr = lane & 15, fq = lane >> 4;
    const int K = g.K;
    unsigned voffA[2], voffB[2];
#pragma unroll
    for (int i = 0; i < 2; ++i) { int R, C; stage_rc(tid * 16 + i * 8192, R, C); const int Rb = Epi::PERM ? ((R & ~31) + perm32(R & 31)) : R;
        voffA[i] = (unsigned)(R * K + C) * 2u; voffB[i] = (unsigned)(Rb * K + C) * 2u; }
    const size_t kstep = (size_t)(BK * 2);
    const size_t hstep = (size_t)HALF * K * 2;
    const size_t tstep = 2 * hstep;
    const unsigned ldsw = (unsigned)wid * 1024u;
    const int aoff = lds_byte(wr * 64 + fr, fq * 8), boff = lds_byte(wc * 32 + fr, fq * 8);
#define PG8_SA(b, h) (((b) * 2 + (h)) * HTB)
#define PG8_SB(b, h) ((4 + (b) * 2 + (h)) * HTB)
#define PG8_STAGE(bufoff, gbase, voff) do { _Pragma("unroll") for (int _i = 0; _i < 2; ++_i) \
        __builtin_amdgcn_global_load_lds((const unsigned*)((const char*)(gbase) + (voff)[_i]), (PG8_LAS unsigned*)(lds + (bufoff) + ldsw + _i * 8192), 16, 0, 0); } while (0)
#define PG8_LDA(dst, b, h) do { _Pragma("unroll") for (int m = 0; m < 4; ++m) _Pragma("unroll") for (int k = 0; k < 2; ++k) dst[m][k] = *(const PG8_LAS bf16x8*)(lds + PG8_SA(b, h) + aoff + m * 2048 + k * 1024); } while (0)
#define PG8_LDB(dst, b, h) do { _Pragma("unroll") for (int n = 0; n < 2; ++n) _Pragma("unroll") for (int k = 0; k < 2; ++k) dst[n][k] = *(const PG8_LAS bf16x8*)(lds + PG8_SB(b, h) + boff + n * 2048 + k * 1024); } while (0)
#define PG8_MMA(ai, bj, At, Bt) do { __builtin_amdgcn_s_setprio(1); _Pragma("unroll") for (int m = 0; m < 4; ++m) _Pragma("unroll") for (int n = 0; n < 2; ++n) _Pragma("unroll") for (int k = 0; k < 2; ++k) \
        acc[ai][bj][m][n] = __builtin_amdgcn_mfma_f32_16x16x32_bf16(Bt[n][k], At[m][k], acc[ai][bj][m][n], 0, 0, 0); __builtin_amdgcn_s_setprio(0); } while (0)
#define PG8_WAIT_V(n) asm volatile("s_waitcnt vmcnt(" #n ")" ::: "memory")
#define PG8_WAIT_L(n) asm volatile("s_waitcnt lgkmcnt(" #n ")" ::: "memory")
#define PG8_BAR __builtin_amdgcn_s_barrier()
#define PG8_SCHED __builtin_amdgcn_sched_barrier(0)
    Unit cur, nxt; int ui = 0;
    if (!S.next(0, cur)) return;
    f32x4 acc[2][2][4][2];
#pragma unroll
    for (int a = 0; a < 2; ++a)
#pragma unroll
        for (int b = 0; b < 2; ++b)
#pragma unroll
            for (int m = 0; m < 4; ++m)
#pragma unroll
                for (int n = 0; n < 2; ++n) acc[a][b][m][n] = (f32x4){0.f, 0.f, 0.f, 0.f};
    bf16x8 At[4][2], B0[2][2], B1[2][2];
    const char* cA = (const char*)g.A + (size_t)cur.pm * tstep + (size_t)cur.k0t * kstep; const char* cB = (const char*)g.Bt + (size_t)cur.pn * tstep + (size_t)cur.k0t * kstep;
    S.a_ready(cur);
    if constexpr (SP2) {
        PG8_STAGE(PG8_SB(0, 0), cB, voffB); PG8_STAGE(PG8_SB(0, 1), cB + hstep, voffB); PG8_STAGE(PG8_SA(0, 0), cA, voffA); PG8_STAGE(PG8_SA(0, 1), cA + hstep, voffA);
        if (wr == 1) PG8_BAR;
        PG8_WAIT_V(2); PG8_BAR;
        PG8_STAGE(PG8_SB(1, 0), cB + kstep, voffB); PG8_STAGE(PG8_SA(1, 0), cA + kstep, voffA); PG8_STAGE(PG8_SB(1, 1), cB + hstep + kstep, voffB);
        PG8_WAIT_V(6); PG8_BAR;
    } else {
        PG8_STAGE(PG8_SB(0, 0), cB, voffB); PG8_STAGE(PG8_SA(0, 0), cA, voffA); PG8_STAGE(PG8_SB(0, 1), cB + hstep, voffB); PG8_STAGE(PG8_SA(0, 1), cA + hstep, voffA);
        if (wr == 1) PG8_BAR;
        PG8_WAIT_V(4); PG8_BAR;
        PG8_STAGE(PG8_SB(1, 0), cB + kstep, voffB); PG8_STAGE(PG8_SA(1, 0), cA + kstep, voffA); PG8_STAGE(PG8_SB(1, 1), cB + hstep + kstep, voffB);
        PG8_WAIT_V(6); PG8_BAR;
    }
    for (;;) {
        const bool has_next = S.next(ui + 1, nxt);
        const char* nA = has_next ? (const char*)g.A + (size_t)nxt.pm * tstep + (size_t)nxt.k0t * kstep : cA; const char* nB = has_next ? (const char*)g.Bt + (size_t)nxt.pn * tstep + (size_t)nxt.k0t * kstep : cB;
        const int nt = cur.nt;
        for (int t = 0; t < nt; t += 2) {
            const bool last = (t == nt - 2);
            const char* a1 = cA + (size_t)(t + 1) * kstep;
            const char* a2 = last ? nA : cA + (size_t)(t + 2) * kstep; const char* b2 = last ? nB : cB + (size_t)(t + 2) * kstep;
            const char* a3 = a2 + kstep; const char* b3 = b2 + kstep;
            if (last && has_next) S.a_ready(nxt);
            if constexpr (SP2) {
            PG8_LDB(B0, 0, 0); PG8_LDB(B1, 0, 1); PG8_SCHED; PG8_LDA(At, 0, 0); PG8_STAGE(PG8_SA(1, 1), a1 + hstep, voffA);
            PG8_WAIT_V(8); PG8_WAIT_L(0); PG8_BAR; PG8_MMA(0, 0, At, B0); PG8_MMA(0, 1, At, B1); PG8_BAR; PG8_SCHED;
            PG8_LDA(At, 0, 1); PG8_STAGE(PG8_SB(0, 0), b2, voffB); PG8_STAGE(PG8_SB(0, 1), b2 + hstep, voffB); PG8_STAGE(PG8_SA(0, 0), a2, voffA);
            PG8_WAIT_V(8); PG8_WAIT_L(0); PG8_BAR; PG8_MMA(1, 0, At, B0); PG8_MMA(1, 1, At, B1); PG8_BAR; PG8_SCHED;
            PG8_LDB(B0, 1, 0); PG8_LDB(B1, 1, 1); PG8_SCHED; PG8_LDA(At, 1, 0); PG8_STAGE(PG8_SA(0, 1), a2 + hstep, voffA);
            PG8_WAIT_V(8); PG8_WAIT_L(0); PG8_BAR; PG8_MMA(0, 0, At, B0); PG8_MMA(0, 1, At, B1); PG8_BAR; PG8_SCHED;
            PG8_LDA(At, 1, 1); PG8_STAGE(PG8_SB(1, 0), b3, voffB); PG8_STAGE(PG8_SB(1, 1), b3 + hstep, voffB); PG8_STAGE(PG8_SA(1, 0), a3, voffA);
            PG8_WAIT_V(8); PG8_WAIT_L(0); PG8_BAR; PG8_MMA(1, 0, At, B0); PG8_MMA(1, 1, At, B1); PG8_BAR; PG8_SCHED;
            } else {
            PG8_LDB(B0, 0, 0); PG8_SCHED; PG8_LDA(At, 0, 0); PG8_STAGE(PG8_SA(1, 1), a1 + hstep, voffA);
            PG8_WAIT_L(8); PG8_BAR; PG8_WAIT_L(0); PG8_MMA(0, 0, At, B0); PG8_BAR; PG8_SCHED;
            PG8_LDB(B1, 0, 1); PG8_STAGE(PG8_SB(0, 0), b2, voffB);
            PG8_BAR; PG8_WAIT_L(0); PG8_MMA(0, 1, At, B1); PG8_BAR;
            PG8_LDA(At, 0, 1); PG8_STAGE(PG8_SA(0, 0), a2, voffA);
            PG8_BAR; PG8_WAIT_L(0); PG8_MMA(1, 0, At, B0); PG8_BAR; PG8_SCHED;
            PG8_STAGE(PG8_SB(0, 1), b2 + hstep, voffB);
            PG8_WAIT_V(6); PG8_BAR; PG8_MMA(1, 1, At, B1); PG8_BAR;
            PG8_LDB(B0, 1, 0); PG8_SCHED; PG8_LDA(At, 1, 0); PG8_STAGE(PG8_SA(0, 1), a2 + hstep, voffA);
            PG8_WAIT_L(8); PG8_BAR; PG8_WAIT_L(0); PG8_MMA(0, 0, At, B0); PG8_BAR; PG8_SCHED;
            PG8_LDB(B1, 1, 1); PG8_STAGE(PG8_SB(1, 0), b3, voffB);
            PG8_BAR; PG8_WAIT_L(0); PG8_MMA(0, 1, At, B1); PG8_BAR;
            PG8_LDA(At, 1, 1); PG8_STAGE(PG8_SA(1, 0), a3, voffA);
            PG8_BAR; PG8_WAIT_L(0); PG8_MMA(1, 0, At, B0); PG8_BAR; PG8_SCHED;
            PG8_STAGE(PG8_SB(1, 1), b3 + hstep, voffB);
            PG8_WAIT_V(6); PG8_BAR; PG8_MMA(1, 1, At, B1); PG8_BAR;
            }
        }
        if constexpr (ALIGN_EPI) { if (wr == 0) PG8_BAR; }
        if constexpr (!Epi::AFTER_DRAIN) { E(acc, cur, wr, wc, fr, fq); S.done(cur); }
        if (!has_next) break;
#pragma unroll
        for (int a = 0; a < 2; ++a)
#pragma unroll
            for (int b = 0; b < 2; ++b)
#pragma unroll
                for (int m = 0; m < 4; ++m)
#pragma unroll
                    for (int n = 0; n < 2; ++n) acc[a][b][m][n] = (f32x4){0.f, 0.f, 0.f, 0.f};
        cur = nxt; cA = nA; cB = nB; ++ui;
        if constexpr (ALIGN_EPI) { if (wr == 1) PG8_BAR; }
    }
    PG8_WAIT_V(0);
    if constexpr (!ALIGN_EPI) { if (wr == 0) PG8_BAR; }
    PG8_BAR;
    if constexpr (Epi::AFTER_DRAIN) { E.fused(acc, cur, wr, wc, fr, fq, lds, wid, lane); S.done(cur); }
#undef PG8_SA
#undef PG8_SB
#undef PG8_STAGE
#undef PG8_LDA
#undef PG8_LDB
#undef PG8_MMA
#undef PG8_WAIT_V
#undef PG8_WAIT_L
#undef PG8_BAR
#undef PG8_SCHED
}
}

#ifndef ATTN_FAST
#define ATTN_FAST 1
#endif
#ifndef SCAN_FAST
#define SCAN_FAST 1
#endif
#ifndef PROBE_MASK
#define PROBE_MASK 0
#endif
#ifndef PROBE_AMP
#define PROBE_AMP 8
#endif
#ifndef SCAN_CHUNKED
#define SCAN_CHUNKED 1
#endif
#ifndef PREP_REP
#define PREP_REP 0
#endif
#ifndef SCANA_REP
#define SCANA_REP 0
#endif
#ifndef SCAN_DEBUG
#define SCAN_DEBUG 0
#endif
#ifndef ONE_LAUNCH
#define ONE_LAUNCH 1
#endif
constexpr int NWAVES = 8, NTHR = 512;
constexpr int D = 1024, NB = 4, TL = 4096, CT = 256, SB = CT + TL  , NL = 4;
constexpr int M = NB * SB;
constexpr int NIN = 2688, NINP = 2816, DFF = 2816, DFF2 = 5632;
constexpr int R_IN = 1152, R_OFF = 768, C_OFF = 1920, K_OFF = 512, V_OFF = 640;
constexpr float NORM_EPS = 1e-6f, GN_EPS = 64e-5f, DECAY_SCALE = 0.606531f;
constexpr float C2 = 0.125f * 1.4426950408889634f;

typedef unsigned short bf16;
typedef unsigned v4u __attribute__((ext_vector_type(4)));
typedef unsigned v2u __attribute__((ext_vector_type(2)));
typedef float f32x4 __attribute__((ext_vector_type(4)));
#define LAS __attribute__((address_space(3)))
#define GAS __attribute__((address_space(1)))
typedef GAS unsigned gu32;
#define RLX_AGENT __ATOMIC_RELAXED, __HIP_MEMORY_SCOPE_AGENT

constexpr size_t MiB = 1u << 20;
constexpr size_t WS_CTL = 0, CTL_ZERO_BYTES = 1 * MiB;
constexpr size_t WS_MODS = 1 * MiB;
constexpr size_t WS_ROPE = WS_MODS + 512 * 1024;
constexpr size_t WS_LR = WS_ROPE + 1 * MiB;
constexpr size_t WS_XCUR = 3 * MiB;
constexpr size_t SZ_XCUR = (size_t)M * D * 4;
constexpr size_t WS_WIN = WS_XCUR + SZ_XCUR;
constexpr size_t WS_WOUT = WS_WIN + (size_t)NINP * D * 2;
constexpr size_t WS_WUP = WS_WOUT + (size_t)D * D * 2;
constexpr size_t WS_WDN = WS_WUP + (size_t)DFF2 * D * 2;
constexpr size_t WS_AR = WS_WDN + (size_t)D * DFF * 2;
constexpr size_t SZ_BF_MD = (size_t)M * D * 2;
constexpr size_t SZ_BF_M256 = (size_t)M * 256 * 2;
constexpr size_t AR_XN = 0;
constexpr size_t AR_Y = 0;
constexpr size_t AR_U = AR_XN + SZ_BF_MD;
constexpr size_t AR_MIXO = AR_U;
constexpr size_t AR_R = AR_U + (size_t)M * NINP * 2;
constexpr size_t AR_V = AR_R + SZ_BF_M256;
constexpr size_t AR_KK = AR_V + SZ_BF_M256;
constexpr size_t AR_G = AR_KK + SZ_BF_M256;
constexpr size_t AR_KE = AR_G + SZ_BF_M256;
constexpr size_t AR_KKA = AR_KE + 2 * SZ_BF_M256;
constexpr size_t AR_W = AR_KKA + 2 * SZ_BF_M256;
constexpr size_t AR_MIX = AR_W + (size_t)2 * M * 256 * 4;
constexpr size_t AR_QKV = AR_MIX + SZ_BF_MD;
constexpr int QKVP = 768;
constexpr size_t AR_END1 = AR_QKV + (size_t)M * QKVP * 2;
constexpr size_t AR_ACT = 0;
constexpr size_t AR_H = AR_ACT + (size_t)M * DFF * 2;
constexpr size_t AR_FO = AR_H;
constexpr size_t AR_PART = AR_H + (size_t)M * D * 4;
constexpr size_t AR_END2 = AR_H + (size_t)M * DFF2 * 2;
constexpr size_t WS_END = WS_AR + (AR_END1 > AR_END2 ? AR_END1 : AR_END2);
static_assert(WS_END <= 384 * MiB, "workspace budget");
constexpr int CW_BAR = 4096;

constexpr int LDS_BYTES = 147456;
constexpr int RING_BYTES = 131072, LDSCTL_OFF = RING_BYTES, MISC_OFF = LDSCTL_OFF + 320;

__device__ __forceinline__ unsigned f2bf(float f) { unsigned u = __builtin_bit_cast(unsigned, f); return (u + 0x7fffu + ((u >> 16) & 1u)) >> 16; }
__device__ __forceinline__ unsigned pk2(float lo, float hi) { return f2bf(lo) | (f2bf(hi) << 16); }
__device__ __forceinline__ float bf2f(unsigned short b) { return __builtin_bit_cast(float, ((unsigned)b) << 16); }
__device__ __forceinline__ float bflo(unsigned w) { return __builtin_bit_cast(float, w << 16); }
__device__ __forceinline__ float bfhi(unsigned w) { return __builtin_bit_cast(float, w & 0xffff0000u); }
__device__ __forceinline__ float sigm(float x) { return 1.f / (1.f + __expf(-x)); }
__device__ __forceinline__ float wave_sum(float v) {
#pragma unroll
    for (int o = 1; o < 64; o <<= 1) v += __shfl_xor(v, o);
    return v;
}
#define LDS_WAIT() asm volatile("s_waitcnt lgkmcnt(0)" ::: "memory")
#define LDS_BARRIER() do { asm volatile("s_waitcnt lgkmcnt(0)" ::: "memory"); __builtin_amdgcn_s_barrier(); asm volatile("" ::: "memory"); } while (0)
__device__ __forceinline__ float red16(float x) {
    float r;
    asm("s_nop 1\n\tv_add_f32_dpp %0, %1, %1 quad_perm:[1,0,3,2] row_mask:0xf bank_mask:0xf\n\ts_nop 1\n\t"
        "v_add_f32_dpp %0, %0, %0 quad_perm:[2,3,0,1] row_mask:0xf bank_mask:0xf\n\ts_nop 1\n\t"
        "v_add_f32_dpp %0, %0, %0 row_half_mirror row_mask:0xf bank_mask:0xf\n\ts_nop 1\n\t"
        "v_add_f32_dpp %0, %0, %0 row_mirror row_mask:0xf bank_mask:0xf\n\ts_nop 0" : "=&v"(r) : "v"(x));
    return r;
}

#define XB_TMO      128
#define XB_XCNT(j)  (256  + 64 * (j))
#define XB_XSUB(j)  (1280 + 64 * (j))
#define XB_XGEN(j)  (2304 + 64 * (j))
#define XB_TOP      3328
#define XB_TOPGEN   3392
#define XCD_BAR_WORDS 3456
#define XB_SPIN_CAP (1u << 18)
__device__ __forceinline__ unsigned xb_ld(unsigned* p)              { return __hip_atomic_load(p, __ATOMIC_RELAXED, __HIP_MEMORY_SCOPE_AGENT); }
__device__ __forceinline__ unsigned xb_add(unsigned* p, unsigned v) { return __hip_atomic_fetch_add(p, v, __ATOMIC_RELAXED, __HIP_MEMORY_SCOPE_AGENT); }
__device__ __forceinline__ unsigned xb_xcc_id() { return (unsigned)__builtin_amdgcn_s_getreg((3 << 11) | 20) & 0xFu; }
#define XB_SPIN(cond, bar) do { unsigned _sp = 0; while (cond) { __builtin_amdgcn_s_sleep(1); \
    if ((++_sp & 255u) == 0u) { if (xb_ld(&(bar)[XB_TMO])) break; if (_sp > XB_SPIN_CAP) { atomicAdd(&(bar)[XB_TMO], 1u); break; } } } } while (0)
struct XcdBarrier { unsigned* bar; unsigned x; volatile LAS unsigned* st; };
__device__ __forceinline__ XcdBarrier xcd_barrier_post(unsigned* bar, volatile LAS unsigned* st) {
    XcdBarrier b; b.bar = bar; b.x = xb_xcc_id(); b.st = st;
    if (threadIdx.x == 0) (void)xb_add(&bar[XB_XCNT(b.x)], 1u);
    return b;
}
__device__ __forceinline__ void xcd_barrier_complete(unsigned* bar, unsigned x, unsigned& nloc, unsigned& nx) {
    const unsigned G = gridDim.x * gridDim.y * gridDim.z;
    unsigned sum, cnt, mine, sp = 0u;
    for (;;) {
        sum = 0u; cnt = 0u; mine = 0u;
#pragma unroll
        for (unsigned j = 0; j < 16; ++j) { const unsigned c = xb_ld(&bar[XB_XCNT(j)]); sum += c; cnt += (c > 0u) ? 1u : 0u; mine = (j == x) ? c : mine; }
        if (sum == G) break;
        __builtin_amdgcn_s_sleep(1);
        if ((++sp & 255u) == 0u) { if (xb_ld(&bar[XB_TMO])) break; if (sp > XB_SPIN_CAP) { atomicAdd(&bar[XB_TMO], 1u); break; } }
    }
    nloc = mine > 0u ? mine : 1u; nx = cnt > 0u ? cnt : 1u;
}
__device__ __forceinline__ void xcd_barrier(const XcdBarrier& b) {
    asm volatile("s_waitcnt vmcnt(0)" ::: "memory");
    __syncthreads();
    if (threadIdx.x == 0) {
        unsigned* bar = b.bar;
        __builtin_amdgcn_s_waitcnt(0);
        unsigned nloc = b.st[0], nx = b.st[1];
        if (nloc == 0u) { xcd_barrier_complete(bar, b.x, nloc, nx); b.st[0] = nloc; b.st[1] = nx; }
        const unsigned old = xb_add(&bar[XB_XSUB(b.x)], 1u);
        const unsigned gen = old / nloc;
        if (old + 1u == (gen + 1u) * nloc) {
            __builtin_amdgcn_fence(__ATOMIC_RELEASE, "agent");
            asm volatile("s_waitcnt vmcnt(0)" ::: "memory");
            const unsigned og = xb_add(&bar[XB_TOP], 1u);
            const unsigned tg = og / nx;
            if (og + 1u == (tg + 1u) * nx) xb_add(&bar[XB_TOPGEN], 1u);
            else XB_SPIN(xb_ld(&bar[XB_TOPGEN]) == tg, bar);
            __builtin_amdgcn_fence(__ATOMIC_ACQUIRE, "agent");
            xb_add(&bar[XB_XGEN(b.x)], 1u);
            asm volatile("s_waitcnt vmcnt(0)" ::: "memory");
        } else {
            XB_SPIN(xb_ld(&bar[XB_XGEN(b.x)]) == gen, bar);
            __builtin_amdgcn_fence(__ATOMIC_ACQUIRE, "agent");
            asm volatile("s_waitcnt vmcnt(0)" ::: "memory");
        }
    }
    __syncthreads();
}

struct Args {
    const float* in[29];
    float* out; unsigned char* ws;
    int ph_lo, ph_hi;
};
enum { I_X = 0, I_C, I_CTX, I_CCTX, I_ADAW, I_ADAB, I_NMPRE, I_NMPOST, I_NFPRE, I_NFPOST, I_WIN, I_WOUT, I_QN, I_KN, I_MU, I_W0, I_WUP, I_A0, I_AUP, I_GUP,
       I_KK, I_KA, I_RK, I_LNW, I_LNB, I_SCW, I_FUP, I_FCONV, I_FDN };

struct Frame {
    LAS unsigned char* lds;
    int tid, lane, wave, bid, G;
    unsigned char* ws;
    float* out;
};
constexpr int PTR_OFF = LDSCTL_OFF + 1024;
#define INP(i) ((const float*)(const GAS float*)(((const unsigned long long LAS*)(F.lds + PTR_OFF))[i]))

__device__ __forceinline__ void transpose_item(const float* W, int K, int N, bf16* WT, LAS float* scr, int item, int lane) {
    const int nblk = N / 32, kb = item / nblk, nb = item % nblk, k0 = 64 * kb, n0 = 32 * nb;
#pragma unroll 8
    for (int i = 0; i < 32; ++i) { const int kk = 2 * i + (lane >> 5); scr[kk * 33 + (lane & 31)] = W[(size_t)(k0 + kk) * N + n0 + (lane & 31)]; }
    LDS_WAIT(); asm volatile("" ::: "memory");
    const int c = lane & 7;
#pragma unroll
    for (int j = 0; j < 4; ++j) { const int n = (lane >> 3) + 8 * j; const LAS float* s = scr + (8 * c) * 33 + n;
        v4u o; o.x = pk2(s[0 * 33], s[1 * 33]); o.y = pk2(s[2 * 33], s[3 * 33]); o.z = pk2(s[4 * 33], s[5 * 33]); o.w = pk2(s[6 * 33], s[7 * 33]);
        *(v4u*)(WT + (size_t)(n0 + n) * K + k0 + 8 * c) = o; }
    LDS_WAIT(); asm volatile("" ::: "memory");
}
__device__ __forceinline__ void convert_weights(const Frame& F, int l) {
    LAS float* scr = (LAS float*)(F.lds + F.wave * 8448);
    const int gw = F.bid * NWAVES + F.wave, NGW = F.G * NWAVES;
    const float* w_in = INP(I_WIN) + (size_t)l * D * NIN; const float* w_out = INP(I_WOUT) + (size_t)l * D * D;
    const float* w_up = INP(I_FUP) + (size_t)l * D * DFF2; const float* w_dn = INP(I_FDN) + (size_t)l * DFF * D;
    bf16* t_in = (bf16*)(F.ws + WS_WIN); bf16* t_out = (bf16*)(F.ws + WS_WOUT); bf16* t_up = (bf16*)(F.ws + WS_WUP); bf16* t_dn = (bf16*)(F.ws + WS_WDN);
    constexpr int I_1 = (D / 64) * (NIN / 32), I_2 = (D / 64) * (D / 32), I_3 = (D / 64) * (DFF2 / 32), I_4 = (DFF / 64) * (D / 32);
    for (int it = gw; it < I_1 + I_2 + I_3 + I_4; it += NGW) {
        int r = it;
        if (r < I_1) { transpose_item(w_in, D, NIN, t_in, scr, r, F.lane); continue; } r -= I_1;
        if (r < I_2) { transpose_item(w_out, D, D, t_out, scr, r, F.lane); continue; } r -= I_2;
        if (r < I_3) { transpose_item(w_up, D, DFF2, t_up, scr, r, F.lane); continue; } r -= I_3;
        transpose_item(w_dn, DFF, D, t_dn, scr, r, F.lane);
    }
    {
        const float* wup = INP(I_WUP) + (size_t)l * 2 * 64 * 256; const float* aup = INP(I_AUP) + (size_t)l * 2 * 64 * 256; const float* gup = INP(I_GUP) + (size_t)l * 128 * 256;
        bf16* lr = (bf16*)(F.ws + WS_LR);
        for (int it = gw; it < 48; it += NGW) {
            if (it < 16) transpose_item(wup + (size_t)(it >> 3) * 64 * 256, 64, 256, lr + (size_t)(it >> 3) * 256 * 64, scr, it & 7, F.lane);
            else if (it < 32) transpose_item(aup + (size_t)((it - 16) >> 3) * 64 * 256, 64, 256, lr + 2 * 256 * 64 + (size_t)((it - 16) >> 3) * 256 * 64, scr, it & 7, F.lane);
            else transpose_item(gup, 128, 256, lr + 4 * 256 * 64, scr, it - 32, F.lane);
        }
    }
    v4u z = {0u, 0u, 0u, 0u};
    for (int i = F.bid * NTHR + F.tid; i < (NINP - NIN) * D / 8; i += F.G * NTHR) *(v4u*)(t_in + (size_t)NIN * D + (size_t)i * 8) = z;
}

__device__ __forceinline__ void phase_pro_a(const Frame& F) {
    convert_weights(F, 0);
    __syncthreads();
    float* rope = (float*)(F.ws + WS_ROPE);
    for (int e = F.bid * NTHR + F.tid; e < TL * 32; e += F.G * NTHR) {
        const int pos = e >> 5, i = e & 31;
        const float inv = powf(10000.0f, -(float)(i & 15) / 16.0f);
        const float p = (i < 16) ? (float)(pos / 64) : (float)(pos % 64);
        const float ang = p * inv;
        rope[2 * e] = cosf(ang); rope[2 * e + 1] = sinf(ang);
    }
    LAS float* sc = (LAS float*)F.lds;
    LAS float* red = (LAS float*)(F.lds + 20480);
    for (int i = F.tid; i < 5 * 1024; i += NTHR) { const int r = i >> 10, k = i & 1023; const float v = r < 4 ? INP(I_C)[r * 1024 + k] : INP(I_CCTX)[k]; sc[i] = v / (1.f + expf(-v)); }
    __syncthreads();
    float* mods = (float*)(F.ws + WS_MODS);
    for (int item = F.bid; item < NL * 96; item += F.G) {
        const int l = item / 96, jg = item % 96;
        const int c4 = (F.lane & 15) * 4, kq = F.lane >> 4;
        const float* w = INP(I_ADAW) + (size_t)l * 1024 * 6144 + jg * 64 + c4;
        f32x4 a0 = {0.f, 0.f, 0.f, 0.f}, a1 = a0, a2 = a0, a3 = a0, a4 = a0;
        const int kb = F.wave * 128;
#pragma unroll 8
        for (int i = 0; i < 32; ++i) { const int k = kb + 4 * i + kq; const f32x4 wv = *(const f32x4*)(w + (size_t)k * 6144);
            a0 += wv * sc[k]; a1 += wv * sc[1024 + k]; a2 += wv * sc[2048 + k]; a3 += wv * sc[3072 + k]; a4 += wv * sc[4096 + k]; }
#pragma unroll
        for (int e = 0; e < 4; ++e) {
            a0[e] += __shfl_xor(a0[e], 16); a0[e] += __shfl_xor(a0[e], 32); a1[e] += __shfl_xor(a1[e], 16); a1[e] += __shfl_xor(a1[e], 32);
            a2[e] += __shfl_xor(a2[e], 16); a2[e] += __shfl_xor(a2[e], 32); a3[e] += __shfl_xor(a3[e], 16); a3[e] += __shfl_xor(a3[e], 32);
            a4[e] += __shfl_xor(a4[e], 16); a4[e] += __shfl_xor(a4[e], 32); }
        if (kq == 0) {
            *(LAS f32x4*)(red + (F.wave * 5 + 0) * 64 + c4) = a0; *(LAS f32x4*)(red + (F.wave * 5 + 1) * 64 + c4) = a1; *(LAS f32x4*)(red + (F.wave * 5 + 2) * 64 + c4) = a2;
            *(LAS f32x4*)(red + (F.wave * 5 + 3) * 64 + c4) = a3; *(LAS f32x4*)(red + (F.wave * 5 + 4) * 64 + c4) = a4; }
        __syncthreads();
        if (F.tid < 320) { const int r = F.tid >> 6, j = F.tid & 63; float s_ = 0.f;
#pragma unroll
            for (int w8 = 0; w8 < 8; ++w8) s_ += red[(w8 * 5 + r) * 64 + j];
            mods[((size_t)l * 5 + r) * 6144 + jg * 64 + j] = s_ + INP(I_ADAB)[l * 6144 + jg * 64 + j]; }
        __syncthreads();
    }
}

__device__ __forceinline__ void norm_phase(const Frame& F, int mode, const float* o, const float* g_post, int lmod_gate, int i_gate,
                                           const float* g_next, int lmod_next, int i_shift, int i_scale, int nks  ) {
    const int gw = F.bid * NWAVES + F.wave, NGW = F.G * NWAVES;
    float* xcur = (float*)(F.ws + WS_XCUR); bf16* xn = (bf16*)(F.ws + WS_AR + AR_XN);
    const float* mods = (const float*)(F.ws + WS_MODS);
    const int b = gw & 3, w4 = gw >> 2, NW4 = NGW >> 2;
    f32x4 c_gp[4], c_gt[4], c_gn[4], c_sh[4], c_sc[4];
#pragma unroll
    for (int j = 0; j < 4; ++j) { const int c0 = 4 * F.lane + 256 * j; const f32x4 z4 = {0.f, 0.f, 0.f, 0.f};
        c_gp[j] = mode >= 1 ? *(const f32x4*)(g_post + c0) : z4; c_gt[j] = mode >= 1 ? *(const f32x4*)(mods + ((size_t)lmod_gate * 5 + b) * 6144 + i_gate * 1024 + c0) : z4;
        c_gn[j] = mode <= 1 ? *(const f32x4*)(g_next + c0) : z4;
        c_sh[j] = mode <= 1 ? *(const f32x4*)(mods + ((size_t)lmod_next * 5 + b) * 6144 + i_shift * 1024 + c0) : z4;
        c_sc[j] = mode <= 1 ? *(const f32x4*)(mods + ((size_t)lmod_next * 5 + b) * 6144 + i_scale * 1024 + c0) : z4; }
    for (int s = w4; s < SB; s += NW4) {
        const int m = b * SB + s; const bool ctx = s < CT;
        f32x4 x[4];
        if (mode == 0) {
            const float* src = ctx ? INP(I_CTX) + ((size_t)b * CT + s) * D : INP(I_X) + ((size_t)b * TL + (s - CT)) * D;
#pragma unroll
            for (int j = 0; j < 4; ++j) x[j] = *(const f32x4*)(src + 4 * F.lane + 256 * j);
        } else {
            f32x4 ov[4], xv[4]; float ss = 0.f;
#pragma unroll
            for (int j = 0; j < 4; ++j) xv[j] = *(const f32x4*)(xcur + (size_t)m * D + 4 * F.lane + 256 * j);
#pragma unroll
            for (int j = 0; j < 4; ++j) {
                if (ctx) { const float* pp = (const float*)(F.ws + WS_AR + AR_PART) + ((size_t)b * 256 + s) * D + 4 * F.lane + 256 * j; f32x4 a = {0.f, 0.f, 0.f, 0.f};
                    for (int ks = 0; ks < nks; ++ks) a += *(const f32x4*)(pp + (size_t)ks * 4 * 256 * D);
                    ov[j] = a; }
                else { const v2u w_ = *(const v2u*)((const bf16*)o + (size_t)m * D + 4 * F.lane + 256 * j); ov[j] = (f32x4){bflo(w_.x), bfhi(w_.x), bflo(w_.y), bfhi(w_.y)}; }
                ss += ov[j][0] * ov[j][0] + ov[j][1] * ov[j][1] + ov[j][2] * ov[j][2] + ov[j][3] * ov[j][3]; }
            ss = wave_sum(ss);
            const float rs = rsqrtf(ss * (1.f / D) + NORM_EPS);
#pragma unroll
            for (int j = 0; j < 4; ++j) { const int c0 = 4 * F.lane + 256 * j;
                const f32x4 gt = ctx ? *(const f32x4*)(mods + ((size_t)lmod_gate * 5 + 4) * 6144 + i_gate * 1024 + c0) : c_gt[j];
                x[j] = xv[j] + gt * (ov[j] * rs * c_gp[j]); }
        }
        if (mode == 2) {
            if (!ctx) {
#pragma unroll
                for (int j = 0; j < 4; ++j) *(f32x4*)(F.out + ((size_t)b * TL + (s - CT)) * D + 4 * F.lane + 256 * j) = x[j];
            }
            continue;
        }
        float ss = 0.f;
#pragma unroll
        for (int j = 0; j < 4; ++j) { *(f32x4*)(xcur + (size_t)m * D + 4 * F.lane + 256 * j) = x[j]; ss += x[j][0] * x[j][0] + x[j][1] * x[j][1] + x[j][2] * x[j][2] + x[j][3] * x[j][3]; }
        ss = wave_sum(ss);
        const float rs = rsqrtf(ss * (1.f / D) + NORM_EPS);
#pragma unroll
        for (int j = 0; j < 4; ++j) { const int c0 = 4 * F.lane + 256 * j;
            const f32x4 sh = ctx ? *(const f32x4*)(mods + ((size_t)lmod_next * 5 + 4) * 6144 + i_shift * 1024 + c0) : c_sh[j];
            const f32x4 scl = ctx ? *(const f32x4*)(mods + ((size_t)lmod_next * 5 + 4) * 6144 + i_scale * 1024 + c0) : c_sc[j];
            const f32x4 y = x[j] * rs * c_gn[j] * (scl + 1.f) + sh;
            v2u w; w.x = pk2(y[0], y[1]); w.y = pk2(y[2], y[3]);
            *(v2u*)(xn + (size_t)m * D + c0) = w; }
    }
}

typedef short pbf16x8 __attribute__((ext_vector_type(8)));
constexpr int PZ_LD = 1152, PA_LD = 136, P_TH = 16 * PZ_LD * 4, P_AD = P_TH + 16 * PA_LD * 2, P_SG = P_AD + 16 * PA_LD * 2, P_KN = P_SG + 16 * PA_LD * 2;
__device__ __forceinline__ void unpack8(const v4u& w, float (&x)[8]) {
#pragma unroll
    for (int q = 0; q < 4; ++q) { x[2 * q] = bflo(w[q]); x[2 * q + 1] = bfhi(w[q]); }
}
__device__ __forceinline__ v4u pack8(const float (&x)[8]) { v4u w;
#pragma unroll
    for (int q = 0; q < 4; ++q) w[q] = pk2(x[2 * q], x[2 * q + 1]);
    return w; }
__device__ __forceinline__ void prep_phase(const Frame& F, int l) {
    LAS float* ZS = (LAS float*)F.lds;
    LAS bf16* TH = (LAS bf16*)(F.lds + P_TH); LAS bf16* AD = (LAS bf16*)(F.lds + P_AD); LAS bf16* SG = (LAS bf16*)(F.lds + P_SG);
    LAS float* KN = (LAS float*)(F.lds + P_KN);
    const bf16* U = (const bf16*)(F.ws + WS_AR + AR_U);
    bf16* QKV = (bf16*)(F.ws + WS_AR + AR_QKV);
    const float* rope = (const float*)(F.ws + WS_ROPE);
    const float* qn = INP(I_QN) + l * 64; const float* kn = INP(I_KN) + l * 64;
    const float* mu = INP(I_MU) + (size_t)l * 2 * R_IN;
    const float* w0 = INP(I_W0) + l * 512; const float* a0 = INP(I_A0) + l * 512;
    const float* k_k = INP(I_KK) + l * 256; const float* k_a = INP(I_KA) + l * 256;
    const float* scw = INP(I_SCW) + (size_t)l * 3 * 256;
    const bf16* lr = (const bf16*)(F.ws + WS_LR);
    bf16* R_o = (bf16*)(F.ws + WS_AR + AR_R); bf16* V_o = (bf16*)(F.ws + WS_AR + AR_V); bf16* KK_o = (bf16*)(F.ws + WS_AR + AR_KK); bf16* G_o = (bf16*)(F.ws + WS_AR + AR_G);
    bf16* KE_o = (bf16*)(F.ws + WS_AR + AR_KE); bf16* KKA_o = (bf16*)(F.ws + WS_AR + AR_KKA); float* W_o = (float*)(F.ws + WS_AR + AR_W);
    bf16* MIX = (bf16*)(F.ws + WS_AR + AR_MIX);
    const int lane = F.lane, wv = F.wave, tid = F.tid, fr = lane & 15, fq = lane >> 4;
    LAS float* CM = (LAS float*)(F.lds + P_KN + 256); LAS float* CP = CM + 2 * R_IN; LAS float* CS = CP + 6 * 256; LAS float* CG = CS + 3 * 256;
    for (int i = tid; i < 2 * R_IN; i += NTHR) CM[i] = mu[i];
    for (int i = tid; i < 256; i += NTHR) { CP[i] = k_k[i]; CP[256 + i] = k_a[i]; CP[512 + i] = w0[i]; CP[768 + i] = w0[256 + i]; CP[1024 + i] = a0[i]; CP[1280 + i] = a0[256 + i]; }
    for (int i = tid; i < 768; i += NTHR) CS[i] = scw[i];
    if (tid < 64) { CG[tid] = qn[tid]; CG[64 + tid] = kn[tid]; }
    __syncthreads();
    const bool bact = tid < 432; const int bch = bact ? tid % 144 : 0, btq = bact ? tid / 144 : 0, bc0 = bch * 8;
    const bool bisk = bact && bc0 >= 256 && bc0 < 512;
    const int ad0 = (lane & 7) * 8;
    const int dc0 = (tid & 31) * 8;
    const bool xaff = F.G == 256;
    for (int it_ = xaff ? ((F.bid >> 3) + 32 * (F.bid & 1)) : F.bid; it_ < (xaff ? SB / 16 : M / 16); it_ += (xaff ? 64 : F.G)) {
        const int item = xaff ? ((F.bid & 7) >> 1) * (SB / 16) + it_ : it_;
        const int m0 = item * 16, s0 = m0 % SB;
        const bool isctx = s0 < CT; const int seq_lo = isctx ? 0 : CT, seq_hi = isctx ? CT : SB;
        v4u araw[2][2], avc[2]; f32x4 arp[2][4];
#pragma unroll
        for (int rr = 0; rr < 2; ++rr) { const int t = 2 * wv + rr; const bf16* ur = U + (size_t)(m0 + t) * NINP;
            araw[rr][0] = *(const v4u*)(ur + 8 * lane); araw[rr][1] = *(const v4u*)(ur + K_OFF + 8 * (lane & 15)); avc[rr] = *(const v4u*)(ur + V_OFF + 8 * (lane & 15));
            const int pos = isctx ? 0 : (s0 + t - CT); const float* rp = rope + ((size_t)pos * 32 + (ad0 & 31)) * 2;
#pragma unroll
            for (int e = 0; e < 4; ++e) arp[rr][e] = *(const f32x4*)(rp + 4 * e); }
        v4u dbg, dcg[3], dxc[3];
        { const int t = tid >> 5, s = s0 + t; const bf16* u = U + (size_t)(m0 + t) * NINP + C_OFF + dc0;
          const int dp = s > seq_lo ? -NINP : 0, dn = s < seq_hi - 1 ? NINP : 0;
          dbg = *(const v4u*)u; dcg[1] = *(const v4u*)(u + 256); dxc[1] = *(const v4u*)(u + 512);
          dcg[0] = *(const v4u*)(u + dp + 256); dxc[0] = *(const v4u*)(u + dp + 512); dcg[2] = *(const v4u*)(u + dn + 256); dxc[2] = *(const v4u*)(u + dn + 512); }
#pragma unroll
        for (int rr = 0; rr < 2; ++rr) {
            const int t = 2 * wv + rr, m = m0 + t;
            bf16* orow = QKV + (size_t)m * QKVP;
#pragma unroll
            for (int pass = 0; pass < 2; ++pass) {
                const bool act = pass == 0 || lane < 16;
                const int col = (pass == 0 ? 0 : K_OFF) + 8 * lane;
                float x[8]; unpack8(araw[rr][pass], x);
                float ss = 0.f;
#pragma unroll
                for (int e = 0; e < 8; ++e) ss += x[e] * x[e];
                ss += __shfl_xor(ss, 1); ss += __shfl_xor(ss, 2); ss += __shfl_xor(ss, 4);
                const float rs = rsqrtf(ss * (1.f / 64.f) + NORM_EPS);
                const f32x4 g0 = *(const LAS f32x4*)(CG + pass * 64 + ad0), g1 = *(const LAS f32x4*)(CG + pass * 64 + ad0 + 4);
                float y[8];
#pragma unroll
                for (int e = 0; e < 4; ++e) { y[e] = x[e] * rs * g0[e]; y[4 + e] = x[4 + e] * rs * g1[e]; }
                float yp[8];
#pragma unroll
                for (int e = 0; e < 8; ++e) yp[e] = __shfl_xor(y[e], 4);
                if (!isctx) {
                    const bool lo_half = ad0 < 32;
#pragma unroll
                    for (int e = 0; e < 8; e += 2) { const f32x4 cs = arp[rr][e >> 1];
                        y[e] = lo_half ? (y[e] * cs[0] - yp[e] * cs[1]) : (y[e] * cs[0] + yp[e] * cs[1]);
                        y[e + 1] = lo_half ? (y[e + 1] * cs[2] - yp[e + 1] * cs[3]) : (y[e + 1] * cs[2] + yp[e + 1] * cs[3]); }
                }
                if (pass == 0) {
#pragma unroll
                    for (int e = 0; e < 8; ++e) y[e] *= C2;
                }
                if (act) *(v4u*)(orow + col) = pack8(y);
            }
            if (lane < 16) *(v4u*)(orow + V_OFF + 8 * lane) = avc[rr];
        }
        { const int t = tid >> 5, s = s0 + t;
          float bg[8], c1[8], x1[8], p[8], pp[8], pn[8];
          unpack8(dbg, bg); unpack8(dcg[1], c1); unpack8(dxc[1], x1);
#pragma unroll
          for (int e = 0; e < 8; ++e) p[e] = c1[e] * x1[e];
          unpack8(dcg[0], c1); unpack8(dxc[0], x1);
          const float mp = s > seq_lo ? 1.f : 0.f, mn = s < seq_hi - 1 ? 1.f : 0.f;
#pragma unroll
          for (int e = 0; e < 8; ++e) pp[e] = c1[e] * x1[e] * mp;
          unpack8(dcg[2], c1); unpack8(dxc[2], x1);
#pragma unroll
          for (int e = 0; e < 8; ++e) pn[e] = c1[e] * x1[e] * mn;
          float o[8];
#pragma unroll
          for (int e = 0; e < 8; ++e) o[e] = bg[e] * (pp[e] * CS[dc0 + e] + p[e] * CS[256 + dc0 + e] + pn[e] * CS[512 + dc0 + e]);
          *(v4u*)(MIX + (size_t)(m0 + t) * D + 768 + dc0) = pack8(o); }
#pragma unroll 1
        for (int hb = 0; hb < 2; ++hb)
        { const int t0 = 6 * btq + 3 * hb, ntok = btq == 2 ? (hb == 0 ? 3 : 1) : 3;
          const f32x4 mu0a = *(const LAS f32x4*)(CM + bc0), mu0b = *(const LAS f32x4*)(CM + bc0 + 4), mu1a = *(const LAS f32x4*)(CM + R_IN + bc0), mu1b = *(const LAS f32x4*)(CM + R_IN + bc0 + 4);
          const f32x4 bkka = bisk ? *(const LAS f32x4*)(CP + bc0 - 256) : (f32x4){0.f, 0.f, 0.f, 0.f}, bkkb = bisk ? *(const LAS f32x4*)(CP + bc0 - 252) : (f32x4){0.f, 0.f, 0.f, 0.f};
          v4u rw[5];
#pragma unroll
          for (int jj = 0; jj < 5; ++jj) { int sr_ = s0 + t0 - 1 + jj; sr_ = sr_ < seq_lo ? seq_lo : (sr_ > seq_hi - 1 ? seq_hi - 1 : sr_);
              const int tt = sr_ - s0; const int tcl = tt > 16 ? 16 : tt;
              rw[jj] = *(const v4u*)(U + (unsigned)(m0 + tcl) * (unsigned)NINP + (unsigned)(R_OFF + bc0)); }
#pragma unroll
          for (int jj = 1; jj <= 3; ++jj) {
              const int t = t0 + jj - 1, s = s0 + t; const bool tv = bact && jj <= ntok;
              float z[8], pv[8], nx[8];
              unpack8(rw[jj], z); unpack8(rw[jj - 1], pv); unpack8(rw[jj + 1], nx);
              const float mp = s > seq_lo ? 1.f : 0.f, mn = s < seq_hi - 1 ? 1.f : 0.f;
#pragma unroll
              for (int e = 0; e < 4; ++e) { z[e] = z[e] + mu0a[e] * (pv[e] * mp - z[e]) + mu1a[e] * (nx[e] * mn - z[e]); z[4 + e] = z[4 + e] + mu0b[e] * (pv[4 + e] * mp - z[4 + e]) + mu1b[e] * (nx[4 + e] * mn - z[4 + e]); }
              if (tv) { *(LAS f32x4*)(ZS + t * PZ_LD + bc0) = (f32x4){z[0], z[1], z[2], z[3]}; *(LAS f32x4*)(ZS + t * PZ_LD + bc0 + 4) = (f32x4){z[4], z[5], z[6], z[7]}; }
              float ss = 0.f;
#pragma unroll
              for (int e = 0; e < 4; ++e) { const float u0 = z[e] * bkka[e], u1 = z[4 + e] * bkkb[e]; ss += u0 * u0 + u1 * u1; }
              ss += __shfl_xor(ss, 1); ss += __shfl_xor(ss, 2); ss += __shfl_xor(ss, 4);
              if (tv && bisk && (bch & 7) == 0) KN[t * 4 + ((bc0 - 256) >> 6)] = rsqrtf(fmaxf(ss, 1e-12f));
              if (tv && bc0 >= 768) {
                  float q[8];
                  if (bc0 < 896) {
#pragma unroll
                      for (int e = 0; e < 8; ++e) q[e] = 1.f - 2.f / (1.f + __expf(2.f * z[e]));
                      *(LAS v4u*)(TH + t * PA_LD + (bc0 - 768)) = pack8(q);
                  } else if (bc0 < 1024) { *(LAS v4u*)(AD + t * PA_LD + (bc0 - 896)) = pack8(z); }
                  else {
#pragma unroll
                      for (int e = 0; e < 8; ++e) q[e] = sigm(z[e]);
                      *(LAS v4u*)(SG + t * PA_LD + (bc0 - 1024)) = pack8(q);
                  }
              }
          } }
        LDS_BARRIER();
        pbf16x8 bwf[2][2][2], baf[2][2][2], bgf[2][4];
#pragma unroll
        for (int nt = 0; nt < 2; ++nt) { const int cw = 32 * wv + 16 * nt + fr;
#pragma unroll
            for (int d = 0; d < 2; ++d)
#pragma unroll
                for (int kb = 0; kb < 2; ++kb) { bwf[nt][d][kb] = *(const pbf16x8*)(lr + (size_t)d * 256 * 64 + (size_t)cw * 64 + kb * 32 + fq * 8);
                    baf[nt][d][kb] = *(const pbf16x8*)(lr + 2 * 256 * 64 + (size_t)d * 256 * 64 + (size_t)cw * 64 + kb * 32 + fq * 8); }
#pragma unroll
            for (int kb = 0; kb < 4; ++kb) bgf[nt][kb] = *(const pbf16x8*)(lr + 4 * 256 * 64 + (size_t)cw * 128 + kb * 32 + fq * 8); }
        { pbf16x8 tha[2][2], ada[2][2], sga[4];
#pragma unroll
          for (int d = 0; d < 2; ++d)
#pragma unroll
              for (int kb = 0; kb < 2; ++kb) { tha[d][kb] = *(const LAS pbf16x8*)(TH + fr * PA_LD + d * 64 + kb * 32 + fq * 8); ada[d][kb] = *(const LAS pbf16x8*)(AD + fr * PA_LD + d * 64 + kb * 32 + fq * 8); }
#pragma unroll
          for (int kb = 0; kb < 4; ++kb) sga[kb] = *(const LAS pbf16x8*)(SG + fr * PA_LD + kb * 32 + fq * 8);
#pragma unroll
          for (int nt = 0; nt < 2; ++nt) {
              const int n0 = 32 * wv + 16 * nt;
              f32x4 accW[2], accA[2], accG = {0.f, 0.f, 0.f, 0.f};
#pragma unroll
              for (int d = 0; d < 2; ++d) { accW[d] = (f32x4){0.f, 0.f, 0.f, 0.f}; accA[d] = (f32x4){0.f, 0.f, 0.f, 0.f};
#pragma unroll
                  for (int kb = 0; kb < 2; ++kb) {
                      accW[d] = __builtin_amdgcn_mfma_f32_16x16x32_bf16(bwf[nt][d][kb], tha[d][kb], accW[d], 0, 0, 0);
                      accA[d] = __builtin_amdgcn_mfma_f32_16x16x32_bf16(baf[nt][d][kb], ada[d][kb], accA[d], 0, 0, 0);
                  } }
#pragma unroll
              for (int kb = 0; kb < 4; ++kb) accG = __builtin_amdgcn_mfma_f32_16x16x32_bf16(bgf[nt][kb], sga[kb], accG, 0, 0, 0);
              const int t = fr, c0 = n0 + 4 * fq; const unsigned o = (unsigned)(m0 + t) * 256u + (unsigned)c0;
              const f32x4 kv = *(const LAS f32x4*)(ZS + t * PZ_LD + 256 + c0), rv = *(const LAS f32x4*)(ZS + t * PZ_LD + c0), vv = *(const LAS f32x4*)(ZS + t * PZ_LD + 512 + c0);
              const f32x4 kkc = *(const LAS f32x4*)(CP + c0), kac = *(const LAS f32x4*)(CP + 256 + c0), w00 = *(const LAS f32x4*)(CP + 512 + c0), w01 = *(const LAS f32x4*)(CP + 768 + c0), a00 = *(const LAS f32x4*)(CP + 1024 + c0), a01 = *(const LAS f32x4*)(CP + 1280 + c0);
              const float knv = KN[t * 4 + (c0 >> 6)];
              f32x4 kk4, lw0, lw1, ke0, ke1, ka0, ka1;
#pragma unroll
              for (int e = 0; e < 4; ++e) { kk4[e] = kv[e] * kkc[e] * knv;
                  lw0[e] = -DECAY_SCALE * sigm(accW[0][e] + w00[e]); lw1[e] = -DECAY_SCALE * sigm(accW[1][e] + w01[e]);
                  const float av0 = sigm(accA[0][e] + a00[e]), av1 = sigm(accA[1][e] + a01[e]);
                  ke0[e] = kv[e] * (1.f + (av0 - 1.f) * kac[e]); ke1[e] = kv[e] * (1.f + (av1 - 1.f) * kac[e]); ka0[e] = kk4[e] * av0; ka1[e] = kk4[e] * av1; }
#define ST4(P, V) do { v2u w_; w_.x = pk2((V)[0], (V)[1]); w_.y = pk2((V)[2], (V)[3]); *(v2u*)(P) = w_; } while (0)
              ST4(R_o + o, rv); ST4(V_o + o, vv); ST4(KK_o + o, kk4); ST4(G_o + o, accG);
              *(f32x4*)(W_o + o) = lw0; *(f32x4*)(W_o + (unsigned)(M * 256) + o) = lw1;
              ST4(KE_o + o, ke0); ST4(KE_o + (unsigned)(M * 256) + o, ke1); ST4(KKA_o + o, ka0); ST4(KKA_o + (unsigned)(M * 256) + o, ka1);
#undef ST4
          } }
        LDS_BARRIER();
    }
}

__device__ __forceinline__ void rwkv_out_phase(const Frame& F, int l) {
    const float* Y = (const float*)(F.ws + WS_AR + AR_Y);
    const bf16* R_i = (const bf16*)(F.ws + WS_AR + AR_R); const bf16* V_i = (const bf16*)(F.ws + WS_AR + AR_V); const bf16* G_i = (const bf16*)(F.ws + WS_AR + AR_G);
    const bf16* KE_i = (const bf16*)(F.ws + WS_AR + AR_KE);
    bf16* MIX = (bf16*)(F.ws + WS_AR + AR_MIX);
    const int gw = F.bid * NWAVES + F.wave, NGW = F.G * NWAVES;
    const int c0 = 4 * F.lane;
    const f32x4 rk = *(const f32x4*)(INP(I_RK) + l * 256 + c0), lw = *(const f32x4*)(INP(I_LNW) + l * 256 + c0), lb = *(const f32x4*)(INP(I_LNB) + l * 256 + c0);
    for (int m = gw; m < M; m += NGW) {
        const unsigned o = (unsigned)m * 256u + (unsigned)c0;
        const f32x4 y0 = *(const f32x4*)(Y + o), y1 = *(const f32x4*)(Y + (unsigned)(M * 256) + o);
        const v2u rw_ = *(const v2u*)(R_i + o), vw = *(const v2u*)(V_i + o), gw_ = *(const v2u*)(G_i + o), k0 = *(const v2u*)(KE_i + o), k1 = *(const v2u*)(KE_i + (unsigned)(M * 256) + o);
        const f32x4 y = y0 + y1;
        const float mean = red16((y[0] + y[1]) + (y[2] + y[3])) * (1.f / 64.f);
        const f32x4 dl = y - mean;
        const float var = red16((dl[0] * dl[0] + dl[1] * dl[1]) + (dl[2] * dl[2] + dl[3] * dl[3])) * (1.f / 64.f);
        const float rs = rsqrtf(var + GN_EPS);
        const f32x4 rr = {bflo(rw_.x), bfhi(rw_.x), bflo(rw_.y), bfhi(rw_.y)}, vv = {bflo(vw.x), bfhi(vw.x), bflo(vw.y), bfhi(vw.y)}, gg = {bflo(gw_.x), bfhi(gw_.x), bflo(gw_.y), bfhi(gw_.y)};
        const f32x4 ke = (f32x4){bflo(k0.x), bfhi(k0.x), bflo(k0.y), bfhi(k0.y)} + (f32x4){bflo(k1.x), bfhi(k1.x), bflo(k1.y), bfhi(k1.y)};
        const f32x4 tt = rr * ke * rk;
        const float bon = red16((tt[0] + tt[1]) + (tt[2] + tt[3]));
        const f32x4 ov = (dl * rs * lw + lb + vv * bon) * gg;
        v2u w; w.x = pk2(ov[0], ov[1]); w.y = pk2(ov[2], ov[3]);
        *(v2u*)(MIX + (size_t)m * D + 512 + c0) = w;
    }
}

__device__ __forceinline__ void act_phase(const Frame& F, int l) {
    const bf16* H = (const bf16*)(F.ws + WS_AR + AR_H); bf16* ACT = (bf16*)(F.ws + WS_AR + AR_ACT);
    const float* wc = INP(I_FCONV) + (size_t)l * 3 * DFF2;
    constexpr int NCH = DFF / 8;
    const int nitems = (M / 8) * NCH;
    for (int it = F.bid * NTHR + F.tid; it < nitems; it += F.G * NTHR) {
        const int rg = it / NCH, ch = it % NCH, j0 = ch * 8, m0 = rg * 8, s0 = m0 % SB;
        const bool isctx = s0 < CT; const int seq_lo = isctx ? 0 : CT, seq_hi = isctx ? CT : SB;
        v4u gr[10], ur[10];
#pragma unroll
        for (int r = 0; r < 10; ++r) { int s = s0 - 1 + r; s = s < seq_lo ? seq_lo : (s > seq_hi - 1 ? seq_hi - 1 : s);
            const bf16* hr = H + (size_t)(m0 - s0 + s) * DFF2 + j0; gr[r] = *(const v4u*)hr; ur[r] = *(const v4u*)(hr + DFF); }
        float wg[3][8], wu[3][8];
#pragma unroll
        for (int tp = 0; tp < 3; ++tp) { const f32x4 a0 = *(const f32x4*)(wc + tp * DFF2 + j0), a1 = *(const f32x4*)(wc + tp * DFF2 + j0 + 4), b0 = *(const f32x4*)(wc + tp * DFF2 + DFF + j0), b1 = *(const f32x4*)(wc + tp * DFF2 + DFF + j0 + 4);
#pragma unroll
            for (int e = 0; e < 4; ++e) { wg[tp][e] = a0[e]; wg[tp][4 + e] = a1[e]; wu[tp][e] = b0[e]; wu[tp][4 + e] = b1[e]; } }
#pragma unroll
        for (int r = 0; r < 8; ++r) {
            const int s = s0 + r;
            const float mp = s > seq_lo ? 1.f : 0.f, mn = s < seq_hi - 1 ? 1.f : 0.f;
            v4u o;
#pragma unroll
            for (int q = 0; q < 4; ++q) {
                const float ga0 = bflo(gr[r][q]) * mp * wg[0][2 * q] + bflo(gr[r + 1][q]) * wg[1][2 * q] + bflo(gr[r + 2][q]) * mn * wg[2][2 * q];
                const float ga1 = bfhi(gr[r][q]) * mp * wg[0][2 * q + 1] + bfhi(gr[r + 1][q]) * wg[1][2 * q + 1] + bfhi(gr[r + 2][q]) * mn * wg[2][2 * q + 1];
                const float u0 = bflo(ur[r][q]) * mp * wu[0][2 * q] + bflo(ur[r + 1][q]) * wu[1][2 * q] + bflo(ur[r + 2][q]) * mn * wu[2][2 * q];
                const float u1 = bfhi(ur[r][q]) * mp * wu[0][2 * q + 1] + bfhi(ur[r + 1][q]) * wu[1][2 * q + 1] + bfhi(ur[r + 2][q]) * mn * wu[2][2 * q + 1];
                o[q] = pk2(ga0 / (1.f + __expf(-ga0)) * u0, ga1 / (1.f + __expf(-ga1)) * u1);
            }
            *(v4u*)(ACT + (size_t)(m0 + r) * DFF + j0) = o;
        }
    }
}

namespace attn_body {
using bf16=__hip_bfloat16;
using bf16x8=__attribute__((ext_vector_type(8)))short;
using s16x4=__attribute__((ext_vector_type(4)))short;
using f32x16=__attribute__((ext_vector_type(16)))float;
using u32x4=__attribute__((ext_vector_type(4)))unsigned;
constexpr int D=64,QP=768,OP=1024;
constexpr int NW=8,QBLK=32,QB=QBLK*NW,KVBLK=64;
constexpr int ATTN_UNIT_ROWS=QB;
__device__ __forceinline__ int crow(int r,int hi){return (r&3)+8*(r>>2)+4*hi;}
#define SBAR() __builtin_amdgcn_sched_barrier(0)
constexpr int NSLOT=3, SLOTB=8192;
constexpr int LDS_K=0, LDS_V=NSLOT*SLOTB, LDS_WS=2*NSLOT*SLOTB, LDS_OST=LDS_WS+NW*64*4, LDS_BYTES=LDS_OST+NW*4096;
__device__ __forceinline__ void glds16(const void*gsrc,unsigned lds_dst){unsigned keep;
  asm volatile("s_mov_b32 %0, m0\n\ts_mov_b32 m0, %2\n\ts_nop 0\n\tglobal_load_lds_dwordx4 %1, off\n\ts_mov_b32 m0, %0":"=&s"(keep):"v"(gsrc),"s"(lds_dst):"memory");}
__device__ __forceinline__ float max3f(float a,float b,float c){float r;asm("v_max3_f32 %0, %1, %2, %3":"=v"(r):"v"(a),"v"(b),"v"(c));return r;}
__device__ __forceinline__ float max2f(float a,float b){float r;asm("v_max_f32_e32 %0, %1, %2":"=v"(r):"v"(a),"v"(b));return r;}
__device__ __forceinline__ float fadd_s(float a,float b){float r;asm("v_add_f32_e32 %0, %1, %2":"=v"(r):"v"(a),"v"(b));return r;}
__device__ __forceinline__ float fsub_s(float a,float b){float r;asm("v_sub_f32_e32 %0, %1, %2":"=v"(r):"v"(a),"v"(b));return r;}
typedef float f32x2_t __attribute__((ext_vector_type(2))); typedef __bf16 bf16x2_t __attribute__((ext_vector_type(2)));
__device__ __forceinline__ unsigned cvtpk_s(float lo,float hi){f32x2_t v={lo,hi};bf16x2_t b=__builtin_convertvector(v,bf16x2_t);return __builtin_bit_cast(unsigned,b);}
#define WAIT_BAR(N) asm volatile("s_waitcnt vmcnt(" #N ") lgkmcnt(0)\n\ts_barrier":::"memory")

__device__ __forceinline__ void qkt(f32x16&p0,f32x16&p1,const char*Kslot,const bf16x8*qr,const f32x16&negm,int r32,int hi){
  const char*kb=Kslot+hi*1024+r32*16;
  #pragma unroll
  for(int d0=0;d0<4;++d0){
    const bf16x8 b0=*reinterpret_cast<const bf16x8*>(kb+d0*2048);
    const bf16x8 b1=*reinterpret_cast<const bf16x8*>(kb+d0*2048+512);
    if(d0==0){p0=__builtin_amdgcn_mfma_f32_32x32x16_bf16(b0,qr[0],negm,0,0,0);p1=__builtin_amdgcn_mfma_f32_32x32x16_bf16(b1,qr[0],negm,0,0,0);}
    else{p0=__builtin_amdgcn_mfma_f32_32x32x16_bf16(b0,qr[d0],p0,0,0,0);p1=__builtin_amdgcn_mfma_f32_32x32x16_bf16(b1,qr[d0],p1,0,0,0);}}
}
typedef __attribute__((address_space(3))) const char* lds_cptr;
typedef short v4i16_t __attribute__((ext_vector_type(4)));
__device__ __forceinline__ void kload8(bf16x8*kf,lds_cptr kp){
  kf[0]=*(const __attribute__((address_space(3))) bf16x8*)(kp);      kf[1]=*(const __attribute__((address_space(3))) bf16x8*)(kp+512);
  kf[2]=*(const __attribute__((address_space(3))) bf16x8*)(kp+2048); kf[3]=*(const __attribute__((address_space(3))) bf16x8*)(kp+2560);
  kf[4]=*(const __attribute__((address_space(3))) bf16x8*)(kp+4096); kf[5]=*(const __attribute__((address_space(3))) bf16x8*)(kp+4608);
  kf[6]=*(const __attribute__((address_space(3))) bf16x8*)(kp+6144); kf[7]=*(const __attribute__((address_space(3))) bf16x8*)(kp+6656);
}
__device__ __forceinline__ void kload2(bf16x8*kf,lds_cptr kp,int j){ kf[2*j]=*(const __attribute__((address_space(3))) bf16x8*)(kp+j*2048); kf[2*j+1]=*(const __attribute__((address_space(3))) bf16x8*)(kp+j*2048+512); }
__device__ __forceinline__ s16x4 vtr(lds_cptr p){ return __builtin_bit_cast(s16x4,__builtin_amdgcn_ds_read_tr16_b64_v4i16((__attribute__((address_space(3))) v4i16_t*)p)); }
__device__ __forceinline__ float rowmax(const f32x16&p0,const f32x16&p1){
  float a=max3f(p0[0],p0[1],p1[0]),b=max3f(p0[2],p0[3],p1[1]);a=max3f(a,p1[2],p1[3]);
  #pragma unroll
  for(int r=4;r<16;r+=4){a=max3f(a,p0[r],p0[r+1]);b=max3f(b,p0[r+2],p0[r+3]);a=max3f(a,p1[r],p1[r+1]);b=max3f(b,p1[r+2],p1[r+3]);}
  const float m=max2f(a,b);
  auto rr=__builtin_amdgcn_permlane32_swap(__float_as_uint(m),__float_as_uint(m),false,false);
  return max2f(__uint_as_float(rr[0]),__uint_as_float(rr[1]));
}
__device__ __forceinline__ void pv(f32x16*o,int vb,bf16x8 pa0,bf16x8 pa1,bf16x8 pa2,bf16x8 pa3){
  #pragma unroll
  for(int d0=0;d0<2;++d0){s16x4 lo[4],hi[4];
    #pragma unroll
    for(int ks=0;ks<4;++ks){
      asm volatile("ds_read_b64_tr_b16 %0,%1 offset:%c2":"=&v"(lo[ks]):"v"(vb),"i"(d0*4096+ks*1024):"memory");
      asm volatile("ds_read_b64_tr_b16 %0,%1 offset:%c2":"=&v"(hi[ks]):"v"(vb),"i"(d0*4096+ks*1024+512):"memory");}
    asm volatile("s_waitcnt lgkmcnt(0)":::"memory");SBAR();
    #define PK(k) (bf16x8){lo[k][0],lo[k][1],lo[k][2],lo[k][3],hi[k][0],hi[k][1],hi[k][2],hi[k][3]}
    o[d0]=__builtin_amdgcn_mfma_f32_32x32x16_bf16(pa0,PK(0),o[d0],0,0,0);
    o[d0]=__builtin_amdgcn_mfma_f32_32x32x16_bf16(pa1,PK(1),o[d0],0,0,0);
    o[d0]=__builtin_amdgcn_mfma_f32_32x32x16_bf16(pa2,PK(2),o[d0],0,0,0);
    o[d0]=__builtin_amdgcn_mfma_f32_32x32x16_bf16(pa3,PK(3),o[d0],0,0,0);
    #undef PK
  }
}

#ifndef ATTN_STORE16
#define ATTN_STORE16(p,v) (*(u32x4*)(p)=(v))
#endif
template<int THRL> __device__ __forceinline__ void attn_unit(const bf16*Qu,const bf16*__restrict__ Kh,const bf16*__restrict__ Vh,bf16*Ou,const int NT,char*shm){
  const int tid=threadIdx.x,lane=tid&63,r32=lane&31,hi=lane>>5; const int wid=__builtin_amdgcn_readfirstlane(tid>>6);
  const bf16*Qw=Qu+(long)(wid*QBLK)*QP;
  const unsigned lds0=(unsigned)(uintptr_t)shm;
  float*wsf=(float*)(shm+LDS_WS)+wid*64;
  const bf16*ksrc=Kh+(long)lane*QP+wid*8;
  const bf16*vsrc=Vh+(long)(16*(wid&3)+(lane>>2))*QP+(wid>>2)*32+(lane&3)*8;
  const unsigned kdst=lds0+LDS_K+wid*1024, vdst=lds0+LDS_V+wid*1024;
  #define DMA_K(t,slot) glds16(ksrc+(long)(t)*KVBLK*QP,(unsigned)__builtin_amdgcn_readfirstlane(kdst+(slot)))
  #define DMA_V(t,slot) glds16(vsrc+(long)(t)*KVBLK*QP,(unsigned)__builtin_amdgcn_readfirstlane(vdst+(slot)))
  const int vb0=(int)(lds0+LDS_V)+((lane>>4)&1)*32+(lane&3)*8+(4*hi+((lane&15)>>2))*64;
  const char*Kbase=shm+LDS_K; bf16x8 kf[8];
  const lds_cptr shm3=(lds_cptr)shm; const lds_cptr kp0=shm3+LDS_K+hi*1024+r32*16; const lds_cptr vp0=shm3+LDS_V+((lane>>4)&1)*32+(lane&3)*8+(4*hi+((lane&15)>>2))*64;
  DMA_K(0,0);DMA_V(0,0);DMA_K(1,SLOTB);
  bf16x8 qr[4];
  #pragma unroll
  for(int d0=0;d0<4;++d0)qr[d0]=*reinterpret_cast<const bf16x8*>(&Qw[(long)r32*QP+d0*16+hi*8]);
  float mhat=0.f,l_reg=0.f;f32x16 o[2];o[0]=f32x16{};o[1]=f32x16{};f32x16 negm=f32x16{};asm volatile("":"+v"(negm));
  #define CMASK(P0,P1,t) do{}while(0)
  bool resc=false;
  #define START(P0,P1) do{ const float rm=rowmax(P0,P1); resc=false; \
    { const float dl=rm; mhat=fadd_s(mhat,dl); \
      _Pragma("unroll") for(int r=0;r<16;++r){P0[r]=fsub_s(P0[r],dl);P1[r]=fsub_s(P1[r],dl);} \
      _Pragma("unroll") for(int r=0;r<16;++r)negm[r]=-mhat; asm volatile("":"+v"(negm)); } \
    _Pragma("unroll") for(int r=0;r<16;++r)P0[r]=__builtin_amdgcn_exp2f(P0[r]); }while(0)
  #define RESC() do{ if(resc){ asm volatile("s_waitcnt lgkmcnt(0)":::"memory"); \
      _Pragma("unroll") for(int d_=0;d_<2;++d_) _Pragma("unroll") for(int r=0;r<16;++r)o[d_][r]*=wsf[crow(r,hi)]; } }while(0)
  f32x16 pA0,pA1,pB0,pB1;
  int sl_prev=0,sl_cur=0,sl_next=SLOTB;
  #define ROT() do{sl_prev=sl_cur;sl_cur=sl_next;sl_next=(sl_next==(NSLOT-1)*SLOTB)?0:sl_next+SLOTB;}while(0)
  DMA_K(2,2*SLOTB);
  WAIT_BAR(3);
  qkt(pA0,pA1,Kbase,qr,negm,r32,hi);asm volatile("s_nop 15\n\ts_nop 7":"+v"(pA0),"+v"(pA1));CMASK(pA0,pA1,0);
  START(pA0,pA1);
  _Pragma("unroll") for(int r=0;r<16;++r)pA1[r]=__builtin_amdgcn_exp2f(pA1[r]);
  WAIT_BAR(0);
  DMA_K(3,0);DMA_V(1,SLOTB);
  ROT();
  kload8(kf,kp0+sl_cur);
  WAIT_BAR(2);
  s16x4 vlo[8],vhi[8]; u32x4 pw0,pw1,pw2,pw3;
  #define PKW(P,B) cvtpk_s(P[B],P[B+1])
  #define PAF(k) __builtin_bit_cast(bf16x8,pw##k)
  #define VFR(i) (bf16x8){vlo[i][0],vlo[i][1],vlo[i][2],vlo[i][3],vhi[i][0],vhi[i][1],vhi[i][2],vhi[i][3]}
  #define PIN(x) asm volatile("":"+v"(x))
  #define MX3(a,b,c) __builtin_fmaxf(__builtin_fmaxf((a),(b)),(c))
  #define GAPA(MF,A0,A1,A2,A3,W0,W1,PW) do{ MF; sacc+=A0; sacc+=A1; sacc+=A2; sacc+=A3; PIN(sacc); W0; W1; PIN(PW); SBAR(); }while(0)
  #define EX(v) __builtin_amdgcn_exp2f(v)
  #define GAPB(MF,X,B) do{ MF; X[B]=EX(X[B]); X[B+1]=EX(X[B+1]); X[B+2]=EX(X[B+2]); X[B+3]=EX(X[B+3]); PIN(X); SBAR(); }while(0)
  #define VRD(i) do{ vlo[i]=vtr(vp_+(((i)>>2)*4096+((i)&3)*1024)); vhi[i]=vtr(vp_+(((i)>>2)*4096+((i)&3)*1024+512)); }while(0)
  #define KRD(G,j) do{ if(G){ kload2(kf,kp0+sl_next,j); SBAR(); } }while(0)
  #define STEP(C0,C1,P0,P1,t,GK,GV,GL) do{ SBAR(); \
    const lds_cptr vp_=vp0+sl_prev; \
    VRD(0); SBAR(); float sacc=(P0[0]+P0[1]); \
    GAPA(C0=__builtin_amdgcn_mfma_f32_32x32x16_bf16(kf[0],qr[0],negm,0,0,0), P0[2],P0[3],P0[4],P0[5],     pw0[0]=PKW(P0,0), pw0[1]=PKW(P0,2), pw0); \
    VRD(4); SBAR(); GAPA(C1=__builtin_amdgcn_mfma_f32_32x32x16_bf16(kf[1],qr[0],negm,0,0,0), P0[6],P0[7],P0[8],P0[9],     pw0[2]=PKW(P0,4), pw0[3]=PKW(P0,6), pw0); \
    VRD(1); SBAR(); GAPA(C0=__builtin_amdgcn_mfma_f32_32x32x16_bf16(kf[2],qr[1],C0,0,0,0),   P0[10],P0[11],P0[12],P0[13], pw1[0]=PKW(P0,8), pw1[1]=PKW(P0,10), pw1); \
    VRD(5); SBAR(); GAPA(C1=__builtin_amdgcn_mfma_f32_32x32x16_bf16(kf[3],qr[1],C1,0,0,0),   P0[14],P0[15],P1[0],P1[1],   pw1[2]=PKW(P0,12),pw1[3]=PKW(P0,14), pw1); \
    VRD(2); SBAR(); GAPA(C0=__builtin_amdgcn_mfma_f32_32x32x16_bf16(kf[4],qr[2],C0,0,0,0),   P1[2],P1[3],P1[4],P1[5],     pw2[0]=PKW(P1,0), pw2[1]=PKW(P1,2), pw2); \
    VRD(6); SBAR(); GAPA(C1=__builtin_amdgcn_mfma_f32_32x32x16_bf16(kf[5],qr[2],C1,0,0,0),   P1[6],P1[7],P1[8],P1[9],     pw2[2]=PKW(P1,4), pw2[3]=PKW(P1,6), pw2); \
    VRD(3); SBAR(); GAPA(C0=__builtin_amdgcn_mfma_f32_32x32x16_bf16(kf[6],qr[3],C0,0,0,0),   P1[10],P1[11],P1[12],P1[13], pw3[0]=PKW(P1,8), pw3[1]=PKW(P1,10), pw3); \
    VRD(7); SBAR(); GAPA(C1=__builtin_amdgcn_mfma_f32_32x32x16_bf16(kf[7],qr[3],C1,0,0,0),   P1[14],P1[15],0.f,0.f,       pw3[2]=PKW(P1,12),pw3[3]=PKW(P1,14), pw3); \
    l_reg+=sacc; \
    if(GK){DMA_K((t)+3,sl_cur);} if(GV){DMA_V((t)+1,sl_next);} \
    CMASK(C0,C1,t); \
    { float a=MX3(C0[0],C0[1],C1[0]),b=MX3(C0[2],C0[3],C1[1]); a=MX3(a,C1[2],C1[3]); \
      _Pragma("unroll") for(int r=4;r<16;r+=4){a=MX3(a,C0[r],C0[r+1]);b=MX3(b,C0[r+2],C0[r+3]);a=MX3(a,C1[r],C1[r+1]);b=MX3(b,C1[r+2],C1[r+3]);} \
      float rm=__builtin_fmaxf(a,b); { auto rr=__builtin_amdgcn_permlane32_swap(__float_as_uint(rm),__float_as_uint(rm),false,false); rm=__builtin_fmaxf(__uint_as_float(rr[0]),__uint_as_float(rr[1])); } \
      resc=false; \
      if(__builtin_expect(__any(rm>(float)THRL),0)){ const float dl=__builtin_fmaxf(rm,0.f); mhat+=dl; \
        _Pragma("unroll") for(int r=0;r<16;++r){C0[r]-=dl;C1[r]-=dl;} \
        _Pragma("unroll") for(int r=0;r<16;++r)negm[r]=-mhat; asm volatile("":"+v"(negm)); \
        const float f=__builtin_amdgcn_exp2f(-dl); l_reg*=f; if(hi==0)wsf[r32]=f; resc=true; } } \
    SBAR(); \
    GAPB(o[0]=__builtin_amdgcn_mfma_f32_32x32x16_bf16(PAF(0),VFR(0),o[0],0,0,0), C0,0); \
    GAPB(o[1]=__builtin_amdgcn_mfma_f32_32x32x16_bf16(PAF(0),VFR(4),o[1],0,0,0), C0,4); \
    KRD(GL,0); GAPB(o[0]=__builtin_amdgcn_mfma_f32_32x32x16_bf16(PAF(1),VFR(1),o[0],0,0,0), C0,8); \
    KRD(GL,1); GAPB(o[1]=__builtin_amdgcn_mfma_f32_32x32x16_bf16(PAF(1),VFR(5),o[1],0,0,0), C0,12); \
    KRD(GL,2); GAPB(o[0]=__builtin_amdgcn_mfma_f32_32x32x16_bf16(PAF(2),VFR(2),o[0],0,0,0), C1,0); \
    KRD(GL,3); GAPB(o[1]=__builtin_amdgcn_mfma_f32_32x32x16_bf16(PAF(2),VFR(6),o[1],0,0,0), C1,4); \
    GAPB(o[0]=__builtin_amdgcn_mfma_f32_32x32x16_bf16(PAF(3),VFR(3),o[0],0,0,0), C1,8); \
    GAPB(o[1]=__builtin_amdgcn_mfma_f32_32x32x16_bf16(PAF(3),VFR(7),o[1],0,0,0), C1,12); \
    }while(0)
  int t=1;
  for(;t+5<NT;t+=2){
    STEP(pB0,pB1,pA0,pA1,t,true,true,true);     WAIT_BAR(2); RESC(); ROT();
    STEP(pA0,pA1,pB0,pB1,t+1,true,true,true);   WAIT_BAR(2); RESC(); ROT();
  }
  #define ENDW(tt) do{ if((tt)+3<NT){WAIT_BAR(2);} else if((tt)+2<NT){WAIT_BAR(1);} else {WAIT_BAR(0);} }while(0)
  for(;t+1<NT;t+=2){
    STEP(pB0,pB1,pA0,pA1,t,(t+3<NT),(t+1<NT),(t+1<NT));       ENDW(t);   RESC(); ROT();
    STEP(pA0,pA1,pB0,pB1,t+1,(t+4<NT),(t+2<NT),(t+2<NT));     ENDW(t+1); RESC(); ROT();
  }
  STEP(pB0,pB1,pA0,pA1,NT-1,false,false,false); RESC();
  { float sacc=pB0[0]+pB0[1]; _Pragma("unroll") for(int r=2;r<16;++r)sacc+=pB0[r]; _Pragma("unroll") for(int r=0;r<16;++r)sacc+=pB1[r]; l_reg+=sacc;
    pw0=(u32x4){PKW(pB0,0),PKW(pB0,2),PKW(pB0,4),PKW(pB0,6)};pw1=(u32x4){PKW(pB0,8),PKW(pB0,10),PKW(pB0,12),PKW(pB0,14)};pw2=(u32x4){PKW(pB1,0),PKW(pB1,2),PKW(pB1,4),PKW(pB1,6)};pw3=(u32x4){PKW(pB1,8),PKW(pB1,10),PKW(pB1,12),PKW(pB1,14)};
    SBAR(); pv(o,vb0+sl_cur,PAF(0),PAF(1),PAF(2),PAF(3)); }
  #undef PKW
  #undef PAF
  #undef VFR
  #undef PIN
  #undef MX3
  #undef GAPA
  #undef GAPB
  #undef EX
  #undef VRD
  #undef KRD
  #undef STEP
  #undef ENDW
  {auto rr=__builtin_amdgcn_permlane32_swap(__float_as_uint(l_reg),__float_as_uint(l_reg),false,false);l_reg=__uint_as_float(rr[0])+__uint_as_float(rr[1]);}
  if(hi==0)wsf[32+r32]=l_reg;asm volatile("s_waitcnt lgkmcnt(0)":::"memory");
  float rli[16];
  #pragma unroll
  for(int r=0;r<16;++r)rli[r]=__builtin_amdgcn_rcpf(wsf[32+crow(r,hi)]);
  bf16*Ow=Ou+(long)(wid*QBLK)*OP;
  { bf16*stg=(bf16*)(shm+LDS_OST)+wid*2048;
    #pragma unroll
    for(int r=0;r<16;++r){const int orow=crow(r,hi);
      #pragma unroll
      for(int d0=0;d0<2;++d0)stg[orow*64+d0*32+r32]=__float2bfloat16(o[d0][r]*rli[r]);}
    asm volatile("s_waitcnt lgkmcnt(0)":::"memory");
    #pragma unroll
    for(int i=0;i<4;++i){const int row=i*8+(lane>>3),ch=lane&7; const u32x4 v=*(const u32x4*)(stg+row*64+ch*8); ATTN_STORE16(Ow+(long)row*OP+ch*8,v);} }
  asm volatile("s_waitcnt lgkmcnt(0)\n\ts_barrier":::"memory");
  #undef DMA_K
  #undef DMA_V
  #undef CMASK
  #undef START
  #undef RESC
  #undef ROT
}
constexpr int ATTN_LDS_BYTES=LDS_BYTES;
#undef SBAR
#undef WAIT_BAR
}

__device__ __forceinline__ void attn_phase(const Frame& F, int l) {
    typedef attn_body::bf16 abf;
    const abf* U = (const abf*)(F.ws + WS_AR + AR_QKV); abf* MIX = (abf*)(F.ws + WS_AR + AR_MIX);
    char* shm = (char*)F.lds;
    for (int u = F.bid; u < 512; u += F.G) {
        const int pair = u & 7, j = u >> 3, b = pair >> 1, kvh = pair & 1, h = kvh * 4 + (j >> 4), qb = j & 15;
        const size_t r0 = (size_t)b * SB, q0 = r0 + CT + (size_t)qb * 256;
        attn_body::attn_unit<8>(U + q0 * QKVP + h * 64, U + r0 * QKVP + K_OFF + kvh * 64, U + r0 * QKVP + V_OFF + kvh * 64, MIX + q0 * D + h * 64, SB / 64, shm);
    }
    if (l + 1 < NL) {
        for (int u = F.bid; u < 32; u += F.G) {
            const int pair = u & 7, b = pair >> 1, kvh = pair & 1, h = kvh * 4 + (u >> 3);
            const size_t r0 = (size_t)b * SB;
            attn_body::attn_unit<8>(U + r0 * QKVP + h * 64, U + r0 * QKVP + K_OFF + kvh * 64, U + r0 * QKVP + V_OFF + kvh * 64, MIX + r0 * D + h * 64, CT / 64, shm);
        }
    }
}

constexpr int SC_STEP_F = 352, SC_CH = 32, SC_BUF_F = SC_CH * SC_STEP_F  , SC_OUT_OFF = 2 * SC_BUF_F * 4  ;
__device__ __forceinline__ int scan_row(int s, int dir) { return s < CT ? (dir ? CT - 1 - s : s) : (dir ? CT + (TL - 1 - (s - CT)) : s); }
__device__ __forceinline__ void scan_task(const Frame& F, int task) {
    const int x = task & 7, t = task >> 3, bh = 2 * x + (t >> 2), b = bh >> 2, h = bh & 3, dir = (t >> 1) & 1, half = t & 1;
    const size_t rb = (size_t)b * SB, dofs = (size_t)dir * M * 256;
    const int col0 = h * 64;
    const float* Wg = (const float*)(F.ws + WS_AR + AR_W) + dofs;
    const bf16* KKg = (const bf16*)(F.ws + WS_AR + AR_KK); const bf16* KKAg = (const bf16*)(F.ws + WS_AR + AR_KKA) + dofs; const bf16* KEg = (const bf16*)(F.ws + WS_AR + AR_KE) + dofs;
    const bf16* Rg = (const bf16*)(F.ws + WS_AR + AR_R); const bf16* Vg = (const bf16*)(F.ws + WS_AR + AR_V);
    float* Yg = (float*)(F.ws + WS_AR + AR_Y) + dofs;
    LAS float* ring = (LAS float*)F.lds; LAS float* outb = (LAS float*)(F.lds + SC_OUT_OFF);
    constexpr int NCH = SB / SC_CH;
    const int tid = F.tid;
    const int lst = tid >> 4, lk4 = (tid & 15) * 4;
    const int vst = (tid & 255) >> 3, vr4 = (tid & 7) * 4;
    f32x4 lw; v2u l1, l2, l3, l4, lv;
#define SC_ISSUE(c) do { const size_t g_ = (rb + scan_row((c) * SC_CH + lst, dir)) * 256 + col0 + lk4; \
        lw = *(const f32x4*)(Wg + g_); l1 = *(const v2u*)(KKg + g_); l2 = *(const v2u*)(KKAg + g_); l3 = *(const v2u*)(KEg + g_); l4 = *(const v2u*)(Rg + g_); \
        if (tid < 256) lv = *(const v2u*)(Vg + (rb + scan_row((c) * SC_CH + vst, dir)) * 256 + col0 + half * 32 + vr4); } while (0)
#define SC_COMMIT(c) do { LAS float* d_ = ring + ((c) & 1) * SC_BUF_F + lst * SC_STEP_F + lk4; \
        *(LAS f32x4*)(d_) = (f32x4){__expf(lw[0]), __expf(lw[1]), __expf(lw[2]), __expf(lw[3])}; \
        *(LAS f32x4*)(d_ + 64) = (f32x4){bflo(l1.x), bfhi(l1.x), bflo(l1.y), bfhi(l1.y)}; \
        *(LAS f32x4*)(d_ + 128) = (f32x4){bflo(l2.x), bfhi(l2.x), bflo(l2.y), bfhi(l2.y)}; \
        *(LAS f32x4*)(d_ + 192) = (f32x4){bflo(l3.x), bfhi(l3.x), bflo(l3.y), bfhi(l3.y)}; \
        *(LAS f32x4*)(d_ + 256) = (f32x4){bflo(l4.x), bfhi(l4.x), bflo(l4.y), bfhi(l4.y)}; \
        if (tid < 256) *(LAS f32x4*)(ring + ((c) & 1) * SC_BUF_F + vst * SC_STEP_F + 320 + vr4) = (f32x4){bflo(lv.x), bfhi(lv.x), bflo(lv.y), bfhi(lv.y)}; } while (0)
#define SC_FLUSH(c) do { if (tid < 256) { const f32x4 v_ = *(const LAS f32x4*)(outb + ((c) & 1) * (SC_CH * 32) + vst * 32 + vr4); \
        *(f32x4*)(Yg + (rb + scan_row((c) * SC_CH + vst, dir)) * 256 + col0 + half * 32 + vr4) = v_; } } while (0)
    SC_ISSUE(0); SC_COMMIT(0);
    __syncthreads();
    const int i = (F.lane >> 4), j = F.lane & 15, wv = F.wave;
    float S0[4] = {0.f, 0.f, 0.f, 0.f};
    for (int c = 0; c < NCH; ++c) {
        if (c + 1 < NCH) SC_ISSUE(c + 1);
        if (c >= 1) SC_FLUSH(c - 1);
        {
            const LAS float* base = ring + (c & 1) * SC_BUF_F + 4 * j;
            const LAS float* vb = ring + (c & 1) * SC_BUF_F + 320 + wv * 4 + i;
            LAS float* ob = outb + (c & 1) * (SC_CH * 32) + wv * 4 + i;
#pragma unroll 8
            for (int s = 0; s < SC_CH; ++s) {
                const LAS float* p = base + s * SC_STEP_F;
                const f32x4 w4 = *(const LAS f32x4*)(p), kk4 = *(const LAS f32x4*)(p + 64), ka4 = *(const LAS f32x4*)(p + 128), ke4 = *(const LAS f32x4*)(p + 192), r4 = *(const LAS f32x4*)(p + 256);
                const float v0 = vb[s * SC_STEP_F];
                float sa0 = S0[0] * kk4[0];
#pragma unroll
                for (int e = 1; e < 4; ++e) sa0 += S0[e] * kk4[e];
                sa0 = red16(sa0);
                float y0 = 0.f;
#pragma unroll
                for (int e = 0; e < 4; ++e) { S0[e] = S0[e] * w4[e] + (v0 * ke4[e] - sa0 * ka4[e]); y0 += S0[e] * r4[e]; }
                y0 = red16(y0);
                if (j == 0) ob[s * 32] = y0;
            }
        }
        if (c + 1 < NCH) SC_COMMIT(c + 1);
        __syncthreads();
    }
    SC_FLUSH(NCH - 1);
    __syncthreads();
#undef SC_ISSUE
#undef SC_COMMIT
#undef SC_FLUSH
}

typedef short sbf8 __attribute__((ext_vector_type(8)));
constexpr int CH_LD = 72;
constexpr int CA_LL = 0, CA_GT = 16384, CA_GC = 129536, CA_MA = 18944, CA_NKV = CA_MA + 18432, CA_MT = 55808, CA_MN = 83456, CA_MW = 111104;
constexpr int NA_LD = 68, TB_LD = 17;
constexpr int NCHUNK = SB / 64;
constexpr size_t SCA_PT = 0, SCA_RY = (size_t)32 * NCHUNK * 4096 * 2, SCA_Q = 2 * SCA_RY, SCA_END = SCA_Q + (size_t)32 * NCHUNK * 4096 * 4;
static_assert(SCA_END <= (size_t)M * NINP * 2, "stage-A outputs fit the U region");
__device__ __forceinline__ f32x4 mma_nt64(const LAS bf16* A, const LAS bf16* B, int ti, int tj, int fr, int fq, f32x4 acc) {
#pragma unroll
    for (int kb = 0; kb < 2; ++kb) {
        const sbf8 a = *(const LAS sbf8*)(A + (16 * ti + fr) * CH_LD + kb * 32 + 8 * fq);
        const sbf8 b = *(const LAS sbf8*)(B + (16 * tj + fr) * CH_LD + kb * 32 + 8 * fq);
        acc = __builtin_amdgcn_mfma_f32_16x16x32_bf16(a, b, acc, 0, 0, 0);
    }
    return acc;
}
__device__ __forceinline__ float quad_sum(float x) {
    float r;
    asm("s_nop 1\n\tv_add_f32_dpp %0, %1, %1 quad_perm:[1,0,3,2] row_mask:0xf bank_mask:0xf\n\ts_nop 1\n\t"
        "v_add_f32_dpp %0, %0, %0 quad_perm:[2,3,0,1] row_mask:0xf bank_mask:0xf\n\ts_nop 0" : "=&v"(r) : "v"(x));
    return r;
}
struct AIn { f32x4 lw0, lw1; v4u kk, ka, ke, rr; };
__device__ __forceinline__ void scanA_issue(const Frame& F, int ch, int c, AIn& in) {
    const int dir = ch >> 4, b = (ch >> 2) & 3, h = ch & 3;
    const size_t rb = (size_t)b * SB, dofs = (size_t)dir * M * 256; const int col0 = h * 64, s_base = c * 64, tid = F.tid;
    size_t z_ = 0; asm volatile("" : "+s"(z_));
    unsigned char* wsb = F.ws + z_;
    const float* LWg = (const float*)(wsb + WS_AR + AR_W) + dofs;
    const bf16* KKg = (const bf16*)(wsb + WS_AR + AR_KK); const bf16* KAg = (const bf16*)(wsb + WS_AR + AR_KKA) + dofs; const bf16* KEg = (const bf16*)(wsb + WS_AR + AR_KE) + dofs;
    const bf16* Rg = (const bf16*)(wsb + WS_AR + AR_R); const bf16* Vg = (const bf16*)(wsb + WS_AR + AR_V);
    { const int t = tid >> 3, k0 = (tid & 7) * 8; const size_t g = (rb + scan_row(s_base + t, dir)) * 256 + col0 + k0;
      in.lw0 = *(const f32x4*)(LWg + g); in.lw1 = *(const f32x4*)(LWg + g + 4);
      in.kk = *(const v4u*)(KKg + g); in.ka = *(const v4u*)(KAg + g); in.ke = *(const v4u*)(KEg + g); in.rr = *(const v4u*)(Rg + g); }
}
__device__ __forceinline__ void scanA_task(const Frame& F, int ch, int c, float* Y0dst, size_t y0_row_stride_sel  , AIn& in, bool has_next, int nch, int nc) {
    const int dir = ch >> 4, b = (ch >> 2) & 3, h = ch & 3;
    const size_t rb = (size_t)b * SB, dofs = (size_t)dir * M * 256; const int col0 = h * 64;
    const float* LWg = (const float*)(F.ws + WS_AR + AR_W) + dofs;
    const bf16* KKg = (const bf16*)(F.ws + WS_AR + AR_KK); const bf16* KAg = (const bf16*)(F.ws + WS_AR + AR_KKA) + dofs; const bf16* KEg = (const bf16*)(F.ws + WS_AR + AR_KE) + dofs;
    const bf16* Rg = (const bf16*)(F.ws + WS_AR + AR_R); const bf16* Vg = (const bf16*)(F.ws + WS_AR + AR_V);
    unsigned char* ob = F.ws + WS_AR + AR_U; const size_t tsk = (size_t)ch * NCHUNK + c;
    bf16* PTg = (bf16*)(ob + SCA_PT) + tsk * 4096; bf16* RYg = (bf16*)(ob + SCA_RY) + tsk * 4096; float* Qg = (float*)(ob + SCA_Q) + tsk * 4096;
    LAS float* LL = (LAS float*)(F.lds + CA_LL); LAS float* GT = (LAS float*)(F.lds + CA_GT); LAS float* GC = (LAS float*)(F.lds + CA_GC);
    LAS bf16* KKG = (LAS bf16*)(F.lds + CA_MA); LAS bf16* RG = KKG + 64 * CH_LD; LAS bf16* AG = RG + 64 * CH_LD; LAS bf16* KG = AG + 64 * CH_LD;
    LAS float* NKV = (LAS float*)(F.lds + CA_NKV);
    LAS bf16* AHT = (LAS bf16*)(F.lds + CA_MT); LAS bf16* KHT = AHT + 64 * CH_LD; LAS bf16* VT = KHT + 64 * CH_LD;
    LAS bf16* NK = (LAS bf16*)(F.lds + CA_MN); LAS bf16* MA = NK + 64 * CH_LD; LAS bf16* MK = MA + 64 * CH_LD;
    LAS bf16* W1T = (LAS bf16*)(F.lds + CA_MW); LAS bf16* W2T = W1T + 64 * CH_LD;
    const int tid = F.tid, lane = F.lane, wv = F.wave, fr = lane & 15, fq = lane >> 4;
    const int s_base = c * 64;
    for (int rep1 = 0; rep1 < (SCANA_REP == 1 ? 2 : 1); ++rep1) {
    { const int t = tid >> 3, k0 = (tid & 7) * 8;
      *(LAS f32x4*)(LL + t * 64 + k0) = in.lw0; *(LAS f32x4*)(LL + t * 64 + k0 + 4) = in.lw1; }
    LDS_BARRIER();
    { const int k = tid & 63, g = tid >> 6; float v[8];
#pragma unroll
      for (int j = 0; j < 8; ++j) v[j] = LL[(8 * g + j) * 64 + k];
#pragma unroll
      for (int j = 1; j < 8; ++j) v[j] += v[j - 1];
      GT[g * 64 + k] = v[7];
      LDS_BARRIER();
      float off = 0.f;
#pragma unroll
      for (int g2 = 0; g2 < 7; ++g2) off += (g2 < g) ? GT[g2 * 64 + k] : 0.f;
#pragma unroll
      for (int j = 0; j < 8; ++j) LL[(8 * g + j) * 64 + k] = v[j] + off; }
    LDS_BARRIER();
    }
    for (int rep2 = 0; rep2 < (SCANA_REP == 2 ? 2 : 1); ++rep2) {
    { const int t = tid >> 3, k0 = (tid & 7) * 8;
      float kk[8], ka[8], ke[8], rr[8], o1[8], o2[8], o3[8], o4[8];
      unpack8(in.kk, kk); unpack8(in.ka, ka); unpack8(in.ke, ke); unpack8(in.rr, rr);
#pragma unroll
      for (int e = 0; e < 8; ++e) { const float Lt = LL[t * 64 + k0 + e], Lp = t > 0 ? LL[(t - 1) * 64 + k0 + e] : 0.f;
          const float e3 = __expf(-Lt);
          o1[e] = kk[e] * __expf(Lp); o2[e] = rr[e] * __expf(Lt); o3[e] = ka[e] * e3; o4[e] = ke[e] * e3; }
      *(LAS v4u*)(KKG + t * CH_LD + k0) = pack8(o1); *(LAS v4u*)(RG + t * CH_LD + k0) = pack8(o2); *(LAS v4u*)(AG + t * CH_LD + k0) = pack8(o3); *(LAS v4u*)(KG + t * CH_LD + k0) = pack8(o4); }
    { const int k = tid & 63, t0 = (tid >> 6) * 8; const float LC = LL[63 * 64 + k];
      float o1[8], o2[8], o3[8];
#pragma unroll
      for (int j = 0; j < 8; ++j) { const size_t g = (rb + scan_row(s_base + t0 + j, dir)) * 256 + col0 + k;
          const float e4 = __expf(LC - LL[(t0 + j) * 64 + k]);
          o1[j] = bf2f(KAg[g]) * e4; o2[j] = bf2f(KEg[g]) * e4; o3[j] = bf2f(Vg[g]); }
      *(LAS v4u*)(AHT + k * CH_LD + t0) = pack8(o1); *(LAS v4u*)(KHT + k * CH_LD + t0) = pack8(o2); *(LAS v4u*)(VT + k * CH_LD + t0) = pack8(o3);
      if (t0 == 0) GC[k] = __expf(LC); }
    }
    LDS_BARRIER();
    if (has_next) scanA_issue(F, nch, nc, in);
    const int ti = wv & 3;
    for (int rep3 = 0; rep3 < (SCANA_REP == 3 ? 2 : 1); ++rep3)
#pragma unroll
    for (int jj = 0; jj < 2; ++jj) {
        const int tj = 2 * (wv >> 2) + jj;
        const f32x4 z4 = {0.f, 0.f, 0.f, 0.f};
        f32x4 na = z4, nk = z4, ma = z4, mk = z4;
        if (tj <= ti) { na = mma_nt64(KKG, AG, ti, tj, fr, fq, z4); nk = mma_nt64(KKG, KG, ti, tj, fr, fq, z4); ma = mma_nt64(RG, AG, ti, tj, fr, fq, z4); mk = mma_nt64(RG, KG, ti, tj, fr, fq, z4); }
        const int i = 16 * tj + fr;
#pragma unroll
        for (int rg = 0; rg < 4; ++rg) { const int t = 16 * ti + 4 * fq + rg;
            const bool lo = i < t, le = i <= t;
            LL[t * NA_LD + i] = lo ? na[rg] : 0.f;
            NK[t * CH_LD + i] = (bf16)f2bf(lo ? nk[rg] : 0.f); MA[t * CH_LD + i] = (bf16)f2bf(le ? ma[rg] : 0.f); MK[t * CH_LD + i] = (bf16)f2bf(le ? mk[rg] : 0.f); }
    }
    LDS_BARRIER();
    f32x4 mkv[2];
#pragma unroll
    for (int jj = 0; jj < 2; ++jj) {
        const int tj = 2 * (wv >> 2) + jj; const f32x4 z4 = {0.f, 0.f, 0.f, 0.f};
        const f32x4 nkv = mma_nt64(NK, VT, ti, tj, fr, fq, z4); mkv[jj] = mma_nt64(MK, VT, ti, tj, fr, fq, z4);
#pragma unroll
        for (int rg = 0; rg < 4; ++rg) NKV[(16 * ti + 4 * fq + rg) * 64 + 16 * tj + fr] = nkv[rg];
    }
    LDS_BARRIER();
    { LAS float* NaR = LL;
      LAS float* TB = (LAS float*)(F.lds + CA_MN + 18432);
      LAS float* XW = wv < 5 ? (LAS float*)(F.lds + CA_NKV) + wv * 768 : (LAS float*)(F.lds + CA_MN) + (wv - 5) * 768;
      const int col = 16 * wv + fr;
      float Rr[4][4];
#pragma unroll
      for (int bb = 0; bb < 4; ++bb)
#pragma unroll
          for (int rg = 0; rg < 4; ++rg) { const int t = 16 * bb + 4 * fq + rg; Rr[bb][rg] = wv < 4 ? bf2f(KKG[t * CH_LD + col]) : NKV[t * 64 + (col - 64)]; }
      if (wv < 4 && lane < 16) {
          const int bb = wv, c = lane; float Tc[16];
#pragma unroll
          for (int r = 0; r < 16; ++r) {
              float acc = (r == c) ? 1.f : 0.f;
#pragma unroll
              for (int i4 = 0; i4 < r; i4 += 4) { const f32x4 dv = *(const LAS f32x4*)(NaR + (16 * bb + r) * NA_LD + 16 * bb + i4);
#pragma unroll
                  for (int e = 0; e < 4; ++e) if (i4 + e < r) acc -= dv[e] * Tc[i4 + e]; }
              Tc[r] = acc; TB[(bb * 16 + r) * TB_LD + c] = acc;
          }
      }
      LDS_BARRIER();
      LAS bf16* WT = wv < 4 ? (W1T + col * CH_LD) : (W2T + (col - 64) * CH_LD);
#pragma unroll
      for (int bb = 0; bb < 4; ++bb) {
          f32x4 z = {0.f, 0.f, 0.f, 0.f};
#pragma unroll
          for (int st = 0; st < 4 * bb; ++st) z = __builtin_amdgcn_mfma_f32_16x16x4f32(NaR[(16 * bb + fr) * NA_LD + 4 * st + fq], XW[(4 * st + fq) * 16 + fr], z, 0, 0, 0);
          LAS float* RW = XW + (bb < 3 ? 16 * bb : 0) * 16;
#pragma unroll
          for (int rg = 0; rg < 4; ++rg) RW[(4 * fq + rg) * 16 + fr] = Rr[bb][rg] - z[rg];
          asm volatile("s_waitcnt lgkmcnt(0)" ::: "memory");
          f32x4 xb = {0.f, 0.f, 0.f, 0.f};
#pragma unroll
          for (int st = 0; st < 4; ++st) xb = __builtin_amdgcn_mfma_f32_16x16x4f32(TB[(bb * 16 + fr) * TB_LD + 4 * st + fq], RW[(4 * st + fq) * 16 + fr], xb, 0, 0, 0);
          asm volatile("s_waitcnt lgkmcnt(0)" ::: "memory");
          if (bb < 3) {
#pragma unroll
              for (int rg = 0; rg < 4; ++rg) XW[(16 * bb + 4 * fq + rg) * 16 + fr] = xb[rg];
          }
          v2u w_; w_.x = pk2(xb[0], xb[1]); w_.y = pk2(xb[2], xb[3]);
          *(LAS v2u*)(WT + 16 * bb + 4 * fq) = w_;
          asm volatile("s_waitcnt lgkmcnt(0)" ::: "memory");
      } }
    LDS_BARRIER();
#pragma unroll
    for (int jj = 0; jj < 2; ++jj) {
        const int tj = 2 * (wv >> 2) + jj; const f32x4 z4 = {0.f, 0.f, 0.f, 0.f};
        const f32x4 a1 = mma_nt64(MA, W1T, ti, tj, fr, fq, z4), a2 = mma_nt64(MA, W2T, ti, tj, fr, fq, z4);
        const f32x4 a3 = mma_nt64(AHT, W1T, ti, tj, fr, fq, z4);
        const f32x4 a4 = mma_nt64(VT, KHT, ti, tj, fr, fq, z4), a5 = mma_nt64(W2T, AHT, ti, tj, fr, fq, z4);
        const int cc = 16 * tj + fr;
#pragma unroll
        for (int rg = 0; rg < 4; ++rg) { const int r_ = 16 * ti + 4 * fq + rg;
            RYg[r_ * 64 + cc] = (bf16)f2bf(bf2f(RG[r_ * CH_LD + cc]) - a1[rg]);
            const size_t yrow = y0_row_stride_sel ? (size_t)(s_base + r_) : (rb + scan_row(s_base + r_, dir));
            Y0dst[((size_t)dir * (y0_row_stride_sel ? (size_t)SB : (size_t)M) + yrow) * 256 + col0 + cc] = mkv[jj][rg] - a2[rg];
            PTg[r_ * 64 + cc] = (bf16)f2bf((r_ == cc ? GC[cc] : 0.f) - a3[rg]);
            Qg[r_ * 64 + cc] = a4[rg] - a5[rg]; }
    }
    LDS_BARRIER();
}

__device__ __forceinline__ void scanA_run(const Frame& F, int ch, int c, float* Y0dst, size_t sel) { AIn in; scanA_issue(F, ch, c, in); scanA_task(F, ch, c, Y0dst, sel, in, false, 0, 0); }
constexpr int BC_RY = 0, BC_PT = 9216, BC_Q = 18432, BC_QLD = 68, BC_Y = BC_Q + 32 * BC_QLD * 4, BC_BUF = BC_Y + 64 * 32 * 4  , BC_S = 2 * BC_BUF;
__device__ __forceinline__ void scanBC_task(const Frame& F, int ch, int half, float* Ybuf, int ydebug, const float* cmp, unsigned* dmax) {
    const int dir = ch >> 4, b = (ch >> 2) & 3, h = ch & 3;
    const size_t rb = (size_t)b * SB; const int col0 = h * 64;
    unsigned char* ob = F.ws + WS_AR + AR_U;
    const bf16* PTg = (const bf16*)(ob + SCA_PT) + (size_t)ch * NCHUNK * 4096; const bf16* RYg = (const bf16*)(ob + SCA_RY) + (size_t)ch * NCHUNK * 4096;
    const float* Qg = (const float*)(ob + SCA_Q) + (size_t)ch * NCHUNK * 4096;
    LAS bf16* SB0 = (LAS bf16*)(F.lds + BC_S);
    const int tid = F.tid, lane = F.lane, wv = F.wave, fr = lane & 15, fq = lane >> 4;
    const int srb = wv & 1, scb = wv >> 1, ytb = wv & 3, yrb = wv >> 2;
    for (int i = tid; i < 2 * 32 * CH_LD / 2; i += NTHR) ((LAS unsigned*)SB0)[i] = 0u;
    float dm = 0.f;
    const int g_rp = (tid >> 3) * 64 + (tid & 7) * 8, l_rp = (tid >> 3) * CH_LD + (tid & 7) * 8;
    const int g_q = (half * 32 + (tid >> 4)) * 64 + (tid & 15) * 4, l_q = (tid >> 4) * BC_QLD + (tid & 15) * 4;
    const int y_t = tid >> 3, y_r4 = (tid & 7) * 4;
    const size_t ydir = (size_t)dir * (ydebug ? (size_t)SB : (size_t)M);
    v4u a_ry, a_pt, b_ry, b_pt; f32x4 a_q, a_y, b_q, b_y;
#define BC_LOAD(c, RYv, PTv, Qv, Yv) do { const size_t o_ = (size_t)(c) * 4096; RYv = *(const v4u*)(RYg + o_ + g_rp); PTv = *(const v4u*)(PTg + o_ + g_rp); Qv = *(const f32x4*)(Qg + o_ + g_q); \
        const int s_ = (c) * 64 + y_t; const size_t yrow_ = ydebug ? (size_t)s_ : (rb + scan_row(s_, dir)); Yv = *(const f32x4*)(Ybuf + (ydir + yrow_) * 256 + col0 + half * 32 + y_r4); } while (0)
#define BC_PARK(c, RYv, PTv, Qv, Yv) do { LAS unsigned char* d_ = F.lds + ((c) & 1) * BC_BUF; *(LAS v4u*)((LAS bf16*)(d_ + BC_RY) + l_rp) = RYv; *(LAS v4u*)((LAS bf16*)(d_ + BC_PT) + l_rp) = PTv; \
        *(LAS f32x4*)((LAS float*)(d_ + BC_Q) + l_q) = Qv; *(LAS f32x4*)((LAS float*)(d_ + BC_Y) + y_t * 32 + y_r4) = Yv; } while (0)
#define BC_STEP(c, RYv, PTv, Qv, Yv) do { \
        const LAS unsigned char* o_ = F.lds + ((c) & 1) * BC_BUF; const LAS bf16* Sc = SB0 + ((c) & 1) * 32 * CH_LD; LAS bf16* Sn = SB0 + (((c) + 1) & 1) * 32 * CH_LD; \
        const LAS bf16* RYs = (const LAS bf16*)(o_ + BC_RY); const LAS bf16* PTs = (const LAS bf16*)(o_ + BC_PT); const LAS float* Qs = (const LAS float*)(o_ + BC_Q); const LAS float* Ys = (const LAS float*)(o_ + BC_Y); \
        f32x4 yacc, sacc; \
        _Pragma("unroll") for (int rg = 0; rg < 4; ++rg) { yacc[rg] = Ys[(16 * ytb + 4 * fq + rg) * 32 + 16 * yrb + fr]; sacc[rg] = Qs[(16 * srb + 4 * fq + rg) * BC_QLD + 16 * scb + fr]; } \
        _Pragma("unroll") for (int kb = 0; kb < 2; ++kb) { \
            const sbf8 ya = *(const LAS sbf8*)(RYs + (16 * ytb + fr) * CH_LD + kb * 32 + 8 * fq), yb = *(const LAS sbf8*)(Sc + (16 * yrb + fr) * CH_LD + kb * 32 + 8 * fq); \
            const sbf8 sa = *(const LAS sbf8*)(Sc + (16 * srb + fr) * CH_LD + kb * 32 + 8 * fq), sb_ = *(const LAS sbf8*)(PTs + (16 * scb + fr) * CH_LD + kb * 32 + 8 * fq); \
            yacc = __builtin_amdgcn_mfma_f32_16x16x32_bf16(ya, yb, yacc, 0, 0, 0); sacc = __builtin_amdgcn_mfma_f32_16x16x32_bf16(sa, sb_, sacc, 0, 0, 0); } \
        _Pragma("unroll") for (int rg = 0; rg < 4; ++rg) Sn[(16 * srb + 4 * fq + rg) * CH_LD + 16 * scb + fr] = (bf16)f2bf(sacc[rg]); \
        _Pragma("unroll") for (int rg = 0; rg < 4; ++rg) { const int s_ = (c) * 64 + 16 * ytb + 4 * fq + rg; \
            if (cmp) { const float ref_ = cmp[((size_t)dir * M + rb + scan_row(s_, dir)) * 256 + col0 + half * 32 + 16 * yrb + fr]; dm = fmaxf(dm, fabsf(yacc[rg] - ref_)); } \
            else { const size_t yrow_ = ydebug ? (size_t)s_ : (rb + scan_row(s_, dir)); Ybuf[(ydir + yrow_) * 256 + col0 + half * 32 + 16 * yrb + fr] = yacc[rg]; } } \
        if ((c) + 1 < NCHUNK) BC_PARK((c) + 1, RYv, PTv, Qv, Yv); \
        if ((c) + 3 < NCHUNK) BC_LOAD((c) + 3, RYv, PTv, Qv, Yv); \
        LDS_BARRIER(); } while (0)
    BC_LOAD(0, a_ry, a_pt, a_q, a_y); BC_LOAD(1, b_ry, b_pt, b_q, b_y);
    BC_PARK(0, a_ry, a_pt, a_q, a_y);
    BC_LOAD(2, a_ry, a_pt, a_q, a_y);
    LDS_BARRIER();
    for (int c = 0; c < NCHUNK; c += 2) {
        BC_STEP(c, b_ry, b_pt, b_q, b_y);
        BC_STEP(c + 1, a_ry, a_pt, a_q, a_y);
    }
#undef BC_LOAD
#undef BC_PARK
#undef BC_STEP
    if (cmp) { dm = fmaxf(dm, __shfl_xor(dm, 1)); dm = fmaxf(dm, __shfl_xor(dm, 2)); dm = fmaxf(dm, __shfl_xor(dm, 4)); dm = fmaxf(dm, __shfl_xor(dm, 8)); dm = fmaxf(dm, __shfl_xor(dm, 16)); dm = fmaxf(dm, __shfl_xor(dm, 32));
        if (lane == 0) atomicMax(dmax, __builtin_bit_cast(unsigned, dm)); }
    __syncthreads();
}

__device__ __forceinline__ void scanA_phase(const Frame& F) {
    float* Y = (float*)(F.ws + WS_AR + AR_Y);
    if (F.G == 256) {
        const int x = F.bid & 7;
        for (int lt = F.bid >> 3; lt < 4 * NCHUNK; lt += 32) { const int cl = lt / NCHUNK, bh = 2 * x + (cl >> 1), dir = cl & 1;
            scanA_run(F, (dir * 4 + (bh >> 2)) * 4 + (bh & 3), lt % NCHUNK, Y, 0); }
        return;
    }
    for (int it = F.bid; it < 32 * NCHUNK; it += F.G) scanA_run(F, it / NCHUNK, it % NCHUNK, Y, 0);
}
__device__ __forceinline__ void mixer_phase(const Frame& F, int l) {
    typedef attn_body::bf16 abf;
    const abf* U = (const abf*)(F.ws + WS_AR + AR_QKV); abf* MIX = (abf*)(F.ws + WS_AR + AR_MIX);
    char* shm = (char*)F.lds;
    const int g = F.bid >> 3;
    const bool scan_cu = (F.G == 256) && ((g & 3) == 3);
#if SCAN_CHUNKED
    if (scan_cu) { const int sc = (g >> 2) * 8 + (F.bid & 7), x = sc & 7, t = sc >> 3, bh = 2 * x + (t >> 2);
        scanBC_task(F, (((t >> 1) & 1) * 4 + (bh >> 2)) * 4 + (bh & 3), t & 1, (float*)(F.ws + WS_AR + AR_Y), 0, nullptr, nullptr); }
    if (F.G != 256) for (int tk = F.bid; tk < 64; tk += F.G) scanBC_task(F, tk >> 1, tk & 1, (float*)(F.ws + WS_AR + AR_Y), 0, nullptr, nullptr);
    if (F.G == 256) {
        unsigned* ctr = (unsigned*)(F.ws + WS_CTL) + 9216 + l * 64 + (F.bid & 7) * 8;
        volatile LAS unsigned* qw = (volatile LAS unsigned*)(F.lds + MISC_OFF + 64);
        const int pair = F.bid & 7, b = pair >> 1, kvh = pair & 1; const size_t r0 = (size_t)b * SB;
        for (;;) {
            if (F.tid == 0) qw[0] = __hip_atomic_fetch_add(ctr, 1u, __ATOMIC_RELAXED, __HIP_MEMORY_SCOPE_AGENT);
            __syncthreads();
            const int j = (int)qw[0];
            __syncthreads();
            if (j >= 64) break;
            const int h = kvh * 4 + (j >> 4), qb = j & 15; const size_t q0 = r0 + CT + (size_t)qb * 256;
            attn_body::attn_unit<8>(U + q0 * QKVP + h * 64, U + r0 * QKVP + K_OFF + kvh * 64, U + r0 * QKVP + V_OFF + kvh * 64, MIX + q0 * D + h * 64, SB / 64, shm);
        }
    } else
    for (int u = F.bid; u < 512; u += F.G) {
        const int pair = u & 7, j = u >> 3, b = pair >> 1, kvh = pair & 1, h = kvh * 4 + (j >> 4), qb = j & 15;
        const size_t r0 = (size_t)b * SB, q0 = r0 + CT + (size_t)qb * 256;
        attn_body::attn_unit<8>(U + q0 * QKVP + h * 64, U + r0 * QKVP + K_OFF + kvh * 64, U + r0 * QKVP + V_OFF + kvh * 64, MIX + q0 * D + h * 64, SB / 64, shm);
    }
    if (l + 1 < NL && !scan_cu && (g >> 2) < 2) {
        const int hi4 = (g & 3) + 0;
        if ((g >> 2) == 0 ? true : (g & 3) == 0) {
            const int hh = (g >> 2) == 0 ? hi4 : 3;
            const int pair = F.bid & 7, b = pair >> 1, kvh = pair & 1, h = kvh * 4 + hh;
            const size_t r0 = (size_t)b * SB;
            attn_body::attn_unit<8>(U + r0 * QKVP + h * 64, U + r0 * QKVP + K_OFF + kvh * 64, U + r0 * QKVP + V_OFF + kvh * 64, MIX + r0 * D + h * 64, CT / 64, shm);
        }
    }
#else
    if (scan_cu) { scan_task(F, (g >> 2) * 8 + (F.bid & 7)); return; }
    const int pair = F.bid & 7, b = pair >> 1, kvh = pair & 1;
    const size_t r0 = (size_t)b * SB;
    const int a = g - (g >> 2);
    for (int jj = a; jj < 64; jj += 24) {
        const int h = kvh * 4 + (jj >> 4), qb = jj & 15;
        const size_t q0 = r0 + CT + (size_t)qb * 256;
        attn_body::attn_unit<8>(U + q0 * QKVP + h * 64, U + r0 * QKVP + K_OFF + kvh * 64, U + r0 * QKVP + V_OFF + kvh * 64, MIX + q0 * D + h * 64, SB / 64, shm);
    }
    if (l + 1 < NL && a >= 20) {
        const int h = kvh * 4 + (a - 20);
        attn_body::attn_unit<8>(U + r0 * QKVP + h * 64, U + r0 * QKVP + K_OFF + kvh * 64, U + r0 * QKVP + V_OFF + kvh * 64, MIX + r0 * D + h * 64, CT / 64, shm);
    }
#endif
}

__device__ __forceinline__ void scan_mixer_phase(const Frame& F, int l) {
    typedef attn_body::bf16 abf;
    const abf* U = (const abf*)(F.ws + WS_AR + AR_QKV); abf* MIX = (abf*)(F.ws + WS_AR + AR_MIX);
    char* shm = (char*)F.lds;
    float* Y = (float*)(F.ws + WS_AR + AR_Y);
    const int g = F.bid >> 3, x = F.bid & 7;
    const bool scan_cu = (g & 3) == 3;
    { int t0, nt_;
      if (scan_cu) { t0 = 5 * (g >> 2); nt_ = 5; } else { const int a = g - (g >> 2); t0 = 40 + (a < 16 ? 10 * a : 160 + 9 * (a - 16)); nt_ = a < 16 ? 10 : 9; }
      AIn ain;
      { const int cl = t0 / NCHUNK, bh = 2 * x + (cl >> 1), dir = cl & 1; scanA_issue(F, (dir * 4 + (bh >> 2)) * 4 + (bh & 3), t0 % NCHUNK, ain); }
      for (int lt = t0; lt < t0 + nt_; ++lt) { const int cl = lt / NCHUNK, bh = 2 * x + (cl >> 1), dir = cl & 1;
          const int l2 = lt + 1, cl2 = l2 / NCHUNK, bh2 = 2 * x + (cl2 >> 1), dir2 = cl2 & 1;
          scanA_task(F, (dir * 4 + (bh >> 2)) * 4 + (bh & 3), lt % NCHUNK, Y, 0, ain, l2 < t0 + nt_, (dir2 * 4 + (bh2 >> 2)) * 4 + (bh2 & 3), l2 % NCHUNK); } }
    unsigned* arrive = (unsigned*)(F.ws + WS_CTL) + 9600 + l * 64;
    asm volatile("s_waitcnt vmcnt(0)" ::: "memory");
    __syncthreads();
    if (F.tid == 0) { __builtin_amdgcn_fence(__ATOMIC_RELEASE, "agent"); asm volatile("s_waitcnt vmcnt(0)" ::: "memory"); __hip_atomic_fetch_add(arrive, 1u, __ATOMIC_RELAXED, __HIP_MEMORY_SCOPE_AGENT); }
    if (l + 1 < NL && !scan_cu && (g >> 2) < 2 && ((g >> 2) == 0 || (g & 3) == 0)) {
        const int hh = (g >> 2) == 0 ? (g & 3) : 3;
        const int b = x >> 1, kvh = x & 1, h = kvh * 4 + hh; const size_t r0 = (size_t)b * SB;
        attn_body::attn_unit<8>(U + r0 * QKVP + h * 64, U + r0 * QKVP + K_OFF + kvh * 64, U + r0 * QKVP + V_OFF + kvh * 64, MIX + r0 * D + h * 64, CT / 64, shm);
    }
    unsigned* ctr = (unsigned*)(F.ws + WS_CTL) + 9216 + l * 64 + x * 8;
    volatile LAS unsigned* qw = (volatile LAS unsigned*)(F.lds + MISC_OFF + 64);
    const int b = x >> 1, kvh = x & 1; const size_t r0 = (size_t)b * SB;
#define AQ_TAKE(jv) do { if (F.tid == 0) qw[0] = __hip_atomic_fetch_add(ctr, 1u, __ATOMIC_RELAXED, __HIP_MEMORY_SCOPE_AGENT); __syncthreads(); jv = (int)qw[0]; __syncthreads(); } while (0)
#define AQ_UNIT(jv) do { const int h_ = kvh * 4 + ((jv) >> 4), qb_ = (jv) & 15; const size_t q0_ = r0 + CT + (size_t)qb_ * 256; \
        attn_body::attn_unit<8>(U + q0_ * QKVP + h_ * 64, U + r0 * QKVP + K_OFF + kvh * 64, U + r0 * QKVP + V_OFF + kvh * 64, MIX + q0_ * D + h_ * 64, SB / 64, shm); } while (0)
    int j0; AQ_TAKE(j0);
    if (j0 < 64) AQ_UNIT(j0);
    if (scan_cu) {
        if (F.tid == 0) { unsigned sp = 0;
            while (__hip_atomic_load(arrive, __ATOMIC_RELAXED, __HIP_MEMORY_SCOPE_AGENT) < (unsigned)F.G) { __builtin_amdgcn_s_sleep(2); if (++sp > (1u << 22)) break; }
            __builtin_amdgcn_fence(__ATOMIC_ACQUIRE, "agent"); asm volatile("s_waitcnt vmcnt(0)" ::: "memory"); }
        __syncthreads();
        const int sc = (g >> 2) * 8 + x, t = sc >> 3, bh = 2 * x + (t >> 2);
        scanBC_task(F, (((t >> 1) & 1) * 4 + (bh >> 2)) * 4 + (bh & 3), t & 1, Y, 0, nullptr, nullptr);
        asm volatile("s_waitcnt vmcnt(0)" ::: "memory");
        __syncthreads();
        if (F.tid == 0) { __builtin_amdgcn_fence(__ATOMIC_RELEASE, "agent"); asm volatile("s_waitcnt vmcnt(0)" ::: "memory"); __hip_atomic_fetch_add(arrive + 16, 1u, __ATOMIC_RELAXED, __HIP_MEMORY_SCOPE_AGENT); }
    }
    if (j0 < 64) for (;;) { int j; AQ_TAKE(j); if (j >= 64) break; AQ_UNIT(j); }
#undef AQ_TAKE
#undef AQ_UNIT
    if (F.tid == 0) { unsigned sp = 0;
        while (__hip_atomic_load(arrive + 16, __ATOMIC_RELAXED, __HIP_MEMORY_SCOPE_AGENT) < 64u) { __builtin_amdgcn_s_sleep(2); if (++sp > (1u << 22)) break; }
        __builtin_amdgcn_fence(__ATOMIC_ACQUIRE, "agent"); asm volatile("s_waitcnt vmcnt(0)" ::: "memory"); }
    __syncthreads();
    rwkv_out_phase(F, l);
}

__global__ void __launch_bounds__(128) k_attn_simple(const bf16* __restrict__ U, bf16* __restrict__ MIX) {
    __shared__ float Ks[64][64];
    __shared__ float Vs[64][64];
    const int qb = blockIdx.x % 34, b = blockIdx.x / 34, h = blockIdx.y, kvh = h >> 2, tid = threadIdx.x;
    const size_t rb = (size_t)b * SB;
    const int row = qb * 128 + tid;
    const int nk = (qb < 2) ? CT : SB;
    float q[64], o[64];
#pragma unroll
    for (int d = 0; d < 64; ++d) { q[d] = bf2f(U[(rb + row) * QKVP + h * 64 + d]); o[d] = 0.f; }
    float m = -1e30f, l = 0.f;
    for (int k0 = 0; k0 < nk; k0 += 64) {
        __syncthreads();
        for (int i = tid; i < 64 * 64; i += 128) { const int j = i >> 6, d = i & 63;
            Ks[j][d] = bf2f(U[(rb + k0 + j) * QKVP + K_OFF + kvh * 64 + d]);
            Vs[j][d] = bf2f(U[(rb + k0 + j) * QKVP + V_OFF + kvh * 64 + d]); }
        __syncthreads();
        for (int j = 0; j < 64; ++j) {
            float s = 0.f;
#pragma unroll
            for (int d = 0; d < 64; ++d) s += q[d] * Ks[j][d];
            const float mn = fmaxf(m, s);
            const float corr = exp2f(m - mn), p = exp2f(s - mn);
            l = l * corr + p; m = mn;
#pragma unroll
            for (int d = 0; d < 64; ++d) o[d] = o[d] * corr + p * Vs[j][d];
        }
    }
    const float il = 1.f / l;
#pragma unroll
    for (int d = 0; d < 64; ++d) MIX[(rb + row) * D + h * 64 + d] = (bf16)f2bf(o[d] * il);
}

__global__ void __launch_bounds__(64) k_scan_simple(const bf16* __restrict__ r_i, const bf16* __restrict__ v_i, const bf16* __restrict__ kk_i,
                                                    const float* __restrict__ w_i, const bf16* __restrict__ ke_i, const bf16* __restrict__ kka_i, float* __restrict__ y_o) {
    __shared__ float sh[16][5][64];
    __shared__ float sv[16][64];
    const int h = blockIdx.x, dir = blockIdx.y, b = blockIdx.z, v = threadIdx.x;
    const size_t dofs = (size_t)dir * M * 256;
    float S[64];
#pragma unroll
    for (int k = 0; k < 64; ++k) S[k] = 0.f;
    for (int s0 = 0; s0 < SB; s0 += 16) {
        __syncthreads();
#pragma unroll
        for (int i = 0; i < 16; ++i) {
            const int s = s0 + i;
            const int sr = s < CT ? (dir == 0 ? s : CT - 1 - s) : (dir == 0 ? s : CT + (TL - 1 - (s - CT)));
            const size_t o = ((size_t)b * SB + sr) * 256 + h * 64 + v;
            sh[i][0][v] = __expf(w_i[dofs + o]); sh[i][1][v] = bf2f(kk_i[o]); sh[i][2][v] = bf2f(kka_i[dofs + o]); sh[i][3][v] = bf2f(ke_i[dofs + o]); sh[i][4][v] = bf2f(r_i[o]); sv[i][v] = bf2f(v_i[o]);
        }
        __syncthreads();
        for (int i = 0; i < 16; ++i) {
            const int s = s0 + i;
            const int sr = s < CT ? (dir == 0 ? s : CT - 1 - s) : (dir == 0 ? s : CT + (TL - 1 - (s - CT)));
            float sa = 0.f;
#pragma unroll
            for (int k = 0; k < 64; ++k) sa += S[k] * sh[i][1][k];
            const float vv = sv[i][v];
            float y = 0.f;
#pragma unroll
            for (int k = 0; k < 64; ++k) { S[k] = S[k] * sh[i][0][k] - sa * sh[i][2][k] + vv * sh[i][3][k]; y += S[k] * sh[i][4][k]; }
            y_o[dofs + ((size_t)b * SB + sr) * 256 + h * 64 + v] = y;
        }
    }
}

struct CtxSplitOrder {
    int G, c, ntk, nks, nsub;
    __device__ void init(int G_, int c_, int ntk_, int nctx) { G = G_; c = c_; ntk = ntk_; nks = ntk_ / 4; nsub = nctx * 4 * nks; }
    __device__ bool next(int i, pg8::Unit& u) const {
        const int Lx = i * G + c;
        if (Lx < 256) {
            int wgid = Lx; { const int q = 256 / 8, xcd = wgid % 8, off = wgid / 8; wgid = xcd * q + off; }
            const int nig = 8 * 4, gid = wgid / nig, fm = gid * 8;
            const int pm64 = fm + ((wgid % nig) % 8); u.pn = (wgid % nig) / 8;
            u.pm = pm64 + pm64 / 16 + 1; u.k0t = 0; u.nt = ntk; u.slot = -1; return true;
        }
        const int sub = Lx - 256; if (sub >= nsub) return false;
        const int ks = sub % nks, ct = sub / nks;
        u.pm = (ct >> 2) * 17; u.pn = ct & 3; u.k0t = ks * 4; u.nt = 4; u.slot = ks; return true;
    }
    __device__ __forceinline__ void a_ready(const pg8::Unit&) const {}
    __device__ __forceinline__ void done(const pg8::Unit&) const {}
};

constexpr int NPL = 11, NPHASE = 2 + NPL * NL;
#define PH_IN(k) (lo <= (k) && (k) < hi)
#if PROBE_MASK
#define PH_STAMP(k) do { if (blockIdx.x == 0 && threadIdx.x == 0) ((unsigned long long*)(F.ws + WS_CTL + 32768))[(k) + 1] = __builtin_amdgcn_s_memrealtime(); } while (0)
#else
#define PH_STAMP(k) do { } while (0)
#endif
#define PH_SEAM(k) do { if (PH_IN(k) && PH_IN((k) + 1)) xcd_barrier(bar); PH_STAMP(k); } while (0)
template <int L> __device__ __forceinline__ void layer_phases(const Frame& F, const int lo, const int hi, const XcdBarrier& bar) {
    constexpr int pb = 2 + NPL * L;
    bf16* XN = (bf16*)(F.ws + WS_AR + AR_XN); bf16* U = (bf16*)(F.ws + WS_AR + AR_U); bf16* MIX = (bf16*)(F.ws + WS_AR + AR_MIX);
    float* MIXO = (float*)(F.ws + WS_AR + AR_MIXO); bf16* H = (bf16*)(F.ws + WS_AR + AR_H); bf16* ACT = (bf16*)(F.ws + WS_AR + AR_ACT); float* FO = (float*)(F.ws + WS_AR + AR_FO);
    bf16* t_in = (bf16*)(F.ws + WS_WIN); bf16* t_out = (bf16*)(F.ws + WS_WOUT); bf16* t_up = (bf16*)(F.ws + WS_WUP); bf16* t_dn = (bf16*)(F.ws + WS_WDN);
    if (PH_IN(pb + 0)) { pg8::Gemm g{XN, t_in, M, NINP, D}; pg8::StaticOrder S; S.init(M, NINP, F.G, F.bid, D);
        pg8::EpiBf16<0> E{U, NINP, nullptr, 0, 0, 1.f};
        pg8::gemm_phase<pg8::EpiBf16<0>, pg8::StaticOrder, true, true>(F.lds, g, S, E); }
    PH_SEAM(pb + 0);
    if (PH_IN(pb + 1)) prep_phase(F, L);
    PH_SEAM(pb + 1);
#if SCAN_CHUNKED && !SCAN_DEBUG
    const bool merged = F.G == 256 && PH_IN(pb + 2) && PH_IN(pb + 3) && PH_IN(pb + 4);
    if (merged) { scan_mixer_phase(F, L); PH_STAMP(pb + 2); }
    else
#else
    const bool merged = false;
#endif
    {
    if (PH_IN(pb + 2)) {
#if SCAN_CHUNKED
        scanA_phase(F);
#endif
    }
    PH_SEAM(pb + 2);
    if (PH_IN(pb + 3)) mixer_phase(F, L);
    }
    if (!merged) PH_SEAM(pb + 3); else PH_STAMP(pb + 3);
#if SCAN_DEBUG && !SCAN_CHUNKED
    if (L == 0 && PH_IN(pb + 3)) {
        float* YD = (float*)(F.ws + WS_AR + AR_U + SCA_END);
        unsigned* dmax = (unsigned*)(F.ws + WS_CTL) + 9000;
        for (int it = F.bid; it < 8 * NCHUNK; it += F.G) { const int cl = it / NCHUNK, c = it % NCHUNK; const int ch = (cl >> 2) * 16 + (cl & 3);
            scanA_run(F, ch, c, YD, 1); }
        xcd_barrier(bar);
        if (F.bid < 16) { const int cl = F.bid >> 1, ch = (cl >> 2) * 16 + (cl & 3);
            scanBC_task(F, ch, F.bid & 1, YD, 1, (const float*)(F.ws + WS_AR + AR_Y), dmax); }
        xcd_barrier(bar);
    }
#endif
    if (PH_IN(pb + 4) && !merged) rwkv_out_phase(F, L);
    PH_SEAM(pb + 4);
    if (PH_IN(pb + 5)) { pg8::Gemm g{MIX, t_out, M, D, D}; CtxSplitOrder S; S.init(F.G, F.bid, D / 64, L + 1 < NL ? 4 : 0);
        pg8::EpiBf16P E{(bf16*)MIXO, D, (float*)(F.ws + WS_AR + AR_PART)};
        pg8::gemm_phase<pg8::EpiBf16P, CtxSplitOrder, true, true>(F.lds, g, S, E); }
    PH_SEAM(pb + 5);
    if (PH_IN(pb + 6)) norm_phase(F, 1, MIXO, INP(I_NMPOST) + L * D, L, 2, INP(I_NFPRE) + L * D, L, 3, 4, L + 1 < NL ? D / 256 : 0);
    PH_SEAM(pb + 6);
    if (PH_IN(pb + 7)) { pg8::Gemm g{XN, t_up, M, DFF2, D}; pg8::StaticOrder S; S.init(M, DFF2, F.G, F.bid, D);
        pg8::EpiBf16<0> E{H, DFF2, nullptr, 0, 0, 1.f};
        pg8::gemm_phase<pg8::EpiBf16<0>, pg8::StaticOrder, true, true>(F.lds, g, S, E); }
    PH_SEAM(pb + 7);
    if (PH_IN(pb + 8)) act_phase(F, L);
    PH_SEAM(pb + 8);
    if (PH_IN(pb + 9)) { pg8::Gemm g{ACT, t_dn, M, D, DFF}; CtxSplitOrder S; S.init(F.G, F.bid, DFF / 64, L + 1 < NL ? 4 : 0);
        pg8::EpiBf16P E{(bf16*)FO, D, (float*)(F.ws + WS_AR + AR_PART)};
        pg8::gemm_phase<pg8::EpiBf16P, CtxSplitOrder, true, true>(F.lds, g, S, E); }
    PH_SEAM(pb + 9);
    if (PH_IN(pb + 10)) {
        if (L + 1 < NL) { norm_phase(F, 1, FO, INP(I_NFPOST) + L * D, L, 5, INP(I_NMPRE) + (L + 1 < NL ? L + 1 : L) * D, L + 1, 0, 1, DFF / 256); __syncthreads(); convert_weights(F, L + 1); }
        else norm_phase(F, 2, FO, INP(I_NFPOST) + L * D, L, 5, nullptr, 0, 0, 0, 0);
    }
    if (L + 1 < NL) PH_SEAM(pb + 10); else PH_STAMP(pb + 10);
}
__global__ void __launch_bounds__(NTHR, 2) mk_fwd(Args args) {
    extern __shared__ __attribute__((aligned(16))) unsigned char lds_raw[];
    Frame F;
    F.lds = (LAS unsigned char*)lds_raw;
    F.tid = threadIdx.x; F.lane = F.tid & 63; F.wave = __builtin_amdgcn_readfirstlane(F.tid >> 6);
    F.bid = blockIdx.x; F.G = gridDim.x; F.ws = args.ws; F.out = args.out;
    volatile LAS unsigned* MISC = (volatile LAS unsigned*)(F.lds + MISC_OFF);
    for (int u = F.tid; u < (LDS_BYTES - LDSCTL_OFF) / 4; u += NTHR) ((LAS unsigned*)(F.lds + LDSCTL_OFF))[u] = 0u;
    __syncthreads();
    if (F.tid == 0) {
#pragma unroll
        for (int i = 0; i < 29; ++i) ((unsigned long long LAS*)(F.lds + PTR_OFF))[i] = (unsigned long long)args.in[i];
    }
    __syncthreads();
    const int lo = args.ph_lo, hi = args.ph_hi;
    XcdBarrier bar; bar.bar = (unsigned*)(F.ws + WS_CTL) + CW_BAR; bar.x = 0; bar.st = nullptr;
    if (hi - lo > 1) bar = xcd_barrier_post((unsigned*)(F.ws + WS_CTL) + CW_BAR, MISC + 8);
#if PROBE_MASK
    if (blockIdx.x == 0 && threadIdx.x == 0) ((unsigned long long*)(F.ws + WS_CTL + 32768))[0] = __builtin_amdgcn_s_memrealtime();
#endif
    if (PH_IN(0)) phase_pro_a(F);
#if ONE_LAUNCH
    if (PH_IN(0) && PH_IN(1)) cg::this_grid().sync();
    PH_STAMP(0);
#else
    PH_SEAM(0);
#endif
    if (PH_IN(1)) norm_phase(F, 0, nullptr, nullptr, 0, 0, INP(I_NMPRE), 0, 0, 1, 0);
    PH_SEAM(1);
    layer_phases<0>(F, lo, hi, bar);
    layer_phases<1>(F, lo, hi, bar);
    layer_phases<2>(F, lo, hi, bar);
    layer_phases<3>(F, lo, hi, bar);
#if SCAN_DEBUG
    xcd_barrier(bar);
    if (blockIdx.x == 0 && threadIdx.x == 0) { const unsigned* dmax = (const unsigned*)(F.ws + WS_CTL) + 9000;
        F.out[0] += 1000.f * __builtin_bit_cast(float, __hip_atomic_load(dmax + (SCAN_DEBUG == 2 ? 1 : 0), __ATOMIC_RELAXED, __HIP_MEMORY_SCOPE_AGENT)); }
#endif
#if PROBE_MASK
    if (blockIdx.x == 0 && threadIdx.x == 0) {
        asm volatile("s_waitcnt vmcnt(0)" ::: "memory");
        volatile unsigned long long* ts = (volatile unsigned long long*)(F.ws + WS_CTL + 32768);
        unsigned long long tot = 0;
        for (int k = 0; k < NPHASE; ++k) {
            const int bit = k == 0 ? 12 : k == 1 ? 13 : (k - 2) % NPL;
            if ((PROBE_MASK >> bit) & 1) tot += ts[k + 1] - ts[k];
        }
        const unsigned long long t0 = __builtin_amdgcn_s_memrealtime();
        while (__builtin_amdgcn_s_memrealtime() - t0 < tot * PROBE_AMP) __builtin_amdgcn_s_sleep(8);
    }
#endif
}

extern "C" void kernel_launch(void* const* d_in, const int* in_sizes, int n_in, void* d_out, int out_size, void* d_ws, size_t ws_size, hipStream_t stream) {
    static int grid = 0;
    if (grid == 0) {
        if (n_in != 29 || ws_size < WS_END) { fprintf(stderr, "kernel_launch: unexpected n_in %d or ws %zu < %zu\n", n_in, ws_size, (size_t)WS_END); grid = -1; return; }
        int dev = 0, cus = 0, per_cu = 0;
        hipGetDevice(&dev); hipDeviceGetAttribute(&cus, hipDeviceAttributeMultiprocessorCount, dev);
        hipFuncSetAttribute((const void*)mk_fwd, hipFuncAttributeMaxDynamicSharedMemorySize, LDS_BYTES);
        hipOccupancyMaxActiveBlocksPerMultiprocessor(&per_cu, (const void*)mk_fwd, NTHR, LDS_BYTES);
        if (per_cu < 1) { fprintf(stderr, "kernel_launch: occupancy query says %d blocks per CU\n", per_cu); grid = -1; return; }
        grid = cus;
    }
    if (grid < 0) return;
    hipMemsetAsync((char*)d_ws + WS_CTL, 0, CTL_ZERO_BYTES, stream);
    Args a{};
    for (int i = 0; i < 29; ++i) a.in[i] = (const float*)d_in[i];
    a.out = (float*)d_out; a.ws = (unsigned char*)d_ws;
    unsigned char* ws = (unsigned char*)d_ws;
    auto launch = [&](int lo, int hi) { a.ph_lo = lo; a.ph_hi = hi; hipLaunchKernelGGL(mk_fwd, dim3(grid), dim3(NTHR), LDS_BYTES, stream, a); };
#if ONE_LAUNCH
    { a.ph_lo = 0; a.ph_hi = NPHASE; void* kargs[] = {&a};
      hipLaunchCooperativeKernel((const void*)mk_fwd, dim3(grid), dim3(NTHR), kargs, LDS_BYTES, stream); }
#else
    launch(0, 1); launch(1, 2);
    for (int l = 0; l < NL; ++l) { const int pb = 2 + NPL * l; for (int p = 0; p < NPL; ++p) launch(pb + p, pb + p + 1); }
#endif
}
```

```cpp
#include <hip/hip_runtime.h>
#include <hip/hip_bf16.h>
#include <hip/hip_cooperative_groups.h>
#include <cstdio>
#include <cstdint>
#include <math.h>
namespace cg = cooperative_groups;

namespace pg8 {
#define PG8_LAS __attribute__((address_space(3)))
typedef unsigned short bf16_t;
typedef short bf16x8 __attribute__((ext_vector_type(8)));
typedef float f32x4 __attribute__((ext_vector_type(4)));
typedef unsigned u32x4 __attribute__((ext_vector_type(4)));
constexpr int BM = 256, BK = 64, HALF = 128, HTB = HALF * BK * 2  , STAGE_BYTES = 8 * HTB, NXCD = 8, WGM = 8;

__host__ __device__ __forceinline__ int lds_byte(int r, int c) { const int st = (r >> 4) * 2 + (c >> 5), rr = r & 15, cc = c & 31, ob = rr * 64 + cc * 2; return st * 1024 + (ob ^ (((ob >> 9) & 1) << 5)); }
__host__ __device__ __forceinline__ void stage_rc(int b, int& R, int& C) { const int st = b / 1024, sb = b % 1024, swz = sb ^ (((sb >> 9) & 1) << 5); R = (st >> 1) * 16 + swz / 64; C = (st & 1) * 32 + (swz % 64) / 2; }
__host__ __device__ __forceinline__ int perm32(int rho) { const int n = rho >> 4, i = rho & 15; return 8 * (i >> 2) + 4 * n + (i & 3); }

struct Unit { int pm, pn, k0t, nt, slot; };
struct Gemm { const bf16_t* A; const bf16_t* Bt; int M, N, K; };

struct StaticOrder {
    int nM, nN, nwg, G, c, ntk;
    __host__ __device__ void init(int M, int N, int G_, int c_, int K_ = 0) { nM = M / BM; nN = N / BM; nwg = nM * nN; G = G_; c = c_; ntk = K_ / BK; }
    __host__ __device__ bool next(int i, Unit& u) const {
        const long L = (long)i * G + c; if (L >= nwg) return false;
        int wgid = (int)L; { const int q = nwg / NXCD, r = nwg % NXCD, xcd = wgid % NXCD, off = wgid / NXCD; wgid = (xcd < r ? xcd * (q + 1) : r * (q + 1) + (xcd - r) * q) + off; }
        const int nig = WGM * nN, gid = wgid / nig, fm = gid * WGM, gsz = (nM - fm) < WGM ? (nM - fm) : WGM;
        u.pm = fm + ((wgid % nig) % gsz); u.pn = (wgid % nig) / gsz; u.k0t = 0; u.nt = ntk; u.slot = -1; return true;
    }
    __device__ __forceinline__ void a_ready(const Unit&) const {}
    __device__ __forceinline__ void done(const Unit&) const {}
};

__device__ __forceinline__ unsigned cvt_pk_bf16(float lo, float hi) { unsigned r; asm volatile("v_cvt_pk_bf16_f32 %0, %1, %2" : "=v"(r) : "v"(lo), "v"(hi)); return r; }
typedef float f32x2 __attribute__((ext_vector_type(2)));
__device__ __forceinline__ f32x2 gelu_pk(f32x2 v) {
    const f32x2 av = __builtin_elementwise_abs(v), d = av * 0.2316418882f + 1.0f;
    f32x2 t; t.x = __builtin_amdgcn_rcpf(d.x); t.y = __builtin_amdgcn_rcpf(d.y);
    f32x2 q = t * 0.5307027145f + (-0.7265760135f); q = q * t + 0.7107068705f; q = q * t + (-0.142248368f); q = q * t + 0.127414796f; q = q * t;
    const f32x2 s = (v * v) * (-0.72134752044f);
    f32x2 e; e.x = __builtin_amdgcn_exp2f(s.x); e.y = __builtin_amdgcn_exp2f(s.y);
    const f32x2 m = v * (q * e), r = v - m;
    f32x2 o; o.x = v.x < 0.f ? m.x : r.x; o.y = v.y < 0.f ? m.y : r.y; return o;
}

template <int ACT  > struct EpiBf16 {
    static constexpr bool PERM = true, AFTER_DRAIN = false; static_assert(ACT == 0 || ACT == 1, "EpiBf16: ACT is 0 (none) or 1 (gelu_pk)");
    bf16_t* O; int ldc; const float* bias; int split_cols; size_t split_stride; float scale0;
    __device__ __forceinline__ void operator()(const f32x4 (&acc)[2][2][4][2], const Unit& u, int wr, int wc, int fr, int fq) const {
        const int row0 = u.pm * BM + wr * 64 + fr; int colt = u.pn * BM; bf16_t* base = O;
        float sc = 1.f; if (split_cols) { const int t = colt / split_cols; base += (size_t)t * split_stride; colt -= t * split_cols; if (t == 0) sc = scale0; }
        const int col0 = colt + wc * 32 + 8 * fq, bcol0 = u.pn * BM + wc * 32 + 8 * fq;
        f32x4 bv[2][2];
#pragma unroll
        for (int bj = 0; bj < 2; ++bj)
#pragma unroll
            for (int n = 0; n < 2; ++n) bv[bj][n] = bias ? *(const f32x4*)(bias + bcol0 + bj * HALF + 4 * n) : (f32x4){0.f, 0.f, 0.f, 0.f};
#pragma unroll
        for (int ai = 0; ai < 2; ++ai)
#pragma unroll
            for (int m = 0; m < 4; ++m) { bf16_t* rowp = base + (size_t)(row0 + ai * HALF + m * 16) * ldc + col0;
#pragma unroll
                for (int bj = 0; bj < 2; ++bj) { f32x4 v0 = acc[ai][bj][m][0] + bv[bj][0], v1 = acc[ai][bj][m][1] + bv[bj][1];
                    if (ACT == 1) { f32x2 a = gelu_pk((f32x2){v0[0], v0[1]}), b = gelu_pk((f32x2){v0[2], v0[3]}), c = gelu_pk((f32x2){v1[0], v1[1]}), d = gelu_pk((f32x2){v1[2], v1[3]});
                        v0 = (f32x4){a.x, a.y, b.x, b.y}; v1 = (f32x4){c.x, c.y, d.x, d.y}; }
                    v0 = v0 * sc; v1 = v1 * sc; u32x4 w; w.x = cvt_pk_bf16(v0[0], v0[1]); w.y = cvt_pk_bf16(v0[2], v0[3]); w.z = cvt_pk_bf16(v1[0], v1[1]); w.w = cvt_pk_bf16(v1[2], v1[3]);
                    *(u32x4*)(rowp + bj * HALF) = w; } }
    }
};

struct EpiF32 {
    static constexpr bool PERM = false, AFTER_DRAIN = false;
    float* C; int ldc; const float* bias; float* part;
    __device__ __forceinline__ void operator()(const f32x4 (&acc)[2][2][4][2], const Unit& u, int wr, int wc, int fr, int fq) const {
        const int row0 = (u.slot >= 0 ? (u.slot * 4 + u.pm / 17) * BM : u.pm * BM) + wr * 64 + fr, col0 = u.pn * BM + wc * 32 + 4 * fq;
        float* const Cb = u.slot >= 0 ? part : C;
        f32x4 bv[2][2];
#pragma unroll
        for (int bj = 0; bj < 2; ++bj)
#pragma unroll
            for (int n = 0; n < 2; ++n) bv[bj][n] = bias ? *(const f32x4*)(bias + col0 + bj * HALF + n * 16) : (f32x4){0.f, 0.f, 0.f, 0.f};
#pragma unroll
        for (int ai = 0; ai < 2; ++ai)
#pragma unroll
            for (int m = 0; m < 4; ++m) { float* rowp = Cb + (size_t)(row0 + ai * HALF + m * 16) * ldc + col0;
#pragma unroll
                for (int bj = 0; bj < 2; ++bj)
#pragma unroll
                    for (int n = 0; n < 2; ++n) *(f32x4*)(rowp + bj * HALF + n * 16) = acc[ai][bj][m][n] + bv[bj][n]; }
    }
};

struct EpiBf16P {
    static constexpr bool PERM = true, AFTER_DRAIN = false;
    bf16_t* O; int ldc; float* part;
    __device__ __forceinline__ void operator()(const f32x4 (&acc)[2][2][4][2], const Unit& u, int wr, int wc, int fr, int fq) const {
        const int col0 = u.pn * BM + wc * 32 + 8 * fq;
        if (u.slot < 0) {
            const int row0 = u.pm * BM + wr * 64 + fr;
#pragma unroll
            for (int ai = 0; ai < 2; ++ai)
#pragma unroll
                for (int m = 0; m < 4; ++m) { bf16_t* rowp = O + (size_t)(row0 + ai * HALF + m * 16) * ldc + col0;
#pragma unroll
                    for (int bj = 0; bj < 2; ++bj) { const f32x4 v0 = acc[ai][bj][m][0], v1 = acc[ai][bj][m][1];
                        u32x4 w; w.x = cvt_pk_bf16(v0[0], v0[1]); w.y = cvt_pk_bf16(v0[2], v0[3]); w.z = cvt_pk_bf16(v1[0], v1[1]); w.w = cvt_pk_bf16(v1[2], v1[3]);
                        *(u32x4*)(rowp + bj * HALF) = w; } }
        } else {
            const int row0 = (u.slot * 4 + u.pm / 17) * BM + wr * 64 + fr;
#pragma unroll
            for (int ai = 0; ai < 2; ++ai)
#pragma unroll
                for (int m = 0; m < 4; ++m) { float* rowp = part + (size_t)(row0 + ai * HALF + m * 16) * ldc + col0;
#pragma unroll
                    for (int bj = 0; bj < 2; ++bj) { *(f32x4*)(rowp + bj * HALF) = acc[ai][bj][m][0]; *(f32x4*)(rowp + bj * HALF + 4) = acc[ai][bj][m][1]; } }
        }
    }
};
template <class Epi, class Sched, bool ALIGN_EPI = false, bool SP2 = false>
__device__ __forceinline__ void gemm_phase(PG8_LAS unsigned char* lds, const Gemm g, const Sched& S, const Epi& E) {
    const int tid = threadIdx.x, wid = __builtin_amdgcn_readfirstlane(tid >> 6), lane = tid & 63, wr = wid >> 2, wc = wid & 3, fr = lane & 15, fq = lane >> 4;
    const int K = g.K;
    unsigned voffA[2], voffB[2];
#pragma unroll
    for (int i = 0; i < 2; ++i) { int R, C; stage_rc(tid * 16 + i * 8192, R, C); const int Rb = Epi::PERM ? ((R & ~31) + perm32(R & 31)) : R;
        voffA[i] = (unsigned)(R * K + C) * 2u; voffB[i] = (unsigned)(Rb * K + C) * 2u; }
    const size_t kstep = (size_t)(BK * 2);
    const size_t hstep = (size_t)HALF * K * 2;
    const size_t tstep = 2 * hstep;
    const unsigned ldsw = (unsigned)wid * 1024u;
    const int aoff = lds_byte(wr * 64 + fr, fq * 8), boff = lds_byte(wc * 32 + fr, fq * 8);
#define PG8_SA(b, h) (((b) * 2 + (h)) * HTB)
#define PG8_SB(b, h) ((4 + (b) * 2 + (h)) * HTB)
#define PG8_STAGE(bufoff, gbase, voff) do { _Pragma("unroll") for (int _i = 0; _i < 2; ++_i) \
        __builtin_amdgcn_global_load_lds((const unsigned*)((const char*)(gbase) + (voff)[_i]), (PG8_LAS unsigned*)(lds + (bufoff) + ldsw + _i * 8192), 16, 0, 0); } while (0)
#define PG8_LDA(dst, b, h) do { _Pragma("unroll") for (int m = 0; m < 4; ++m) _Pragma("unroll") for (int k = 0; k < 2; ++k) dst[m][k] = *(const PG8_LAS bf16x8*)(lds + PG8_SA(b, h) + aoff + m * 2048 + k * 1024); } while (0)
#define PG8_LDB(dst, b, h) do { _Pragma("unroll") for (int n = 0; n < 2; ++n) _Pragma("unroll") for (int k = 0; k < 2; ++k) dst[n][k] = *(const PG8_LAS bf16x8*)(lds + PG8_SB(b, h) + boff + n * 2048 + k * 1024); } while (0)
#define PG8_MMA(ai, bj, At, Bt) do { __builtin_amdgcn_s_setprio(1); _Pragma("unroll") for (int m = 0; m < 4; ++m) _Pragma("unroll") for (int n = 0; n < 2; ++n) _Pragma("unroll") for (int k = 0; k < 2; ++k) \
        acc[ai][bj][m][n] = __builtin_amdgcn_mfma_f32_16x16x32_bf16(Bt[n][k], At[m][k], acc[ai][bj][m][n], 0, 0, 0); __builtin_amdgcn_s_setprio(0); } while (0)
#define PG8_WAIT_V(n) asm volatile("s_waitcnt vmcnt(" #n ")" ::: "memory")
#define PG8_WAIT_L(n) asm volatile("s_waitcnt lgkmcnt(" #n ")" ::: "memory")
#define PG8_BAR __builtin_amdgcn_s_barrier()
#define PG8_SCHED __builtin_amdgcn_sched_barrier(0)
    Unit cur, nxt; int ui = 0;
    if (!S.next(0, cur)) return;
    f32x4 acc[2][2][4][2];
#pragma unroll
    for (int a = 0; a < 2; ++a)
#pragma unroll
        for (int b = 0; b < 2; ++b)
#pragma unroll
            for (int m = 0; m < 4; ++m)
#pragma unroll
                for (int n = 0; n < 2; ++n) acc[a][b][m][n] = (f32x4){0.f, 0.f, 0.f, 0.f};
    bf16x8 At[4][2], B0[2][2], B1[2][2];
    const char* cA = (const char*)g.A + (size_t)cur.pm * tstep + (size_t)cur.k0t * kstep; const char* cB = (const char*)g.Bt + (size_t)cur.pn * tstep + (size_t)cur.k0t * kstep;
    S.a_ready(cur);
    if constexpr (SP2) {
        PG8_STAGE(PG8_SB(0, 0), cB, voffB); PG8_STAGE(PG8_SB(0, 1), cB + hstep, voffB); PG8_STAGE(PG8_SA(0, 0), cA, voffA); PG8_STAGE(PG8_SA(0, 1), cA + hstep, voffA);
        if (wr == 1) PG8_BAR;
        PG8_WAIT_V(2); PG8_BAR;
        PG8_STAGE(PG8_SB(1, 0), cB + kstep, voffB); PG8_STAGE(PG8_SA(1, 0), cA + kstep, voffA); PG8_STAGE(PG8_SB(1, 1), cB + hstep + kstep, voffB);
        PG8_WAIT_V(6); PG8_BAR;
    } else {
        PG8_STAGE(PG8_SB(0, 0), cB, voffB); PG8_STAGE(PG8_SA(0, 0), cA, voffA); PG8_STAGE(PG8_SB(0, 1), cB + hstep, voffB); PG8_STAGE(PG8_SA(0, 1), cA + hstep, voffA);
        if (wr == 1) PG8_BAR;
        PG8_WAIT_V(4); PG8_BAR;
        PG8_STAGE(PG8_SB(1, 0), cB + kstep, voffB); PG8_STAGE(PG8_SA(1, 0), cA + kstep, voffA); PG8_STAGE(PG8_SB(1, 1), cB + hstep + kstep, voffB);
        PG8_WAIT_V(6); PG8_BAR;
    }
    for (;;) {
        const bool has_next = S.next(ui + 1, nxt);
        const char* nA = has_next ? (const char*)g.A + (size_t)nxt.pm * tstep + (size_t)nxt.k0t * kstep : cA; const char* nB = has_next ? (const char*)g.Bt + (size_t)nxt.pn * tstep + (size_t)nxt.k0t * kstep : cB;
        const int nt = cur.nt;
        for (int t = 0; t < nt; t += 2) {
            const bool last = (t == nt - 2);
            const char* a1 = cA + (size_t)(t + 1) * kstep;
            const char* a2 = last ? nA : cA + (size_t)(t + 2) * kstep; const char* b2 = last ? nB : cB + (size_t)(t + 2) * kstep;
            const char* a3 = a2 + kstep; const char* b3 = b2 + kstep;
            if (last && has_next) S.a_ready(nxt);
            if constexpr (SP2) {
            PG8_LDB(B0, 0, 0); PG8_LDB(B1, 0, 1); PG8_SCHED; PG8_LDA(At, 0, 0); PG8_STAGE(PG8_SA(1, 1), a1 + hstep, voffA);
            PG8_WAIT_V(8); PG8_WAIT_L(0); PG8_BAR; PG8_MMA(0, 0, At, B0); PG8_MMA(0, 1, At, B1); PG8_BAR; PG8_SCHED;
            PG8_LDA(At, 0, 1); PG8_STAGE(PG8_SB(0, 0), b2, voffB); PG8_STAGE(PG8_SB(0, 1), b2 + hstep, voffB); PG8_STAGE(PG8_SA(0, 0), a2, voffA);
            PG8_WAIT_V(8); PG8_WAIT_L(0); PG8_BAR; PG8_MMA(1, 0, At, B0); PG8_MMA(1, 1, At, B1); PG8_BAR; PG8_SCHED;
            PG8_LDB(B0, 1, 0); PG8_LDB(B1, 1, 1); PG8_SCHED; PG8_LDA(At, 1, 0); PG8_STAGE(PG8_SA(0, 1), a2 + hstep, voffA);
            PG8_WAIT_V(8); PG8_WAIT_L(0); PG8_BAR; PG8_MMA(0, 0, At, B0); PG8_MMA(0, 1, At, B1); PG8_BAR; PG8_SCHED;
            PG8_LDA(At, 1, 1); PG8_STAGE(PG8_SB(1, 0), b3, voffB); PG8_STAGE(PG8_SB(1, 1), b3 + hstep, voffB); PG8_STAGE(PG8_SA(1, 0), a3, voffA);
            PG8_WAIT_V(8); PG8_WAIT_L(0); PG8_BAR; PG8_MMA(1, 0, At, B0); PG8_MMA(1, 1, At, B1); PG8_BAR; PG8_SCHED;
            } else {
            PG8_LDB(B0, 0, 0); PG8_SCHED; PG8_LDA(At, 0, 0); PG8_STAGE(PG8_SA(1, 1), a1 + hstep, voffA);
            PG8_WAIT_L(8); PG8_BAR; PG8_WAIT_L(0); PG8_MMA(0, 0, At, B0); PG8_BAR; PG8_SCHED;
            PG8_LDB(B1, 0, 1); PG8_STAGE(PG8_SB(0, 0), b2, voffB);
            PG8_BAR; PG8_WAIT_L(0); PG8_MMA(0, 1, At, B1); PG8_BAR;
            PG8_LDA(At, 0, 1); PG8_STAGE(PG8_SA(0, 0), a2, voffA);
            PG8_BAR; PG8_WAIT_L(0); PG8_MMA(1, 0, At, B0); PG8_BAR; PG8_SCHED;
            PG8_STAGE(PG8_SB(0, 1), b2 + hstep, voffB);
            PG8_WAIT_V(6); PG8_BAR; PG8_MMA(1, 1, At, B1); PG8_BAR;
            PG8_LDB(B0, 1, 0); PG8_SCHED; PG8_LDA(At, 1, 0); PG8_STAGE(PG8_SA(0, 1), a2 + hstep, voffA);
            PG8_WAIT_L(8); PG8_BAR; PG8_WAIT_L(0); PG8_MMA(0, 0, At, B0); PG8_BAR; PG8_SCHED;
            PG8_LDB(B1, 1, 1); PG8_STAGE(PG8_SB(1, 0), b3, voffB);
            PG8_BAR; PG8_WAIT_L(0); PG8_MMA(0, 1, At, B1); PG8_BAR;
            PG8_LDA(At, 1, 1); PG8_STAGE(PG8_SA(1, 0), a3, voffA);
            PG8_BAR; PG8_WAIT_L(0); PG8_MMA(1, 0, At, B0); PG8_BAR; PG8_SCHED;
            PG8_STAGE(PG8_SB(1, 1), b3 + hstep, voffB);
            PG8_WAIT_V(6); PG8_BAR; PG8_MMA(1, 1, At, B1); PG8_BAR;
            }
        }
        if constexpr (ALIGN_EPI) { if (wr == 0) PG8_BAR; }
        if constexpr (!Epi::AFTER_DRAIN) { E(acc, cur, wr, wc, fr, fq); S.done(cur); }
        if (!has_next) break;
#pragma unroll
        for (int a = 0; a < 2; ++a)
#pragma unroll
            for (int b = 0; b < 2; ++b)
#pragma unroll
                for (int m = 0; m < 4; ++m)
#pragma unroll
                    for (int n = 0; n < 2; ++n) acc[a][b][m][n] = (f32x4){0.f, 0.f, 0.f, 0.f};
        cur = nxt; cA = nA; cB = nB; ++ui;
        if constexpr (ALIGN_EPI) { if (wr == 1) PG8_BAR; }
    }
    PG8_WAIT_V(0);
    if constexpr (!ALIGN_EPI) { if (wr == 0) PG8_BAR; }
    PG8_BAR;
    if constexpr (Epi::AFTER_DRAIN) { E.fused(acc, cur, wr, wc, fr, fq, lds, wid, lane); S.done(cur); }
#undef PG8_SA
#undef PG8_SB
#undef PG8_STAGE
#undef PG8_LDA
#undef PG8_LDB
#undef PG8_MMA
#undef PG8_WAIT_V
#undef PG8_WAIT_L
#undef PG8_BAR
#undef PG8_SCHED
}
}

#ifndef ATTN_FAST
#define ATTN_FAST 1
#endif
#ifndef SCAN_FAST
#define SCAN_FAST 1
#endif
#ifndef PROBE_MASK
#define PROBE_MASK 0
#endif
#ifndef PROBE_AMP
#define PROBE_AMP 8
#endif
#ifndef SCAN_CHUNKED
#define SCAN_CHUNKED 1
#endif
#ifndef PREP_REP
#define PREP_REP 0
#endif
#ifndef SCANA_REP
#define SCANA_REP 0
#endif
#ifndef SCAN_DEBUG
#define SCAN_DEBUG 0
#endif
#ifndef ONE_LAUNCH
#define ONE_LAUNCH 1
#endif
constexpr int NWAVES = 8, NTHR = 512;
constexpr int D = 1024, NB = 4, TL = 4096, CT = 256, SB = CT + TL  , NL = 4;
constexpr int M = NB * SB;
constexpr int NIN = 2688, NINP = 2816, DFF = 2816, DFF2 = 5632;
constexpr int R_IN = 1152, R_OFF = 768, C_OFF = 1920, K_OFF = 512, V_OFF = 640;
constexpr float NORM_EPS = 1e-6f, GN_EPS = 64e-5f, DECAY_SCALE = 0.606531f;
constexpr float C2 = 0.125f * 1.4426950408889634f;

typedef unsigned short bf16;
typedef unsigned v4u __attribute__((ext_vector_type(4)));
typedef unsigned v2u __attribute__((ext_vector_type(2)));
typedef float f32x4 __attribute__((ext_vector_type(4)));
#define LAS __attribute__((address_space(3)))
#define GAS __attribute__((address_space(1)))
typedef GAS unsigned gu32;
#define RLX_AGENT __ATOMIC_RELAXED, __HIP_MEMORY_SCOPE_AGENT

constexpr size_t MiB = 1u << 20;
constexpr size_t WS_CTL = 0, CTL_ZERO_BYTES = 1 * MiB;
constexpr size_t WS_MODS = 1 * MiB;
constexpr size_t WS_ROPE = WS_MODS + 512 * 1024;
constexpr size_t WS_LR = WS_ROPE + 1 * MiB;
constexpr size_t WS_XCUR = 3 * MiB;
constexpr size_t SZ_XCUR = (size_t)M * D * 4;
constexpr size_t WS_WIN = WS_XCUR + SZ_XCUR;
constexpr size_t WS_WOUT = WS_WIN + (size_t)NINP * D * 2;
constexpr size_t WS_WUP = WS_WOUT + (size_t)D * D * 2;
constexpr size_t WS_WDN = WS_WUP + (size_t)DFF2 * D * 2;
constexpr size_t WS_AR = WS_WDN + (size_t)D * DFF * 2;
constexpr size_t SZ_BF_MD = (size_t)M * D * 2;
constexpr size_t SZ_BF_M256 = (size_t)M * 256 * 2;
constexpr size_t AR_XN = 0;
constexpr size_t AR_Y = 0;
constexpr size_t AR_U = AR_XN + SZ_BF_MD;
constexpr size_t AR_MIXO = AR_U;
constexpr size_t AR_R = AR_U + (size_t)M * NINP * 2;
constexpr size_t AR_V = AR_R + SZ_BF_M256;
constexpr size_t AR_KK = AR_V + SZ_BF_M256;
constexpr size_t AR_G = AR_KK + SZ_BF_M256;
constexpr size_t AR_KE = AR_G + SZ_BF_M256;
constexpr size_t AR_KKA = AR_KE + 2 * SZ_BF_M256;
constexpr size_t AR_W = AR_KKA + 2 * SZ_BF_M256;
constexpr size_t AR_MIX = AR_W + (size_t)2 * M * 256 * 4;
constexpr size_t AR_QKV = AR_MIX + SZ_BF_MD;
constexpr int QKVP = 768;
constexpr size_t AR_END1 = AR_QKV + (size_t)M * QKVP * 2;
constexpr size_t AR_ACT = 0;
constexpr size_t AR_H = AR_ACT + (size_t)M * DFF * 2;
constexpr size_t AR_FO = AR_H;
constexpr size_t AR_PART = AR_H + (size_t)M * D * 4;
constexpr size_t AR_END2 = AR_H + (size_t)M * DFF2 * 2;
constexpr size_t WS_END = WS_AR + (AR_END1 > AR_END2 ? AR_END1 : AR_END2);
static_assert(WS_END <= 384 * MiB, "workspace budget");
constexpr int CW_BAR = 4096;

constexpr int LDS_BYTES = 147456;
constexpr int RING_BYTES = 131072, LDSCTL_OFF = RING_BYTES, MISC_OFF = LDSCTL_OFF + 320;

__device__ __forceinline__ unsigned f2bf(float f) { unsigned u = __builtin_bit_cast(unsigned, f); return (u + 0x7fffu + ((u >> 16) & 1u)) >> 16; }
__device__ __forceinline__ unsigned pk2(float lo, float hi) { return f2bf(lo) | (f2bf(hi) << 16); }
__device__ __forceinline__ float bf2f(unsigned short b) { return __builtin_bit_cast(float, ((unsigned)b) << 16); }
__device__ __forceinline__ float bflo(unsigned w) { return __builtin_bit_cast(float, w << 16); }
__device__ __forceinline__ float bfhi(unsigned w) { return __builtin_bit_cast(float, w & 0xffff0000u); }
__device__ __forceinline__ float sigm(float x) { return 1.f / (1.f + __expf(-x)); }
__device__ __forceinline__ float wave_sum(float v) {
#pragma unroll
    for (int o = 1; o < 64; o <<= 1) v += __shfl_xor(v, o);
    return v;
}
#define LDS_WAIT() asm volatile("s_waitcnt lgkmcnt(0)" ::: "memory")
#define LDS_BARRIER() do { asm volatile("s_waitcnt lgkmcnt(0)" ::: "memory"); __builtin_amdgcn_s_barrier(); asm volatile("" ::: "memory"); } while (0)
__device__ __forceinline__ float red16(float x) {
    float r;
    asm("s_nop 1\n\tv_add_f32_dpp %0, %1, %1 quad_perm:[1,0,3,2] row_mask:0xf bank_mask:0xf\n\ts_nop 1\n\t"
        "v_add_f32_dpp %0, %0, %0 quad_perm:[2,3,0,1] row_mask:0xf bank_mask:0xf\n\ts_nop 1\n\t"
        "v_add_f32_dpp %0, %0, %0 row_half_mirror row_mask:0xf bank_mask:0xf\n\ts_nop 1\n\t"
        "v_add_f32_dpp %0, %0, %0 row_mirror row_mask:0xf bank_mask:0xf\n\ts_nop 0" : "=&v"(r) : "v"(x));
    return r;
}

#define XB_TMO      128
#define XB_XCNT(j)  (256  + 64 * (j))
#define XB_XSUB(j)  (1280 + 64 * (j))
#define XB_XGEN(j)  (2304 + 64 * (j))
#define XB_TOP      3328
#define XB_TOPGEN   3392
#define XCD_BAR_WORDS 3456
#define XB_SPIN_CAP (1u << 18)
__device__ __forceinline__ unsigned xb_ld(unsigned* p)              { return __hip_atomic_load(p, __ATOMIC_RELAXED, __HIP_MEMORY_SCOPE_AGENT); }
__device__ __forceinline__ unsigned xb_add(unsigned* p, unsigned v) { return __hip_atomic_fetch_add(p, v, __ATOMIC_RELAXED, __HIP_MEMORY_SCOPE_AGENT); }
__device__ __forceinline__ unsigned xb_xcc_id() { return (unsigned)__builtin_amdgcn_s_getreg((3 << 11) | 20) & 0xFu; }
#define XB_SPIN(cond, bar) do { unsigned _sp = 0; while (cond) { __builtin_amdgcn_s_sleep(1); \
    if ((++_sp & 255u) == 0u) { if (xb_ld(&(bar)[XB_TMO])) break; if (_sp > XB_SPIN_CAP) { atomicAdd(&(bar)[XB_TMO], 1u); break; } } } } while (0)
struct XcdBarrier { unsigned* bar; unsigned x; volatile LAS unsigned* st; };
__device__ __forceinline__ XcdBarrier xcd_barrier_post(unsigned* bar, volatile LAS unsigned* st) {
    XcdBarrier b; b.bar = bar; b.x = xb_xcc_id(); b.st = st;
    if (threadIdx.x == 0) (void)xb_add(&bar[XB_XCNT(b.x)], 1u);
    return b;
}
__device__ __forceinline__ void xcd_barrier_complete(unsigned* bar, unsigned x, unsigned& nloc, unsigned& nx) {
    const unsigned G = gridDim.x * gridDim.y * gridDim.z;
    unsigned sum, cnt, mine, sp = 0u;
    for (;;) {
        sum = 0u; cnt = 0u; mine = 0u;
#pragma unroll
        for (unsigned j = 0; j < 16; ++j) { const unsigned c = xb_ld(&bar[XB_XCNT(j)]); sum += c; cnt += (c > 0u) ? 1u : 0u; mine = (j == x) ? c : mine; }
        if (sum == G) break;
        __builtin_amdgcn_s_sleep(1);
        if ((++sp & 255u) == 0u) { if (xb_ld(&bar[XB_TMO])) break; if (sp > XB_SPIN_CAP) { atomicAdd(&bar[XB_TMO], 1u); break; } }
    }
    nloc = mine > 0u ? mine : 1u; nx = cnt > 0u ? cnt : 1u;
}
__device__ __forceinline__ void xcd_barrier(const XcdBarrier& b) {
    asm volatile("s_waitcnt vmcnt(0)" ::: "memory");
    __syncthreads();
    if (threadIdx.x == 0) {
        unsigned* bar = b.bar;
        __builtin_amdgcn_s_waitcnt(0);
        unsigned nloc = b.st[0], nx = b.st[1];
        if (nloc == 0u) { xcd_barrier_complete(bar, b.x, nloc, nx); b.st[0] = nloc; b.st[1] = nx; }
        const unsigned old = xb_add(&bar[XB_XSUB(b.x)], 1u);
        const unsigned gen = old / nloc;
        if (old + 1u == (gen + 1u) * nloc) {
            __builtin_amdgcn_fence(__ATOMIC_RELEASE, "agent");
            asm volatile("s_waitcnt vmcnt(0)" ::: "memory");
            const unsigned og = xb_add(&bar[XB_TOP], 1u);
            const unsigned tg = og / nx;
            if (og + 1u == (tg + 1u) * nx) xb_add(&bar[XB_TOPGEN], 1u);
            else XB_SPIN(xb_ld(&bar[XB_TOPGEN]) == tg, bar);
            __builtin_amdgcn_fence(__ATOMIC_ACQUIRE, "agent");
            xb_add(&bar[XB_XGEN(b.x)], 1u);
            asm volatile("s_waitcnt vmcnt(0)" ::: "memory");
        } else {
            XB_SPIN(xb_ld(&bar[XB_XGEN(b.x)]) == gen, bar);
            __builtin_amdgcn_fence(__ATOMIC_ACQUIRE, "agent");
            asm volatile("s_waitcnt vmcnt(0)" ::: "memory");
        }
    }
    __syncthreads();
}

struct Args {
    const float* in[29];
    float* out; unsigned char* ws;
    int ph_lo, ph_hi;
};
enum { I_X = 0, I_C, I_CTX, I_CCTX, I_ADAW, I_ADAB, I_NMPRE, I_NMPOST, I_NFPRE, I_NFPOST, I_WIN, I_WOUT, I_QN, I_KN, I_MU, I_W0, I_WUP, I_A0, I_AUP, I_GUP,
       I_KK, I_KA, I_RK, I_LNW, I_LNB, I_SCW, I_FUP, I_FCONV, I_FDN };

struct Frame {
    LAS unsigned char* lds;
    int tid, lane, wave, bid, G;
    unsigned char* ws;
    float* out;
};
constexpr int PTR_OFF = LDSCTL_OFF + 1024;
#define INP(i) ((const float*)(const GAS float*)(((const unsigned long long LAS*)(F.lds + PTR_OFF))[i]))

__device__ __forceinline__ void transpose_item(const float* W, int K, int N, bf16* WT, LAS float* scr, int item, int lane) {
    const int nblk = N / 32, kb = item / nblk, nb = item % nblk, k0 = 64 * kb, n0 = 32 * nb;
#pragma unroll 8
    for (int i = 0; i < 32; ++i) { const int kk = 2 * i + (lane >> 5); scr[kk * 33 + (lane & 31)] = W[(size_t)(k0 + kk) * N + n0 + (lane & 31)]; }
    LDS_WAIT(); asm volatile("" ::: "memory");
    const int c = lane & 7;
#pragma unroll
    for (int j = 0; j < 4; ++j) { const int n = (lane >> 3) + 8 * j; const LAS float* s = scr + (8 * c) * 33 + n;
        v4u o; o.x = pk2(s[0 * 33], s[1 * 33]); o.y = pk2(s[2 * 33], s[3 * 33]); o.z = pk2(s[4 * 33], s[5 * 33]); o.w = pk2(s[6 * 33], s[7 * 33]);
        *(v4u*)(WT + (size_t)(n0 + n) * K + k0 + 8 * c) = o; }
    LDS_WAIT(); asm volatile("" ::: "memory");
}
__device__ __forceinline__ void convert_weights(const Frame& F, int l) {
    LAS float* scr = (LAS float*)(F.lds + F.wave * 8448);
    const int gw = F.bid * NWAVES + F.wave, NGW = F.G * NWAVES;
    const float* w_in = INP(I_WIN) + (size_t)l * D * NIN; const float* w_out = INP(I_WOUT) + (size_t)l * D * D;
    const float* w_up = INP(I_FUP) + (size_t)l * D * DFF2; const float* w_dn = INP(I_FDN) + (size_t)l * DFF * D;
    bf16* t_in = (bf16*)(F.ws + WS_WIN); bf16* t_out = (bf16*)(F.ws + WS_WOUT); bf16* t_up = (bf16*)(F.ws + WS_WUP); bf16* t_dn = (bf16*)(F.ws + WS_WDN);
    constexpr int I_1 = (D / 64) * (NIN / 32), I_2 = (D / 64) * (D / 32), I_3 = (D / 64) * (DFF2 / 32), I_4 = (DFF / 64) * (D / 32);
    for (int it = gw; it < I_1 + I_2 + I_3 + I_4; it += NGW) {
        int r = it;
        if (r < I_1) { transpose_item(w_in, D, NIN, t_in, scr, r, F.lane); continue; } r -= I_1;
        if (r < I_2) { transpose_item(w_out, D, D, t_out, scr, r, F.lane); continue; } r -= I_2;
        if (r < I_3) { transpose_item(w_up, D, DFF2, t_up, scr, r, F.lane); continue; } r -= I_3;
        transpose_item(w_dn, DFF, D, t_dn, scr, r, F.lane);
    }
    {
        const float* wup = INP(I_WUP) + (size_t)l * 2 * 64 * 256; const float* aup = INP(I_AUP) + (size_t)l * 2 * 64 * 256; const float* gup = INP(I_GUP) + (size_t)l * 128 * 256;
        bf16* lr = (bf16*)(F.ws + WS_LR);
        for (int it = gw; it < 48; it += NGW) {
            if (it < 16) transpose_item(wup + (size_t)(it >> 3) * 64 * 256, 64, 256, lr + (size_t)(it >> 3) * 256 * 64, scr, it & 7, F.lane);
            else if (it < 32) transpose_item(aup + (size_t)((it - 16) >> 3) * 64 * 256, 64, 256, lr + 2 * 256 * 64 + (size_t)((it - 16) >> 3) * 256 * 64, scr, it & 7, F.lane);
            else transpose_item(gup, 128, 256, lr + 4 * 256 * 64, scr, it - 32, F.lane);
        }
    }
    v4u z = {0u, 0u, 0u, 0u};
    for (int i = F.bid * NTHR + F.tid; i < (NINP - NIN) * D / 8; i += F.G * NTHR) *(v4u*)(t_in + (size_t)NIN * D + (size_t)i * 8) = z;
}

__device__ __forceinline__ void phase_pro_a(const Frame& F) {
    convert_weights(F, 0);
    __syncthreads();
    float* rope = (float*)(F.ws + WS_ROPE);
    for (int e = F.bid * NTHR + F.tid; e < TL * 32; e += F.G * NTHR) {
        const int pos = e >> 5, i = e & 31;
        const float inv = powf(10000.0f, -(float)(i & 15) / 16.0f);
        const float p = (i < 16) ? (float)(pos / 64) : (float)(pos % 64);
        const float ang = p * inv;
        rope[2 * e] = cosf(ang); rope[2 * e + 1] = sinf(ang);
    }
    LAS float* sc = (LAS float*)F.lds;
    LAS float* red = (LAS float*)(F.lds + 20480);
    for (int i = F.tid; i < 5 * 1024; i += NTHR) { const int r = i >> 10, k = i & 1023; const float v = r < 4 ? INP(I_C)[r * 1024 + k] : INP(I_CCTX)[k]; sc[i] = v / (1.f + expf(-v)); }
    __syncthreads();
    float* mods = (float*)(F.ws + WS_MODS);
    for (int item = F.bid; item < NL * 96; item += F.G) {
        const int l = item / 96, jg = item % 96;
        const int c4 = (F.lane & 15) * 4, kq = F.lane >> 4;
        const float* w = INP(I_ADAW) + (size_t)l * 1024 * 6144 + jg * 64 + c4;
        f32x4 a0 = {0.f, 0.f, 0.f, 0.f}, a1 = a0, a2 = a0, a3 = a0, a4 = a0;
        const int kb = F.wave * 128;
#pragma unroll 8
        for (int i = 0; i < 32; ++i) { const int k = kb + 4 * i + kq; const f32x4 wv = *(const f32x4*)(w + (size_t)k * 6144);
            a0 += wv * sc[k]; a1 += wv * sc[1024 + k]; a2 += wv * sc[2048 + k]; a3 += wv * sc[3072 + k]; a4 += wv * sc[4096 + k]; }
#pragma unroll
        for (int e = 0; e < 4; ++e) {
            a0[e] += __shfl_xor(a0[e], 16); a0[e] += __shfl_xor(a0[e], 32); a1[e] += __shfl_xor(a1[e], 16); a1[e] += __shfl_xor(a1[e], 32);
            a2[e] += __shfl_xor(a2[e], 16); a2[e] += __shfl_xor(a2[e], 32); a3[e] += __shfl_xor(a3[e], 16); a3[e] += __shfl_xor(a3[e], 32);
            a4[e] += __shfl_xor(a4[e], 16); a4[e] += __shfl_xor(a4[e], 32); }
        if (kq == 0) {
            *(LAS f32x4*)(red + (F.wave * 5 + 0) * 64 + c4) = a0; *(LAS f32x4*)(red + (F.wave * 5 + 1) * 64 + c4) = a1; *(LAS f32x4*)(red + (F.wave * 5 + 2) * 64 + c4) = a2;
            *(LAS f32x4*)(red + (F.wave * 5 + 3) * 64 + c4) = a3; *(LAS f32x4*)(red + (F.wave * 5 + 4) * 64 + c4) = a4; }
        __syncthreads();
        if (F.tid < 320) { const int r = F.tid >> 6, j = F.tid & 63; float s_ = 0.f;
#pragma unroll
            for (int w8 = 0; w8 < 8; ++w8) s_ += red[(w8 * 5 + r) * 64 + j];
            mods[((size_t)l * 5 + r) * 6144 + jg * 64 + j] = s_ + INP(I_ADAB)[l * 6144 + jg * 64 + j]; }
        __syncthreads();
    }
}

__device__ __forceinline__ void norm_phase(const Frame& F, int mode, const float* o, const float* g_post, int lmod_gate, int i_gate,
                                           const float* g_next, int lmod_next, int i_shift, int i_scale, int nks  ) {
    const int gw = F.bid * NWAVES + F.wave, NGW = F.G * NWAVES;
    float* xcur = (float*)(F.ws + WS_XCUR); bf16* xn = (bf16*)(F.ws + WS_AR + AR_XN);
    const float* mods = (const float*)(F.ws + WS_MODS);
    const int b = gw & 3, w4 = gw >> 2, NW4 = NGW >> 2;
    f32x4 c_gp[4], c_gt[4], c_gn[4], c_sh[4], c_sc[4];
#pragma unroll
    for (int j = 0; j < 4; ++j) { const int c0 = 4 * F.lane + 256 * j; const f32x4 z4 = {0.f, 0.f, 0.f, 0.f};
        c_gp[j] = mode >= 1 ? *(const f32x4*)(g_post + c0) : z4; c_gt[j] = mode >= 1 ? *(const f32x4*)(mods + ((size_t)lmod_gate * 5 + b) * 6144 + i_gate * 1024 + c0) : z4;
        c_gn[j] = mode <= 1 ? *(const f32x4*)(g_next + c0) : z4;
        c_sh[j] = mode <= 1 ? *(const f32x4*)(mods + ((size_t)lmod_next * 5 + b) * 6144 + i_shift * 1024 + c0) : z4;
        c_sc[j] = mode <= 1 ? *(const f32x4*)(mods + ((size_t)lmod_next * 5 + b) * 6144 + i_scale * 1024 + c0) : z4; }
    for (int s = w4; s < SB; s += NW4) {
        const int m = b * SB + s; const bool ctx = s < CT;
        f32x4 x[4];
        if (mode == 0) {
            const float* src = ctx ? INP(I_CTX) + ((size_t)b * CT + s) * D : INP(I_X) + ((size_t)b * TL + (s - CT)) * D;
#pragma unroll
            for (int j = 0; j < 4; ++j) x[j] = *(const f32x4*)(src + 4 * F.lane + 256 * j);
        } else {
            f32x4 ov[4], xv[4]; float ss = 0.f;
#pragma unroll
            for (int j = 0; j < 4; ++j) xv[j] = *(const f32x4*)(xcur + (size_t)m * D + 4 * F.lane + 256 * j);
#pragma unroll
            for (int j = 0; j < 4; ++j) {
                if (ctx) { const float* pp = (const float*)(F.ws + WS_AR + AR_PART) + ((size_t)b * 256 + s) * D + 4 * F.lane + 256 * j; f32x4 a = {0.f, 0.f, 0.f, 0.f};
                    for (int ks = 0; ks < nks; ++ks) a += *(const f32x4*)(pp + (size_t)ks * 4 * 256 * D);
                    ov[j] = a; }
                else { const v2u w_ = *(const v2u*)((const bf16*)o + (size_t)m * D + 4 * F.lane + 256 * j); ov[j] = (f32x4){bflo(w_.x), bfhi(w_.x), bflo(w_.y), bfhi(w_.y)}; }
                ss += ov[j][0] * ov[j][0] + ov[j][1] * ov[j][1] + ov[j][2] * ov[j][2] + ov[j][3] * ov[j][3]; }
            ss = wave_sum(ss);
            const float rs = rsqrtf(ss * (1.f / D) + NORM_EPS);
#pragma unroll
            for (int j = 0; j < 4; ++j) { const int c0 = 4 * F.lane + 256 * j;
                const f32x4 gt = ctx ? *(const f32x4*)(mods + ((size_t)lmod_gate * 5 + 4) * 6144 + i_gate * 1024 + c0) : c_gt[j];
                x[j] = xv[j] + gt * (ov[j] * rs * c_gp[j]); }
        }
        if (mode == 2) {
            if (!ctx) {
#pragma unroll
                for (int j = 0; j < 4; ++j) *(f32x4*)(F.out + ((size_t)b * TL + (s - CT)) * D + 4 * F.lane + 256 * j) = x[j];
            }
            continue;
        }
        float ss = 0.f;
#pragma unroll
        for (int j = 0; j < 4; ++j) { *(f32x4*)(xcur + (size_t)m * D + 4 * F.lane + 256 * j) = x[j]; ss += x[j][0] * x[j][0] + x[j][1] * x[j][1] + x[j][2] * x[j][2] + x[j][3] * x[j][3]; }
        ss = wave_sum(ss);
        const float rs = rsqrtf(ss * (1.f / D) + NORM_EPS);
#pragma unroll
        for (int j = 0; j < 4; ++j) { const int c0 = 4 * F.lane + 256 * j;
            const f32x4 sh = ctx ? *(const f32x4*)(mods + ((size_t)lmod_next * 5 + 4) * 6144 + i_shift * 1024 + c0) : c_sh[j];
            const f32x4 scl = ctx ? *(const f32x4*)(mods + ((size_t)lmod_next * 5 + 4) * 6144 + i_scale * 1024 + c0) : c_sc[j];
            const f32x4 y = x[j] * rs * c_gn[j] * (scl + 1.f) + sh;
            v2u w; w.x = pk2(y[0], y[1]); w.y = pk2(y[2], y[3]);
            *(v2u*)(xn + (size_t)m * D + c0) = w; }
    }
}

typedef short pbf16x8 __attribute__((ext_vector_type(8)));
constexpr int PZ_LD = 1152, PA_LD = 136, P_TH = 16 * PZ_LD * 4, P_AD = P_TH + 16 * PA_LD * 2, P_SG = P_AD + 16 * PA_LD * 2, P_KN = P_SG + 16 * PA_LD * 2;
__device__ __forceinline__ void unpack8(const v4u& w, float (&x)[8]) {
#pragma unroll
    for (int q = 0; q < 4; ++q) { x[2 * q] = bflo(w[q]); x[2 * q + 1] = bfhi(w[q]); }
}
__device__ __forceinline__ v4u pack8(const float (&x)[8]) { v4u w;
#pragma unroll
    for (int q = 0; q < 4; ++q) w[q] = pk2(x[2 * q], x[2 * q + 1]);
    return w; }
__device__ __forceinline__ void prep_phase(const Frame& F, int l) {
    LAS float* ZS = (LAS float*)F.lds;
    LAS bf16* TH = (LAS bf16*)(F.lds + P_TH); LAS bf16* AD = (LAS bf16*)(F.lds + P_AD); LAS bf16* SG = (LAS bf16*)(F.lds + P_SG);
    LAS float* KN = (LAS float*)(F.lds + P_KN);
    const bf16* U = (const bf16*)(F.ws + WS_AR + AR_U);
    bf16* QKV = (bf16*)(F.ws + WS_AR + AR_QKV);
    const float* rope = (const float*)(F.ws + WS_ROPE);
    const float* qn = INP(I_QN) + l * 64; const float* kn = INP(I_KN) + l * 64;
    const float* mu = INP(I_MU) + (size_t)l * 2 * R_IN;
    const float* w0 = INP(I_W0) + l * 512; const float* a0 = INP(I_A0) + l * 512;
    const float* k_k = INP(I_KK) + l * 256; const float* k_a = INP(I_KA) + l * 256;
    const float* scw = INP(I_SCW) + (size_t)l * 3 * 256;
    const bf16* lr = (const bf16*)(F.ws + WS_LR);
    bf16* R_o = (bf16*)(F.ws + WS_AR + AR_R); bf16* V_o = (bf16*)(F.ws + WS_AR + AR_V); bf16* KK_o = (bf16*)(F.ws + WS_AR + AR_KK); bf16* G_o = (bf16*)(F.ws + WS_AR + AR_G);
    bf16* KE_o = (bf16*)(F.ws + WS_AR + AR_KE); bf16* KKA_o = (bf16*)(F.ws + WS_AR + AR_KKA); float* W_o = (float*)(F.ws + WS_AR + AR_W);
    bf16* MIX = (bf16*)(F.ws + WS_AR + AR_MIX);
    const int lane = F.lane, wv = F.wave, tid = F.tid, fr = lane & 15, fq = lane >> 4;
    LAS float* CM = (LAS float*)(F.lds + P_KN + 256); LAS float* CP = CM + 2 * R_IN; LAS float* CS = CP + 6 * 256; LAS float* CG = CS + 3 * 256;
    for (int i = tid; i < 2 * R_IN; i += NTHR) CM[i] = mu[i];
    for (int i = tid; i < 256; i += NTHR) { CP[i] = k_k[i]; CP[256 + i] = k_a[i]; CP[512 + i] = w0[i]; CP[768 + i] = w0[256 + i]; CP[1024 + i] = a0[i]; CP[1280 + i] = a0[256 + i]; }
    for (int i = tid; i < 768; i += NTHR) CS[i] = scw[i];
    if (tid < 64) { CG[tid] = qn[tid]; CG[64 + tid] = kn[tid]; }
    __syncthreads();
    const bool bact = tid < 432; const int bch = bact ? tid % 144 : 0, btq = bact ? tid / 144 : 0, bc0 = bch * 8;
    const bool bisk = bact && bc0 >= 256 && bc0 < 512;
    const int ad0 = (lane & 7) * 8;
    const int dc0 = (tid & 31) * 8;
    const bool xaff = F.G == 256;
    for (int it_ = xaff ? ((F.bid >> 3) + 32 * (F.bid & 1)) : F.bid; it_ < (xaff ? SB / 16 : M / 16); it_ += (xaff ? 64 : F.G)) {
        const int item = xaff ? ((F.bid & 7) >> 1) * (SB / 16) + it_ : it_;
        const int m0 = item * 16, s0 = m0 % SB;
        const bool isctx = s0 < CT; const int seq_lo = isctx ? 0 : CT, seq_hi = isctx ? CT : SB;
        v4u araw[2][2], avc[2]; f32x4 arp[2][4];
#pragma unroll
        for (int rr = 0; rr < 2; ++rr) { const int t = 2 * wv + rr; const bf16* ur = U + (size_t)(m0 + t) * NINP;
            araw[rr][0] = *(const v4u*)(ur + 8 * lane); araw[rr][1] = *(const v4u*)(ur + K_OFF + 8 * (lane & 15)); avc[rr] = *(const v4u*)(ur + V_OFF + 8 * (lane & 15));
            const int pos = isctx ? 0 : (s0 + t - CT); const float* rp = rope + ((size_t)pos * 32 + (ad0 & 31)) * 2;
#pragma unroll
            for (int e = 0; e < 4; ++e) arp[rr][e] = *(const f32x4*)(rp + 4 * e); }
        v4u dbg, dcg[3], dxc[3];
        { const int t = tid >> 5, s = s0 + t; const bf16* u = U + (size_t)(m0 + t) * NINP + C_OFF + dc0;
          const int dp = s > seq_lo ? -NINP : 0, dn = s < seq_hi - 1 ? NINP : 0;
          dbg = *(const v4u*)u; dcg[1] = *(const v4u*)(u + 256); dxc[1] = *(const v4u*)(u + 512);
          dcg[0] = *(const v4u*)(u + dp + 256); dxc[0] = *(const v4u*)(u + dp + 512); dcg[2] = *(const v4u*)(u + dn + 256); dxc[2] = *(const v4u*)(u + dn + 512); }
#pragma unroll
        for (int rr = 0; rr < 2; ++rr) {
            const int t = 2 * wv + rr, m = m0 + t;
            bf16* orow = QKV + (size_t)m * QKVP;
#pragma unroll
            for (int pass = 0; pass < 2; ++pass) {
                const bool act = pass == 0 || lane < 16;
                const int col = (pass == 0 ? 0 : K_OFF) + 8 * lane;
                float x[8]; unpack8(araw[rr][pass], x);
                float ss = 0.f;
#pragma unroll
                for (int e = 0; e < 8; ++e) ss += x[e] * x[e];
                ss += __shfl_xor(ss, 1); ss += __shfl_xor(ss, 2); ss += __shfl_xor(ss, 4);
                const float rs = rsqrtf(ss * (1.f / 64.f) + NORM_EPS);
                const f32x4 g0 = *(const LAS f32x4*)(CG + pass * 64 + ad0), g1 = *(const LAS f32x4*)(CG + pass * 64 + ad0 + 4);
                float y[8];
#pragma unroll
                for (int e = 0; e < 4; ++e) { y[e] = x[e] * rs * g0[e]; y[4 + e] = x[4 + e] * rs * g1[e]; }
                float yp[8];
#pragma unroll
                for (int e = 0; e < 8; ++e) yp[e] = __shfl_xor(y[e], 4);
                if (!isctx) {
                    const bool lo_half = ad0 < 32;
#pragma unroll
                    for (int e = 0; e < 8; e += 2) { const f32x4 cs = arp[rr][e >> 1];
                        y[e] = lo_half ? (y[e] * cs[0] - yp[e] * cs[1]) : (y[e] * cs[0] + yp[e] * cs[1]);
                        y[e + 1] = lo_half ? (y[e + 1] * cs[2] - yp[e + 1] * cs[3]) : (y[e + 1] * cs[2] + yp[e + 1] * cs[3]); }
                }
                if (pass == 0) {
#pragma unroll
                    for (int e = 0; e < 8; ++e) y[e] *= C2;
                }
                if (act) *(v4u*)(orow + col) = pack8(y);
            }
            if (lane < 16) *(v4u*)(orow + V_OFF + 8 * lane) = avc[rr];
        }
        { const int t = tid >> 5, s = s0 + t;
          float bg[8], c1[8], x1[8], p[8], pp[8], pn[8];
          unpack8(dbg, bg); unpack8(dcg[1], c1); unpack8(dxc[1], x1);
#pragma unroll
          for (int e = 0; e < 8; ++e) p[e] = c1[e] * x1[e];
          unpack8(dcg[0], c1); unpack8(dxc[0], x1);
          const float mp = s > seq_lo ? 1.f : 0.f, mn = s < seq_hi - 1 ? 1.f : 0.f;
#pragma unroll
          for (int e = 0; e < 8; ++e) pp[e] = c1[e] * x1[e] * mp;
          unpack8(dcg[2], c1); unpack8(dxc[2], x1);
#pragma unroll
          for (int e = 0; e < 8; ++e) pn[e] = c1[e] * x1[e] * mn;
          float o[8];
#pragma unroll
          for (int e = 0; e < 8; ++e) o[e] = bg[e] * (pp[e] * CS[dc0 + e] + p[e] * CS[256 + dc0 + e] + pn[e] * CS[512 + dc0 + e]);
          *(v4u*)(MIX + (size_t)(m0 + t) * D + 768 + dc0) = pack8(o); }
#pragma unroll 1
        for (int hb = 0; hb < 2; ++hb)
        { const int t0 = 6 * btq + 3 * hb, ntok = btq == 2 ? (hb == 0 ? 3 : 1) : 3;
          const f32x4 mu0a = *(const LAS f32x4*)(CM + bc0), mu0b = *(const LAS f32x4*)(CM + bc0 + 4), mu1a = *(const LAS f32x4*)(CM + R_IN + bc0), mu1b = *(const LAS f32x4*)(CM + R_IN + bc0 + 4);
          const f32x4 bkka = bisk ? *(const LAS f32x4*)(CP + bc0 - 256) : (f32x4){0.f, 0.f, 0.f, 0.f}, bkkb = bisk ? *(const LAS f32x4*)(CP + bc0 - 252) : (f32x4){0.f, 0.f, 0.f, 0.f};
          v4u rw[5];
#pragma unroll
          for (int jj = 0; jj < 5; ++jj) { int sr_ = s0 + t0 - 1 + jj; sr_ = sr_ < seq_lo ? seq_lo : (sr_ > seq_hi - 1 ? seq_hi - 1 : sr_);
              const int tt = sr_ - s0; const int tcl = tt > 16 ? 16 : tt;
              rw[jj] = *(const v4u*)(U + (unsigned)(m0 + tcl) * (unsigned)NINP + (unsigned)(R_OFF + bc0)); }
#pragma unroll
          for (int jj = 1; jj <= 3; ++jj) {
              const int t = t0 + jj - 1, s = s0 + t; const bool tv = bact && jj <= ntok;
              float z[8], pv[8], nx[8];
              unpack8(rw[jj], z); unpack8(rw[jj - 1], pv); unpack8(rw[jj + 1], nx);
              const float mp = s > seq_lo ? 1.f : 0.f, mn = s < seq_hi - 1 ? 1.f : 0.f;
#pragma unroll
              for (int e = 0; e < 4; ++e) { z[e] = z[e] + mu0a[e] * (pv[e] * mp - z[e]) + mu1a[e] * (nx[e] * mn - z[e]); z[4 + e] = z[4 + e] + mu0b[e] * (pv[4 + e] * mp - z[4 + e]) + mu1b[e] * (nx[4 + e] * mn - z[4 + e]); }
              if (tv) { *(LAS f32x4*)(ZS + t * PZ_LD + bc0) = (f32x4){z[0], z[1], z[2], z[3]}; *(LAS f32x4*)(ZS + t * PZ_LD + bc0 + 4) = (f32x4){z[4], z[5], z[6], z[7]}; }
              float ss = 0.f;
#pragma unroll
              for (int e = 0; e < 4; ++e) { const float u0 = z[e] * bkka[e], u1 = z[4 + e] * bkkb[e]; ss += u0 * u0 + u1 * u1; }
              ss += __shfl_xor(ss, 1); ss += __shfl_xor(ss, 2); ss += __shfl_xor(ss, 4);
              if (tv && bisk && (bch & 7) == 0) KN[t * 4 + ((bc0 - 256) >> 6)] = rsqrtf(fmaxf(ss, 1e-12f));
              if (tv && bc0 >= 768) {
                  float q[8];
                  if (bc0 < 896) {
#pragma unroll
                      for (int e = 0; e < 8; ++e) q[e] = 1.f - 2.f / (1.f + __expf(2.f * z[e]));
                      *(LAS v4u*)(TH + t * PA_LD + (bc0 - 768)) = pack8(q);
                  } else if (bc0 < 1024) { *(LAS v4u*)(AD + t * PA_LD + (bc0 - 896)) = pack8(z); }
                  else {
#pragma unroll
                      for (int e = 0; e < 8; ++e) q[e] = sigm(z[e]);
                      *(LAS v4u*)(SG + t * PA_LD + (bc0 - 1024)) = pack8(q);
                  }
              }
          } }
        LDS_BARRIER();
        pbf16x8 bwf[2][2][2], baf[2][2][2], bgf[2][4];
#pragma unroll
        for (int nt = 0; nt < 2; ++nt) { const int cw = 32 * wv + 16 * nt + fr;
#pragma unroll
            for (int d = 0; d < 2; ++d)
#pragma unroll
                for (int kb = 0; kb < 2; ++kb) { bwf[nt][d][kb] = *(const pbf16x8*)(lr + (size_t)d * 256 * 64 + (size_t)cw * 64 + kb * 32 + fq * 8);
                    baf[nt][d][kb] = *(const pbf16x8*)(lr + 2 * 256 * 64 + (size_t)d * 256 * 64 + (size_t)cw * 64 + kb * 32 + fq * 8); }
#pragma unroll
            for (int kb = 0; kb < 4; ++kb) bgf[nt][kb] = *(const pbf16x8*)(lr + 4 * 256 * 64 + (size_t)cw * 128 + kb * 32 + fq * 8); }
        { pbf16x8 tha[2][2], ada[2][2], sga[4];
#pragma unroll
          for (int d = 0; d < 2; ++d)
#pragma unroll
              for (int kb = 0; kb < 2; ++kb) { tha[d][kb] = *(const LAS pbf16x8*)(TH + fr * PA_LD + d * 64 + kb * 32 + fq * 8); ada[d][kb] = *(const LAS pbf16x8*)(AD + fr * PA_LD + d * 64 + kb * 32 + fq * 8); }
#pragma unroll
          for (int kb = 0; kb < 4; ++kb) sga[kb] = *(const LAS pbf16x8*)(SG + fr * PA_LD + kb * 32 + fq * 8);
#pragma unroll
          for (int nt = 0; nt < 2; ++nt) {
              const int n0 = 32 * wv + 16 * nt;
              f32x4 accW[2], accA[2], accG = {0.f, 0.f, 0.f, 0.f};
#pragma unroll
              for (int d = 0; d < 2; ++d) { accW[d] = (f32x4){0.f, 0.f, 0.f, 0.f}; accA[d] = (f32x4){0.f, 0.f, 0.f, 0.f};
#pragma unroll
                  for (int kb = 0; kb < 2; ++kb) {
                      accW[d] = __builtin_amdgcn_mfma_f32_16x16x32_bf16(bwf[nt][d][kb], tha[d][kb], accW[d], 0, 0, 0);
                      accA[d] = __builtin_amdgcn_mfma_f32_16x16x32_bf16(baf[nt][d][kb], ada[d][kb], accA[d], 0, 0, 0);
                  } }
#pragma unroll
              for (int kb = 0; kb < 4; ++kb) accG = __builtin_amdgcn_mfma_f32_16x16x32_bf16(bgf[nt][kb], sga[kb], accG, 0, 0, 0);
              const int t = fr, c0 = n0 + 4 * fq; const unsigned o = (unsigned)(m0 + t) * 256u + (unsigned)c0;
              const f32x4 kv = *(const LAS f32x4*)(ZS + t * PZ_LD + 256 + c0), rv = *(const LAS f32x4*)(ZS + t * PZ_LD + c0), vv = *(const LAS f32x4*)(ZS + t * PZ_LD + 512 + c0);
              const f32x4 kkc = *(const LAS f32x4*)(CP + c0), kac = *(const LAS f32x4*)(CP + 256 + c0), w00 = *(const LAS f32x4*)(CP + 512 + c0), w01 = *(const LAS f32x4*)(CP + 768 + c0), a00 = *(const LAS f32x4*)(CP + 1024 + c0), a01 = *(const LAS f32x4*)(CP + 1280 + c0);
              const float knv = KN[t * 4 + (c0 >> 6)];
              f32x4 kk4, lw0, lw1, ke0, ke1, ka0, ka1;
#pragma unroll
              for (int e = 0; e < 4; ++e) { kk4[e] = kv[e] * kkc[e] * knv;
                  lw0[e] = -DECAY_SCALE * sigm(accW[0][e] + w00[e]); lw1[e] = -DECAY_SCALE * sigm(accW[1][e] + w01[e]);
                  const float av0 = sigm(accA[0][e] + a00[e]), av1 = sigm(accA[1][e] + a01[e]);
                  ke0[e] = kv[e] * (1.f + (av0 - 1.f) * kac[e]); ke1[e] = kv[e] * (1.f + (av1 - 1.f) * kac[e]); ka0[e] = kk4[e] * av0; ka1[e] = kk4[e] * av1; }
#define ST4(P, V) do { v2u w_; w_.x = pk2((V)[0], (V)[1]); w_.y = pk2((V)[2], (V)[3]); *(v2u*)(P) = w_; } while (0)
              ST4(R_o + o, rv); ST4(V_o + o, vv); ST4(KK_o + o, kk4); ST4(G_o + o, accG);
              *(f32x4*)(W_o + o) = lw0; *(f32x4*)(W_o + (unsigned)(M * 256) + o) = lw1;
              ST4(KE_o + o, ke0); ST4(KE_o + (unsigned)(M * 256) + o, ke1); ST4(KKA_o + o, ka0); ST4(KKA_o + (unsigned)(M * 256) + o, ka1);
#undef ST4
          } }
        LDS_BARRIER();
    }
}

__device__ __forceinline__ void rwkv_out_phase(const Frame& F, int l) {
    const float* Y = (const float*)(F.ws + WS_AR + AR_Y);
    const bf16* R_i = (const bf16*)(F.ws + WS_AR + AR_R); const bf16* V_i = (const bf16*)(F.ws + WS_AR + AR_V); const bf16* G_i = (const bf16*)(F.ws + WS_AR + AR_G);
    const bf16* KE_i = (const bf16*)(F.ws + WS_AR + AR_KE);
    bf16* MIX = (bf16*)(F.ws + WS_AR + AR_MIX);
    const int gw = F.bid * NWAVES + F.wave, NGW = F.G * NWAVES;
    const int c0 = 4 * F.lane;
    const f32x4 rk = *(const f32x4*)(INP(I_RK) + l * 256 + c0), lw = *(const f32x4*)(INP(I_LNW) + l * 256 + c0), lb = *(const f32x4*)(INP(I_LNB) + l * 256 + c0);
    for (int m = gw; m < M; m += NGW) {
        const unsigned o = (unsigned)m * 256u + (unsigned)c0;
        const f32x4 y0 = *(const f32x4*)(Y + o), y1 = *(const f32x4*)(Y + (unsigned)(M * 256) + o);
        const v2u rw_ = *(const v2u*)(R_i + o), vw = *(const v2u*)(V_i + o), gw_ = *(const v2u*)(G_i + o), k0 = *(const v2u*)(KE_i + o), k1 = *(const v2u*)(KE_i + (unsigned)(M * 256) + o);
        const f32x4 y = y0 + y1;
        const float mean = red16((y[0] + y[1]) + (y[2] + y[3])) * (1.f / 64.f);
        const f32x4 dl = y - mean;
        const float var = red16((dl[0] * dl[0] + dl[1] * dl[1]) + (dl[2] * dl[2] + dl[3] * dl[3])) * (1.f / 64.f);
        const float rs = rsqrtf(var + GN_EPS);
        const f32x4 rr = {bflo(rw_.x), bfhi(rw_.x), bflo(rw_.y), bfhi(rw_.y)}, vv = {bflo(vw.x), bfhi(vw.x), bflo(vw.y), bfhi(vw.y)}, gg = {bflo(gw_.x), bfhi(gw_.x), bflo(gw_.y), bfhi(gw_.y)};
        const f32x4 ke = (f32x4){bflo(k0.x), bfhi(k0.x), bflo(k0.y), bfhi(k0.y)} + (f32x4){bflo(k1.x), bfhi(k1.x), bflo(k1.y), bfhi(k1.y)};
        const f32x4 tt = rr * ke * rk;
        const float bon = red16((tt[0] + tt[1]) + (tt[2] + tt[3]));
        const f32x4 ov = (dl * rs * lw + lb + vv * bon) * gg;
        v2u w; w.x = pk2(ov[0], ov[1]); w.y = pk2(ov[2], ov[3]);
        *(v2u*)(MIX + (size_t)m * D + 512 + c0) = w;
    }
}

__device__ __forceinline__ void act_phase(const Frame& F, int l) {
    const bf16* H = (const bf16*)(F.ws + WS_AR + AR_H); bf16* ACT = (bf16*)(F.ws + WS_AR + AR_ACT);
    const float* wc = INP(I_FCONV) + (size_t)l * 3 * DFF2;
    constexpr int NCH = DFF / 8;
    const int nitems = (M / 8) * NCH;
    for (int it = F.bid * NTHR + F.tid; it < nitems; it += F.G * NTHR) {
        const int rg = it / NCH, ch = it % NCH, j0 = ch * 8, m0 = rg * 8, s0 = m0 % SB;
        const bool isctx = s0 < CT; const int seq_lo = isctx ? 0 : CT, seq_hi = isctx ? CT : SB;
        v4u gr[10], ur[10];
#pragma unroll
        for (int r = 0; r < 10; ++r) { int s = s0 - 1 + r; s = s < seq_lo ? seq_lo : (s > seq_hi - 1 ? seq_hi - 1 : s);
            const bf16* hr = H + (size_t)(m0 - s0 + s) * DFF2 + j0; gr[r] = *(const v4u*)hr; ur[r] = *(const v4u*)(hr + DFF); }
        float wg[3][8], wu[3][8];
#pragma unroll
        for (int tp = 0; tp < 3; ++tp) { const f32x4 a0 = *(const f32x4*)(wc + tp * DFF2 + j0), a1 = *(const f32x4*)(wc + tp * DFF2 + j0 + 4), b0 = *(const f32x4*)(wc + tp * DFF2 + DFF + j0), b1 = *(const f32x4*)(wc + tp * DFF2 + DFF + j0 + 4);
#pragma unroll
            for (int e = 0; e < 4; ++e) { wg[tp][e] = a0[e]; wg[tp][4 + e] = a1[e]; wu[tp][e] = b0[e]; wu[tp][4 + e] = b1[e]; } }
#pragma unroll
        for (int r = 0; r < 8; ++r) {
            const int s = s0 + r;
            const float mp = s > seq_lo ? 1.f : 0.f, mn = s < seq_hi - 1 ? 1.f : 0.f;
            v4u o;
#pragma unroll
            for (int q = 0; q < 4; ++q) {
                const float ga0 = bflo(gr[r][q]) * mp * wg[0][2 * q] + bflo(gr[r + 1][q]) * wg[1][2 * q] + bflo(gr[r + 2][q]) * mn * wg[2][2 * q];
                const float ga1 = bfhi(gr[r][q]) * mp * wg[0][2 * q + 1] + bfhi(gr[r + 1][q]) * wg[1][2 * q + 1] + bfhi(gr[r + 2][q]) * mn * wg[2][2 * q + 1];
                const float u0 = bflo(ur[r][q]) * mp * wu[0][2 * q] + bflo(ur[r + 1][q]) * wu[1][2 * q] + bflo(ur[r + 2][q]) * mn * wu[2][2 * q];
                const float u1 = bfhi(ur[r][q]) * mp * wu[0][2 * q + 1] + bfhi(ur[r + 1][q]) * wu[1][2 * q + 1] + bfhi(ur[r + 2][q]) * mn * wu[2][2 * q + 1];
                o[q] = pk2(ga0 / (1.f + __expf(-ga0)) * u0, ga1 / (1.f + __expf(-ga1)) * u1);
            }
            *(v4u*)(ACT + (size_t)(m0 + r) * DFF + j0) = o;
        }
    }
}

namespace attn_body {
using bf16=__hip_bfloat16;
using bf16x8=__attribute__((ext_vector_type(8)))short;
using s16x4=__attribute__((ext_vector_type(4)))short;
using f32x16=__attribute__((ext_vector_type(16)))float;
using u32x4=__attribute__((ext_vector_type(4)))unsigned;
constexpr int D=64,QP=768,OP=1024;
constexpr int NW=8,QBLK=32,QB=QBLK*NW,KVBLK=64;
constexpr int ATTN_UNIT_ROWS=QB;
__device__ __forceinline__ int crow(int r,int hi){return (r&3)+8*(r>>2)+4*hi;}
#define SBAR() __builtin_amdgcn_sched_barrier(0)
constexpr int NSLOT=3, SLOTB=8192;
constexpr int LDS_K=0, LDS_V=NSLOT*SLOTB, LDS_WS=2*NSLOT*SLOTB, LDS_OST=LDS_WS+NW*64*4, LDS_BYTES=LDS_OST+NW*4096;
__device__ __forceinline__ void glds16(const void*gsrc,unsigned lds_dst){unsigned keep;
  asm volatile("s_mov_b32 %0, m0\n\ts_mov_b32 m0, %2\n\ts_nop 0\n\tglobal_load_lds_dwordx4 %1, off\n\ts_mov_b32 m0, %0":"=&s"(keep):"v"(gsrc),"s"(lds_dst):"memory");}
__device__ __forceinline__ float max3f(float a,float b,float c){float r;asm("v_max3_f32 %0, %1, %2, %3":"=v"(r):"v"(a),"v"(b),"v"(c));return r;}
__device__ __forceinline__ float max2f(float a,float b){float r;asm("v_max_f32_e32 %0, %1, %2":"=v"(r):"v"(a),"v"(b));return r;}
__device__ __forceinline__ float fadd_s(float a,float b){float r;asm("v_add_f32_e32 %0, %1, %2":"=v"(r):"v"(a),"v"(b));return r;}
__device__ __forceinline__ float fsub_s(float a,float b){float r;asm("v_sub_f32_e32 %0, %1, %2":"=v"(r):"v"(a),"v"(b));return r;}
typedef float f32x2_t __attribute__((ext_vector_type(2))); typedef __bf16 bf16x2_t __attribute__((ext_vector_type(2)));
__device__ __forceinline__ unsigned cvtpk_s(float lo,float hi){f32x2_t v={lo,hi};bf16x2_t b=__builtin_convertvector(v,bf16x2_t);return __builtin_bit_cast(unsigned,b);}
#define WAIT_BAR(N) asm volatile("s_waitcnt vmcnt(" #N ") lgkmcnt(0)\n\ts_barrier":::"memory")

__device__ __forceinline__ void qkt(f32x16&p0,f32x16&p1,const char*Kslot,const bf16x8*qr,const f32x16&negm,int r32,int hi){
  const char*kb=Kslot+hi*1024+r32*16;
  #pragma unroll
  for(int d0=0;d0<4;++d0){
    const bf16x8 b0=*reinterpret_cast<const bf16x8*>(kb+d0*2048);
    const bf16x8 b1=*reinterpret_cast<const bf16x8*>(kb+d0*2048+512);
    if(d0==0){p0=__builtin_amdgcn_mfma_f32_32x32x16_bf16(b0,qr[0],negm,0,0,0);p1=__builtin_amdgcn_mfma_f32_32x32x16_bf16(b1,qr[0],negm,0,0,0);}
    else{p0=__builtin_amdgcn_mfma_f32_32x32x16_bf16(b0,qr[d0],p0,0,0,0);p1=__builtin_amdgcn_mfma_f32_32x32x16_bf16(b1,qr[d0],p1,0,0,0);}}
}
typedef __attribute__((address_space(3))) const char* lds_cptr;
typedef short v4i16_t __attribute__((ext_vector_type(4)));
__device__ __forceinline__ void kload8(bf16x8*kf,lds_cptr kp){
  kf[0]=*(const __attribute__((address_space(3))) bf16x8*)(kp);      kf[1]=*(const __attribute__((address_space(3))) bf16x8*)(kp+512);
  kf[2]=*(const __attribute__((address_space(3))) bf16x8*)(kp+2048); kf[3]=*(const __attribute__((address_space(3))) bf16x8*)(kp+2560);
  kf[4]=*(const __attribute__((address_space(3))) bf16x8*)(kp+4096); kf[5]=*(const __attribute__((address_space(3))) bf16x8*)(kp+4608);
  kf[6]=*(const __attribute__((address_space(3))) bf16x8*)(kp+6144); kf[7]=*(const __attribute__((address_space(3))) bf16x8*)(kp+6656);
}
__device__ __forceinline__ void kload2(bf16x8*kf,lds_cptr kp,int j){ kf[2*j]=*(const __attribute__((address_space(3))) bf16x8*)(kp+j*2048); kf[2*j+1]=*(const __attribute__((address_space(3))) bf16x8*)(kp+j*2048+512); }
__device__ __forceinline__ s16x4 vtr(lds_cptr p){ return __builtin_bit_cast(s16x4,__builtin_amdgcn_ds_read_tr16_b64_v4i16((__attribute__((address_space(3))) v4i16_t*)p)); }
__device__ __forceinline__ float rowmax(const f32x16&p0,const f32x16&p1){
  float a=max3f(p0[0],p0[1],p1[0]),b=max3f(p0[2],p0[3],p1[1]);a=max3f(a,p1[2],p1[3]);
  #pragma unroll
  for(int r=4;r<16;r+=4){a=max3f(a,p0[r],p0[r+1]);b=max3f(b,p0[r+2],p0[r+3]);a=max3f(a,p1[r],p1[r+1]);b=max3f(b,p1[r+2],p1[r+3]);}
  const float m=max2f(a,b);
  auto rr=__builtin_amdgcn_permlane32_swap(__float_as_uint(m),__float_as_uint(m),false,false);
  return max2f(__uint_as_float(rr[0]),__uint_as_float(rr[1]));
}
__device__ __forceinline__ void pv(f32x16*o,int vb,bf16x8 pa0,bf16x8 pa1,bf16x8 pa2,bf16x8 pa3){
  #pragma unroll
  for(int d0=0;d0<2;++d0){s16x4 lo[4],hi[4];
    #pragma unroll
    for(int ks=0;ks<4;++ks){
      asm volatile("ds_read_b64_tr_b16 %0,%1 offset:%c2":"=&v"(lo[ks]):"v"(vb),"i"(d0*4096+ks*1024):"memory");
      asm volatile("ds_read_b64_tr_b16 %0,%1 offset:%c2":"=&v"(hi[ks]):"v"(vb),"i"(d0*4096+ks*1024+512):"memory");}
    asm volatile("s_waitcnt lgkmcnt(0)":::"memory");SBAR();
    #define PK(k) (bf16x8){lo[k][0],lo[k][1],lo[k][2],lo[k][3],hi[k][0],hi[k][1],hi[k][2],hi[k][3]}
    o[d0]=__builtin_amdgcn_mfma_f32_32x32x16_bf16(pa0,PK(0),o[d0],0,0,0);
    o[d0]=__builtin_amdgcn_mfma_f32_32x32x16_bf16(pa1,PK(1),o[d0],0,0,0);
    o[d0]=__builtin_amdgcn_mfma_f32_32x32x16_bf16(pa2,PK(2),o[d0],0,0,0);
    o[d0]=__builtin_amdgcn_mfma_f32_32x32x16_bf16(pa3,PK(3),o[d0],0,0,0);
    #undef PK
  }
}

#ifndef ATTN_STORE16
#define ATTN_STORE16(p,v) (*(u32x4*)(p)=(v))
#endif
template<int THRL> __device__ __forceinline__ void attn_unit(const bf16*Qu,const bf16*__restrict__ Kh,const bf16*__restrict__ Vh,bf16*Ou,const int NT,char*shm){
  const int tid=threadIdx.x,lane=tid&63,r32=lane&31,hi=lane>>5; const int wid=__builtin_amdgcn_readfirstlane(tid>>6);
  const bf16*Qw=Qu+(long)(wid*QBLK)*QP;
  const unsigned lds0=(unsigned)(uintptr_t)shm;
  float*wsf=(float*)(shm+LDS_WS)+wid*64;
  const bf16*ksrc=Kh+(long)lane*QP+wid*8;
  const bf16*vsrc=Vh+(long)(16*(wid&3)+(lane>>2))*QP+(wid>>2)*32+(lane&3)*8;
  const unsigned kdst=lds0+LDS_K+wid*1024, vdst=lds0+LDS_V+wid*1024;
  #define DMA_K(t,slot) glds16(ksrc+(long)(t)*KVBLK*QP,(unsigned)__builtin_amdgcn_readfirstlane(kdst+(slot)))
  #define DMA_V(t,slot) glds16(vsrc+(long)(t)*KVBLK*QP,(unsigned)__builtin_amdgcn_readfirstlane(vdst+(slot)))
  const int vb0=(int)(lds0+LDS_V)+((lane>>4)&1)*32+(lane&3)*8+(4*hi+((lane&15)>>2))*64;
  const char*Kbase=shm+LDS_K; bf16x8 kf[8];
  const lds_cptr shm3=(lds_cptr)shm; const lds_cptr kp0=shm3+LDS_K+hi*1024+r32*16; const lds_cptr vp0=shm3+LDS_V+((lane>>4)&1)*32+(lane&3)*8+(4*hi+((lane&15)>>2))*64;
  DMA_K(0,0);DMA_V(0,0);DMA_K(1,SLOTB);
  bf16x8 qr[4];
  #pragma unroll
  for(int d0=0;d0<4;++d0)qr[d0]=*reinterpret_cast<const bf16x8*>(&Qw[(long)r32*QP+d0*16+hi*8]);
  float mhat=0.f,l_reg=0.f;f32x16 o[2];o[0]=f32x16{};o[1]=f32x16{};f32x16 negm=f32x16{};asm volatile("":"+v"(negm));
  #define CMASK(P0,P1,t) do{}while(0)
  bool resc=false;
  #define START(P0,P1) do{ const float rm=rowmax(P0,P1); resc=false; \
    { const float dl=rm; mhat=fadd_s(mhat,dl); \
      _Pragma("unroll") for(int r=0;r<16;++r){P0[r]=fsub_s(P0[r],dl);P1[r]=fsub_s(P1[r],dl);} \
      _Pragma("unroll") for(int r=0;r<16;++r)negm[r]=-mhat; asm volatile("":"+v"(negm)); } \
    _Pragma("unroll") for(int r=0;r<16;++r)P0[r]=__builtin_amdgcn_exp2f(P0[r]); }while(0)
  #define RESC() do{ if(resc){ asm volatile("s_waitcnt lgkmcnt(0)":::"memory"); \
      _Pragma("unroll") for(int d_=0;d_<2;++d_) _Pragma("unroll") for(int r=0;r<16;++r)o[d_][r]*=wsf[crow(r,hi)]; } }while(0)
  f32x16 pA0,pA1,pB0,pB1;
  int sl_prev=0,sl_cur=0,sl_next=SLOTB;
  #define ROT() do{sl_prev=sl_cur;sl_cur=sl_next;sl_next=(sl_next==(NSLOT-1)*SLOTB)?0:sl_next+SLOTB;}while(0)
  DMA_K(2,2*SLOTB);
  WAIT_BAR(3);
  qkt(pA0,pA1,Kbase,qr,negm,r32,hi);asm volatile("s_nop 15\n\ts_nop 7":"+v"(pA0),"+v"(pA1));CMASK(pA0,pA1,0);
  START(pA0,pA1);
  _Pragma("unroll") for(int r=0;r<16;++r)pA1[r]=__builtin_amdgcn_exp2f(pA1[r]);
  WAIT_BAR(0);
  DMA_K(3,0);DMA_V(1,SLOTB);
  ROT();
  kload8(kf,kp0+sl_cur);
  WAIT_BAR(2);
  s16x4 vlo[8],vhi[8]; u32x4 pw0,pw1,pw2,pw3;
  #define PKW(P,B) cvtpk_s(P[B],P[B+1])
  #define PAF(k) __builtin_bit_cast(bf16x8,pw##k)
  #define VFR(i) (bf16x8){vlo[i][0],vlo[i][1],vlo[i][2],vlo[i][3],vhi[i][0],vhi[i][1],vhi[i][2],vhi[i][3]}
  #define PIN(x) asm volatile("":"+v"(x))
  #define MX3(a,b,c) __builtin_fmaxf(__builtin_fmaxf((a),(b)),(c))
  #define GAPA(MF,A0,A1,A2,A3,W0,W1,PW) do{ MF; sacc+=A0; sacc+=A1; sacc+=A2; sacc+=A3; PIN(sacc); W0; W1; PIN(PW); SBAR(); }while(0)
  #define EX(v) __builtin_amdgcn_exp2f(v)
  #define GAPB(MF,X,B) do{ MF; X[B]=EX(X[B]); X[B+1]=EX(X[B+1]); X[B+2]=EX(X[B+2]); X[B+3]=EX(X[B+3]); PIN(X); SBAR(); }while(0)
  #define VRD(i) do{ vlo[i]=vtr(vp_+(((i)>>2)*4096+((i)&3)*1024)); vhi[i]=vtr(vp_+(((i)>>2)*4096+((i)&3)*1024+512)); }while(0)
  #define KRD(G,j) do{ if(G){ kload2(kf,kp0+sl_next,j); SBAR(); } }while(0)
  #define STEP(C0,C1,P0,P1,t,GK,GV,GL) do{ SBAR(); \
    const lds_cptr vp_=vp0+sl_prev; \
    VRD(0); SBAR(); float sacc=(P0[0]+P0[1]); \
    GAPA(C0=__builtin_amdgcn_mfma_f32_32x32x16_bf16(kf[0],qr[0],negm,0,0,0), P0[2],P0[3],P0[4],P0[5],     pw0[0]=PKW(P0,0), pw0[1]=PKW(P0,2), pw0); \
    VRD(4); SBAR(); GAPA(C1=__builtin_amdgcn_mfma_f32_32x32x16_bf16(kf[1],qr[0],negm,0,0,0), P0[6],P0[7],P0[8],P0[9],     pw0[2]=PKW(P0,4), pw0[3]=PKW(P0,6), pw0); \
    VRD(1); SBAR(); GAPA(C0=__builtin_amdgcn_mfma_f32_32x32x16_bf16(kf[2],qr[1],C0,0,0,0),   P0[10],P0[11],P0[12],P0[13], pw1[0]=PKW(P0,8), pw1[1]=PKW(P0,10), pw1); \
    VRD(5); SBAR(); GAPA(C1=__builtin_amdgcn_mfma_f32_32x32x16_bf16(kf[3],qr[1],C1,0,0,0),   P0[14],P0[15],P1[0],P1[1],   pw1[2]=PKW(P0,12),pw1[3]=PKW(P0,14), pw1); \
    VRD(2); SBAR(); GAPA(C0=__builtin_amdgcn_mfma_f32_32x32x16_bf16(kf[4],qr[2],C0,0,0,0),   P1[2],P1[3],P1[4],P1[5],     pw2[0]=PKW(P1,0), pw2[1]=PKW(P1,2), pw2); \
    VRD(6); SBAR(); GAPA(C1=__builtin_amdgcn_mfma_f32_32x32x16_bf16(kf[5],qr[2],C1,0,0,0),   P1[6],P1[7],P1[8],P1[9],     pw2[2]=PKW(P1,4), pw2[3]=PKW(P1,6), pw2); \
    VRD(3); SBAR(); GAPA(C0=__builtin_amdgcn_mfma_f32_32x32x16_bf16(kf[6],qr[3],C0,0,0,0),   P1[10],P1[11],P1[12],P1[13], pw3[0]=PKW(P1,8), pw3[1]=PKW(P1,10), pw3); \
    VRD(7); SBAR(); GAPA(C1=__builtin_amdgcn_mfma_f32_32x32x16_bf16(kf[7],qr[3],C1,0,0,0),   P1[14],P1[15],0.f,0.f,       pw3[2]=PKW(P1,12),pw3[3]=PKW(P1,14), pw3); \
    l_reg+=sacc; \
    if(GK){DMA_K((t)+3,sl_cur);} if(GV){DMA_V((t)+1,sl_next);} \
    CMASK(C0,C1,t); \
    { float a=MX3(C0[0],C0[1],C1[0]),b=MX3(C0[2],C0[3],C1[1]); a=MX3(a,C1[2],C1[3]); \
      _Pragma("unroll") for(int r=4;r<16;r+=4){a=MX3(a,C0[r],C0[r+1]);b=MX3(b,C0[r+2],C0[r+3]);a=MX3(a,C1[r],C1[r+1]);b=MX3(b,C1[r+2],C1[r+3]);} \
      float rm=__builtin_fmaxf(a,b); { auto rr=__builtin_amdgcn_permlane32_swap(__float_as_uint(rm),__float_as_uint(rm),false,false); rm=__builtin_fmaxf(__uint_as_float(rr[0]),__uint_as_float(rr[1])); } \
      resc=false; \
      if(__builtin_expect(__any(rm>(float)THRL),0)){ const float dl=__builtin_fmaxf(rm,0.f); mhat+=dl; \
        _Pragma("unroll") for(int r=0;r<16;++r){C0[r]-=dl;C1[r]-=dl;} \
        _Pragma("unroll") for(int r=0;r<16;++r)negm[r]=-mhat; asm volatile("":"+v"(negm)); \
        const float f=__builtin_amdgcn_exp2f(-dl); l_reg*=f; if(hi==0)wsf[r32]=f; resc=true; } } \
    SBAR(); \
    GAPB(o[0]=__builtin_amdgcn_mfma_f32_32x32x16_bf16(PAF(0),VFR(0),o[0],0,0,0), C0,0); \
    GAPB(o[1]=__builtin_amdgcn_mfma_f32_32x32x16_bf16(PAF(0),VFR(4),o[1],0,0,0), C0,4); \
    KRD(GL,0); GAPB(o[0]=__builtin_amdgcn_mfma_f32_32x32x16_bf16(PAF(1),VFR(1),o[0],0,0,0), C0,8); \
    KRD(GL,1); GAPB(o[1]=__builtin_amdgcn_mfma_f32_32x32x16_bf16(PAF(1),VFR(5),o[1],0,0,0), C0,12); \
    KRD(GL,2); GAPB(o[0]=__builtin_amdgcn_mfma_f32_32x32x16_bf16(PAF(2),VFR(2),o[0],0,0,0), C1,0); \
    KRD(GL,3); GAPB(o[1]=__builtin_amdgcn_mfma_f32_32x32x16_bf16(PAF(2),VFR(6),o[1],0,0,0), C1,4); \
    GAPB(o[0]=__builtin_amdgcn_mfma_f32_32x32x16_bf16(PAF(3),VFR(3),o[0],0,0,0), C1,8); \
    GAPB(o[1]=__builtin_amdgcn_mfma_f32_32x32x16_bf16(PAF(3),VFR(7),o[1],0,0,0), C1,12); \
    }while(0)
  int t=1;
  for(;t+5<NT;t+=2){
    STEP(pB0,pB1,pA0,pA1,t,true,true,true);     WAIT_BAR(2); RESC(); ROT();
    STEP(pA0,pA1,pB0,pB1,t+1,true,true,true);   WAIT_BAR(2); RESC(); ROT();
  }
  #define ENDW(tt) do{ if((tt)+3<NT){WAIT_BAR(2);} else if((tt)+2<NT){WAIT_BAR(1);} else {WAIT_BAR(0);} }while(0)
  for(;t+1<NT;t+=2){
    STEP(pB0,pB1,pA0,pA1,t,(t+3<NT),(t+1<NT),(t+1<NT));       ENDW(t);   RESC(); ROT();
    STEP(pA0,pA1,pB0,pB1,t+1,(t+4<NT),(t+2<NT),(t+2<NT));     ENDW(t+1); RESC(); ROT();
  }
  STEP(pB0,pB1,pA0,pA1,NT-1,false,false,false); RESC();
  { float sacc=pB0[0]+pB0[1]; _Pragma("unroll") for(int r=2;r<16;++r)sacc+=pB0[r]; _Pragma("unroll") for(int r=0;r<16;++r)sacc+=pB1[r]; l_reg+=sacc;
    pw0=(u32x4){PKW(pB0,0),PKW(pB0,2),PKW(pB0,4),PKW(pB0,6)};pw1=(u32x4){PKW(pB0,8),PKW(pB0,10),PKW(pB0,12),PKW(pB0,14)};pw2=(u32x4){PKW(pB1,0),PKW(pB1,2),PKW(pB1,4),PKW(pB1,6)};pw3=(u32x4){PKW(pB1,8),PKW(pB1,10),PKW(pB1,12),PKW(pB1,14)};
    SBAR(); pv(o,vb0+sl_cur,PAF(0),PAF(1),PAF(2),PAF(3)); }
  #undef PKW
  #undef PAF
  #undef VFR
  #undef PIN
  #undef MX3
  #undef GAPA
  #undef GAPB
  #undef EX
  #undef VRD
  #undef KRD
  #undef STEP
  #undef ENDW
  {auto rr=__builtin_amdgcn_permlane32_swap(__float_as_uint(l_reg),__float_as_uint(l_reg),false,false);l_reg=__uint_as_float(rr[0])+__uint_as_float(rr[1]);}
  if(hi==0)wsf[32+r32]=l_reg;asm volatile("s_waitcnt lgkmcnt(0)":::"memory");
  float rli[16];
  #pragma unroll
  for(int r=0;r<16;++r)rli[r]=__builtin_amdgcn_rcpf(wsf[32+crow(r,hi)]);
  bf16*Ow=Ou+(long)(wid*QBLK)*OP;
  { bf16*stg=(bf16*)(shm+LDS_OST)+wid*2048;
    #pragma unroll
    for(int r=0;r<16;++r){const int orow=crow(r,hi);
      #pragma unroll
      for(int d0=0;d0<2;++d0)stg[orow*64+d0*32+r32]=__float2bfloat16(o[d0][r]*rli[r]);}
    asm volatile("s_waitcnt lgkmcnt(0)":::"memory");
    #pragma unroll
    for(int i=0;i<4;++i){const int row=i*8+(lane>>3),ch=lane&7; const u32x4 v=*(const u32x4*)(stg+row*64+ch*8); ATTN_STORE16(Ow+(long)row*OP+ch*8,v);} }
  asm volatile("s_waitcnt lgkmcnt(0)\n\ts_barrier":::"memory");
  #undef DMA_K
  #undef DMA_V
  #undef CMASK
  #undef START
  #undef RESC
  #undef ROT
}
constexpr int ATTN_LDS_BYTES=LDS_BYTES;
#undef SBAR
#undef WAIT_BAR
}

__device__ __forceinline__ void attn_phase(const Frame& F, int l) {
    typedef attn_body::bf16 abf;
    const abf* U = (const abf*)(F.ws + WS_AR + AR_QKV); abf* MIX = (abf*)(F.ws + WS_AR + AR_MIX);
    char* shm = (char*)F.lds;
    for (int u = F.bid; u < 512; u += F.G) {
        const int pair = u & 7, j = u >> 3, b = pair >> 1, kvh = pair & 1, h = kvh * 4 + (j >> 4), qb = j & 15;
        const size_t r0 = (size_t)b * SB, q0 = r0 + CT + (size_t)qb * 256;
        attn_body::attn_unit<8>(U + q0 * QKVP + h * 64, U + r0 * QKVP + K_OFF + kvh * 64, U + r0 * QKVP + V_OFF + kvh * 64, MIX + q0 * D + h * 64, SB / 64, shm);
    }
    if (l + 1 < NL) {
        for (int u = F.bid; u < 32; u += F.G) {
            const int pair = u & 7, b = pair >> 1, kvh = pair & 1, h = kvh * 4 + (u >> 3);
            const size_t r0 = (size_t)b * SB;
            attn_body::attn_unit<8>(U + r0 * QKVP + h * 64, U + r0 * QKVP + K_OFF + kvh * 64, U + r0 * QKVP + V_OFF + kvh * 64, MIX + r0 * D + h * 64, CT / 64, shm);
        }
    }
}

constexpr int SC_STEP_F = 352, SC_CH = 32, SC_BUF_F = SC_CH * SC_STEP_F  , SC_OUT_OFF = 2 * SC_BUF_F * 4  ;
__device__ __forceinline__ int scan_row(int s, int dir) { return s < CT ? (dir ? CT - 1 - s : s) : (dir ? CT + (TL - 1 - (s - CT)) : s); }
__device__ __forceinline__ void scan_task(const Frame& F, int task) {
    const int x = task & 7, t = task >> 3, bh = 2 * x + (t >> 2), b = bh >> 2, h = bh & 3, dir = (t >> 1) & 1, half = t & 1;
    const size_t rb = (size_t)b * SB, dofs = (size_t)dir * M * 256;
    const int col0 = h * 64;
    const float* Wg = (const float*)(F.ws + WS_AR + AR_W) + dofs;
    const bf16* KKg = (const bf16*)(F.ws + WS_AR + AR_KK); const bf16* KKAg = (const bf16*)(F.ws + WS_AR + AR_KKA) + dofs; const bf16* KEg = (const bf16*)(F.ws + WS_AR + AR_KE) + dofs;
    const bf16* Rg = (const bf16*)(F.ws + WS_AR + AR_R); const bf16* Vg = (const bf16*)(F.ws + WS_AR + AR_V);
    float* Yg = (float*)(F.ws + WS_AR + AR_Y) + dofs;
    LAS float* ring = (LAS float*)F.lds; LAS float* outb = (LAS float*)(F.lds + SC_OUT_OFF);
    constexpr int NCH = SB / SC_CH;
    const int tid = F.tid;
    const int lst = tid >> 4, lk4 = (tid & 15) * 4;
    const int vst = (tid & 255) >> 3, vr4 = (tid & 7) * 4;
    f32x4 lw; v2u l1, l2, l3, l4, lv;
#define SC_ISSUE(c) do { const size_t g_ = (rb + scan_row((c) * SC_CH + lst, dir)) * 256 + col0 + lk4; \
        lw = *(const f32x4*)(Wg + g_); l1 = *(const v2u*)(KKg + g_); l2 = *(const v2u*)(KKAg + g_); l3 = *(const v2u*)(KEg + g_); l4 = *(const v2u*)(Rg + g_); \
        if (tid < 256) lv = *(const v2u*)(Vg + (rb + scan_row((c) * SC_CH + vst, dir)) * 256 + col0 + half * 32 + vr4); } while (0)
#define SC_COMMIT(c) do { LAS float* d_ = ring + ((c) & 1) * SC_BUF_F + lst * SC_STEP_F + lk4; \
        *(LAS f32x4*)(d_) = (f32x4){__expf(lw[0]), __expf(lw[1]), __expf(lw[2]), __expf(lw[3])}; \
        *(LAS f32x4*)(d_ + 64) = (f32x4){bflo(l1.x), bfhi(l1.x), bflo(l1.y), bfhi(l1.y)}; \
        *(LAS f32x4*)(d_ + 128) = (f32x4){bflo(l2.x), bfhi(l2.x), bflo(l2.y), bfhi(l2.y)}; \
        *(LAS f32x4*)(d_ + 192) = (f32x4){bflo(l3.x), bfhi(l3.x), bflo(l3.y), bfhi(l3.y)}; \
        *(LAS f32x4*)(d_ + 256) = (f32x4){bflo(l4.x), bfhi(l4.x), bflo(l4.y), bfhi(l4.y)}; \
        if (tid < 256) *(LAS f32x4*)(ring + ((c) & 1) * SC_BUF_F + vst * SC_STEP_F + 320 + vr4) = (f32x4){bflo(lv.x), bfhi(lv.x), bflo(lv.y), bfhi(lv.y)}; } while (0)
#define SC_FLUSH(c) do { if (tid < 256) { const f32x4 v_ = *(const LAS f32x4*)(outb + ((c) & 1) * (SC_CH * 32) + vst * 32 + vr4); \
        *(f32x4*)(Yg + (rb + scan_row((c) * SC_CH + vst, dir)) * 256 + col0 + half * 32 + vr4) = v_; } } while (0)
    SC_ISSUE(0); SC_COMMIT(0);
    __syncthreads();
    const int i = (F.lane >> 4), j = F.lane & 15, wv = F.wave;
    float S0[4] = {0.f, 0.f, 0.f, 0.f};
    for (int c = 0; c < NCH; ++c) {
        if (c + 1 < NCH) SC_ISSUE(c + 1);
        if (c >= 1) SC_FLUSH(c - 1);
        {
            const LAS float* base = ring + (c & 1) * SC_BUF_F + 4 * j;
            const LAS float* vb = ring + (c & 1) * SC_BUF_F + 320 + wv * 4 + i;
            LAS float* ob = outb + (c & 1) * (SC_CH * 32) + wv * 4 + i;
#pragma unroll 8
            for (int s = 0; s < SC_CH; ++s) {
                const LAS float* p = base + s * SC_STEP_F;
                const f32x4 w4 = *(const LAS f32x4*)(p), kk4 = *(const LAS f32x4*)(p + 64), ka4 = *(const LAS f32x4*)(p + 128), ke4 = *(const LAS f32x4*)(p + 192), r4 = *(const LAS f32x4*)(p + 256);
                const float v0 = vb[s * SC_STEP_F];
                float sa0 = S0[0] * kk4[0];
#pragma unroll
                for (int e = 1; e < 4; ++e) sa0 += S0[e] * kk4[e];
                sa0 = red16(sa0);
                float y0 = 0.f;
#pragma unroll
                for (int e = 0; e < 4; ++e) { S0[e] = S0[e] * w4[e] + (v0 * ke4[e] - sa0 * ka4[e]); y0 += S0[e] * r4[e]; }
                y0 = red16(y0);
                if (j == 0) ob[s * 32] = y0;
            }
        }
        if (c + 1 < NCH) SC_COMMIT(c + 1);
        __syncthreads();
    }
    SC_FLUSH(NCH - 1);
    __syncthreads();
#undef SC_ISSUE
#undef SC_COMMIT
#undef SC_FLUSH
}

typedef short sbf8 __attribute__((ext_vector_type(8)));
constexpr int CH_LD = 72;
constexpr int CA_LL = 0, CA_GT = 16384, CA_GC = 129536, CA_MA = 18944, CA_NKV = CA_MA + 18432, CA_MT = 55808, CA_MN = 83456, CA_MW = 111104;
constexpr int NA_LD = 68, TB_LD = 17;
constexpr int NCHUNK = SB / 64;
constexpr size_t SCA_PT = 0, SCA_RY = (size_t)32 * NCHUNK * 4096 * 2, SCA_Q = 2 * SCA_RY, SCA_END = SCA_Q + (size_t)32 * NCHUNK * 4096 * 4;
static_assert(SCA_END <= (size_t)M * NINP * 2, "stage-A outputs fit the U region");
__device__ __forceinline__ f32x4 mma_nt64(const LAS bf16* A, const LAS bf16* B, int ti, int tj, int fr, int fq, f32x4 acc) {
#pragma unroll
    for (int kb = 0; kb < 2; ++kb) {
        const sbf8 a = *(const LAS sbf8*)(A + (16 * ti + fr) * CH_LD + kb * 32 + 8 * fq);
        const sbf8 b = *(const LAS sbf8*)(B + (16 * tj + fr) * CH_LD + kb * 32 + 8 * fq);
        acc = __builtin_amdgcn_mfma_f32_16x16x32_bf16(a, b, acc, 0, 0, 0);
    }
    return acc;
}
__device__ __forceinline__ float quad_sum(float x) {
    float r;
    asm("s_nop 1\n\tv_add_f32_dpp %0, %1, %1 quad_perm:[1,0,3,2] row_mask:0xf bank_mask:0xf\n\ts_nop 1\n\t"
        "v_add_f32_dpp %0, %0, %0 quad_perm:[2,3,0,1] row_mask:0xf bank_mask:0xf\n\ts_nop 0" : "=&v"(r) : "v"(x));
    return r;
}
struct AIn { f32x4 lw0, lw1; v4u kk, ka, ke, rr; };
__device__ __forceinline__ void scanA_issue(const Frame& F, int ch, int c, AIn& in) {
    const int dir = ch >> 4, b = (ch >> 2) & 3, h = ch & 3;
    const size_t rb = (size_t)b * SB, dofs = (size_t)dir * M * 256; const int col0 = h * 64, s_base = c * 64, tid = F.tid;
    size_t z_ = 0; asm volatile("" : "+s"(z_));
    unsigned char* wsb = F.ws + z_;
    const float* LWg = (const float*)(wsb + WS_AR + AR_W) + dofs;
    const bf16* KKg = (const bf16*)(wsb + WS_AR + AR_KK); const bf16* KAg = (const bf16*)(wsb + WS_AR + AR_KKA) + dofs; const bf16* KEg = (const bf16*)(wsb + WS_AR + AR_KE) + dofs;
    const bf16* Rg = (const bf16*)(wsb + WS_AR + AR_R); const bf16* Vg = (const bf16*)(wsb + WS_AR + AR_V);
    { const int t = tid >> 3, k0 = (tid & 7) * 8; const size_t g = (rb + scan_row(s_base + t, dir)) * 256 + col0 + k0;
      in.lw0 = *(const f32x4*)(LWg + g); in.lw1 = *(const f32x4*)(LWg + g + 4);
      in.kk = *(const v4u*)(KKg + g); in.ka = *(const v4u*)(KAg + g); in.ke = *(const v4u*)(KEg + g); in.rr = *(const v4u*)(Rg + g); }
}
__device__ __forceinline__ void scanA_task(const Frame& F, int ch, int c, float* Y0dst, size_t y0_row_stride_sel  , AIn& in, bool has_next, int nch, int nc) {
    const int dir = ch >> 4, b = (ch >> 2) & 3, h = ch & 3;
    const size_t rb = (size_t)b * SB, dofs = (size_t)dir * M * 256; const int col0 = h * 64;
    const float* LWg = (const float*)(F.ws + WS_AR + AR_W) + dofs;
    const bf16* KKg = (const bf16*)(F.ws + WS_AR + AR_KK); const bf16* KAg = (const bf16*)(F.ws + WS_AR + AR_KKA) + dofs; const bf16* KEg = (const bf16*)(F.ws + WS_AR + AR_KE) + dofs;
    const bf16* Rg = (const bf16*)(F.ws + WS_AR + AR_R); const bf16* Vg = (const bf16*)(F.ws + WS_AR + AR_V);
    unsigned char* ob = F.ws + WS_AR + AR_U; const size_t tsk = (size_t)ch * NCHUNK + c;
    bf16* PTg = (bf16*)(ob + SCA_PT) + tsk * 4096; bf16* RYg = (bf16*)(ob + SCA_RY) + tsk * 4096; float* Qg = (float*)(ob + SCA_Q) + tsk * 4096;
    LAS float* LL = (LAS float*)(F.lds + CA_LL); LAS float* GT = (LAS float*)(F.lds + CA_GT); LAS float* GC = (LAS float*)(F.lds + CA_GC);
    LAS bf16* KKG = (LAS bf16*)(F.lds + CA_MA); LAS bf16* RG = KKG + 64 * CH_LD; LAS bf16* AG = RG + 64 * CH_LD; LAS bf16* KG = AG + 64 * CH_LD;
    LAS float* NKV = (LAS float*)(F.lds + CA_NKV);
    LAS bf16* AHT = (LAS bf16*)(F.lds + CA_MT); LAS bf16* KHT = AHT + 64 * CH_LD; LAS bf16* VT = KHT + 64 * CH_LD;
    LAS bf16* NK = (LAS bf16*)(F.lds + CA_MN); LAS bf16* MA = NK + 64 * CH_LD; LAS bf16* MK = MA + 64 * CH_LD;
    LAS bf16* W1T = (LAS bf16*)(F.lds + CA_MW); LAS bf16* W2T = W1T + 64 * CH_LD;
    const int tid = F.tid, lane = F.lane, wv = F.wave, fr = lane & 15, fq = lane >> 4;
    const int s_base = c * 64;
    for (int rep1 = 0; rep1 < (SCANA_REP == 1 ? 2 : 1); ++rep1) {
    { const int t = tid >> 3, k0 = (tid & 7) * 8;
      *(LAS f32x4*)(LL + t * 64 + k0) = in.lw0; *(LAS f32x4*)(LL + t * 64 + k0 + 4) = in.lw1; }
    LDS_BARRIER();
    { const int k = tid & 63, g = tid >> 6; float v[8];
#pragma unroll
      for (int j = 0; j < 8; ++j) v[j] = LL[(8 * g + j) * 64 + k];
#pragma unroll
      for (int j = 1; j < 8; ++j) v[j] += v[j - 1];
      GT[g * 64 + k] = v[7];
      LDS_BARRIER();
      float off = 0.f;
#pragma unroll
      for (int g2 = 0; g2 < 7; ++g2) off += (g2 < g) ? GT[g2 * 64 + k] : 0.f;
#pragma unroll
      for (int j = 0; j < 8; ++j) LL[(8 * g + j) * 64 + k] = v[j] + off; }
    LDS_BARRIER();
    }
    for (int rep2 = 0; rep2 < (SCANA_REP == 2 ? 2 : 1); ++rep2) {
    { const int t = tid >> 3, k0 = (tid & 7) * 8;
      float kk[8], ka[8], ke[8], rr[8], o1[8], o2[8], o3[8], o4[8];
      unpack8(in.kk, kk); unpack8(in.ka, ka); unpack8(in.ke, ke); unpack8(in.rr, rr);
#pragma unroll
      for (int e = 0; e < 8; ++e) { const float Lt = LL[t * 64 + k0 + e], Lp = t > 0 ? LL[(t - 1) * 64 + k0 + e] : 0.f;
          const float e3 = __expf(-Lt);
          o1[e] = kk[e] * __expf(Lp); o2[e] = rr[e] * __expf(Lt); o3[e] = ka[e] * e3; o4[e] = ke[e] * e3; }
      *(LAS v4u*)(KKG + t * CH_LD + k0) = pack8(o1); *(LAS v4u*)(RG + t * CH_LD + k0) = pack8(o2); *(LAS v4u*)(AG + t * CH_LD + k0) = pack8(o3); *(LAS v4u*)(KG + t * CH_LD + k0) = pack8(o4); }
    { const int k = tid & 63, t0 = (tid >> 6) * 8; const float LC = LL[63 * 64 + k];
      float o1[8], o2[8], o3[8];
#pragma unroll
      for (int j = 0; j < 8; ++j) { const size_t g = (rb + scan_row(s_base + t0 + j, dir)) * 256 + col0 + k;
          const float e4 = __expf(LC - LL[(t0 + j) * 64 + k]);
          o1[j] = bf2f(KAg[g]) * e4; o2[j] = bf2f(KEg[g]) * e4; o3[j] = bf2f(Vg[g]); }
      *(LAS v4u*)(AHT + k * CH_LD + t0) = pack8(o1); *(LAS v4u*)(KHT + k * CH_LD + t0) = pack8(o2); *(LAS v4u*)(VT + k * CH_LD + t0) = pack8(o3);
      if (t0 == 0) GC[k] = __expf(LC); }
    }
    LDS_BARRIER();
    if (has_next) scanA_issue(F, nch, nc, in);
    const int ti = wv & 3;
    for (int rep3 = 0; rep3 < (SCANA_REP == 3 ? 2 : 1); ++rep3)
#pragma unroll
    for (int jj = 0; jj < 2; ++jj) {
        const int tj = 2 * (wv >> 2) + jj;
        const f32x4 z4 = {0.f, 0.f, 0.f, 0.f};
        f32x4 na = z4, nk = z4, ma = z4, mk = z4;
        if (tj <= ti) { na = mma_nt64(KKG, AG, ti, tj, fr, fq, z4); nk = mma_nt64(KKG, KG, ti, tj, fr, fq, z4); ma = mma_nt64(RG, AG, ti, tj, fr, fq, z4); mk = mma_nt64(RG, KG, ti, tj, fr, fq, z4); }
        const int i = 16 * tj + fr;
#pragma unroll
        for (int rg = 0; rg < 4; ++rg) { const int t = 16 * ti + 4 * fq + rg;
            const bool lo = i < t, le = i <= t;
            LL[t * NA_LD + i] = lo ? na[rg] : 0.f;
            NK[t * CH_LD + i] = (bf16)f2bf(lo ? nk[rg] : 0.f); MA[t * CH_LD + i] = (bf16)f2bf(le ? ma[rg] : 0.f); MK[t * CH_LD + i] = (bf16)f2bf(le ? mk[rg] : 0.f); }
    }
    LDS_BARRIER();
    f32x4 mkv[2];
#pragma unroll
    for (int jj = 0; jj < 2; ++jj) {
        const int tj = 2 * (wv >> 2) + jj; const f32x4 z4 = {0.f, 0.f, 0.f, 0.f};
        const f32x4 nkv = mma_nt64(NK, VT, ti, tj, fr, fq, z4); mkv[jj] = mma_nt64(MK, VT, ti, tj, fr, fq, z4);
#pragma unroll
        for (int rg = 0; rg < 4; ++rg) NKV[(16 * ti + 4 * fq + rg) * 64 + 16 * tj + fr] = nkv[rg];
    }
    LDS_BARRIER();
    { LAS float* NaR = LL;
      LAS float* TB = (LAS float*)(F.lds + CA_MN + 18432);
      LAS float* XW = wv < 5 ? (LAS float*)(F.lds + CA_NKV) + wv * 768 : (LAS float*)(F.lds + CA_MN) + (wv - 5) * 768;
      const int col = 16 * wv + fr;
      float Rr[4][4];
#pragma unroll
      for (int bb = 0; bb < 4; ++bb)
#pragma unroll
          for (int rg = 0; rg < 4; ++rg) { const int t = 16 * bb + 4 * fq + rg; Rr[bb][rg] = wv < 4 ? bf2f(KKG[t * CH_LD + col]) : NKV[t * 64 + (col - 64)]; }
      if (wv < 4 && lane < 16) {
          const int bb = wv, c = lane; float Tc[16];
#pragma unroll
          for (int r = 0; r < 16; ++r) {
              float acc = (r == c) ? 1.f : 0.f;
#pragma unroll
              for (int i4 = 0; i4 < r; i4 += 4) { const f32x4 dv = *(const LAS f32x4*)(NaR + (16 * bb + r) * NA_LD + 16 * bb + i4);
#pragma unroll
                  for (int e = 0; e < 4; ++e) if (i4 + e < r) acc -= dv[e] * Tc[i4 + e]; }
              Tc[r] = acc; TB[(bb * 16 + r) * TB_LD + c] = acc;
          }
      }
      LDS_BARRIER();
      LAS bf16* WT = wv < 4 ? (W1T + col * CH_LD) : (W2T + (col - 64) * CH_LD);
#pragma unroll
      for (int bb = 0; bb < 4; ++bb) {
          f32x4 z = {0.f, 0.f, 0.f, 0.f};
#pragma unroll
          for (int st = 0; st < 4 * bb; ++st) z = __builtin_amdgcn_mfma_f32_16x16x4f32(NaR[(16 * bb + fr) * NA_LD + 4 * st + fq], XW[(4 * st + fq) * 16 + fr], z, 0, 0, 0);
          LAS float* RW = XW + (bb < 3 ? 16 * bb : 0) * 16;
#pragma unroll
          for (int rg = 0; rg < 4; ++rg) RW[(4 * fq + rg) * 16 + fr] = Rr[bb][rg] - z[rg];
          asm volatile("s_waitcnt lgkmcnt(0)" ::: "memory");
          f32x4 xb = {0.f, 0.f, 0.f, 0.f};
#pragma unroll
          for (int st = 0; st < 4; ++st) xb = __builtin_amdgcn_mfma_f32_16x16x4f32(TB[(bb * 16 + fr) * TB_LD + 4 * st + fq], RW[(4 * st + fq) * 16 + fr], xb, 0, 0, 0);
          asm volatile("s_waitcnt lgkmcnt(0)" ::: "memory");
          if (bb < 3) {
#pragma unroll
              for (int rg = 0; rg < 4; ++rg) XW[(16 * bb + 4 * fq + rg) * 16 + fr] = xb[rg];
          }
          v2u w_; w_.x = pk2(xb[0], xb[1]); w_.y = pk2(xb[2], xb[3]);
          *(LAS v2u*)(WT + 16 * bb + 4 * fq) = w_;
          asm volatile("s_waitcnt lgkmcnt(0)" ::: "memory");
      } }
    LDS_BARRIER();
#pragma unroll
    for (int jj = 0; jj < 2; ++jj) {
        const int tj = 2 * (wv >> 2) + jj; const f32x4 z4 = {0.f, 0.f, 0.f, 0.f};
        const f32x4 a1 = mma_nt64(MA, W1T, ti, tj, fr, fq, z4), a2 = mma_nt64(MA, W2T, ti, tj, fr, fq, z4);
        const f32x4 a3 = mma_nt64(AHT, W1T, ti, tj, fr, fq, z4);
        const f32x4 a4 = mma_nt64(VT, KHT, ti, tj, fr, fq, z4), a5 = mma_nt64(W2T, AHT, ti, tj, fr, fq, z4);
        const int cc = 16 * tj + fr;
#pragma unroll
        for (int rg = 0; rg < 4; ++rg) { const int r_ = 16 * ti + 4 * fq + rg;
            RYg[r_ * 64 + cc] = (bf16)f2bf(bf2f(RG[r_ * CH_LD + cc]) - a1[rg]);
            const size_t yrow = y0_row_stride_sel ? (size_t)(s_base + r_) : (rb + scan_row(s_base + r_, dir));
            Y0dst[((size_t)dir * (y0_row_stride_sel ? (size_t)SB : (size_t)M) + yrow) * 256 + col0 + cc] = mkv[jj][rg] - a2[rg];
            PTg[r_ * 64 + cc] = (bf16)f2bf((r_ == cc ? GC[cc] : 0.f) - a3[rg]);
            Qg[r_ * 64 + cc] = a4[rg] - a5[rg]; }
    }
    LDS_BARRIER();
}

__device__ __forceinline__ void scanA_run(const Frame& F, int ch, int c, float* Y0dst, size_t sel) { AIn in; scanA_issue(F, ch, c, in); scanA_task(F, ch, c, Y0dst, sel, in, false, 0, 0); }
constexpr int BC_RY = 0, BC_PT = 9216, BC_Q = 18432, BC_QLD = 68, BC_Y = BC_Q + 32 * BC_QLD * 4, BC_BUF = BC_Y + 64 * 32 * 4  , BC_S = 2 * BC_BUF;
__device__ __forceinline__ void scanBC_task(const Frame& F, int ch, int half, float* Ybuf, int ydebug, const float* cmp, unsigned* dmax) {
    const int dir = ch >> 4, b = (ch >> 2) & 3, h = ch & 3;
    const size_t rb = (size_t)b * SB; const int col0 = h * 64;
    unsigned char* ob = F.ws + WS_AR + AR_U;
    const bf16* PTg = (const bf16*)(ob + SCA_PT) + (size_t)ch * NCHUNK * 4096; const bf16* RYg = (const bf16*)(ob + SCA_RY) + (size_t)ch * NCHUNK * 4096;
    const float* Qg = (const float*)(ob + SCA_Q) + (size_t)ch * NCHUNK * 4096;
    LAS bf16* SB0 = (LAS bf16*)(F.lds + BC_S);
    const int tid = F.tid, lane = F.lane, wv = F.wave, fr = lane & 15, fq = lane >> 4;
    const int srb = wv & 1, scb = wv >> 1, ytb = wv & 3, yrb = wv >> 2;
    for (int i = tid; i < 2 * 32 * CH_LD / 2; i += NTHR) ((LAS unsigned*)SB0)[i] = 0u;
    float dm = 0.f;
    const int g_rp = (tid >> 3) * 64 + (tid & 7) * 8, l_rp = (tid >> 3) * CH_LD + (tid & 7) * 8;
    const int g_q = (half * 32 + (tid >> 4)) * 64 + (tid & 15) * 4, l_q = (tid >> 4) * BC_QLD + (tid & 15) * 4;
    const int y_t = tid >> 3, y_r4 = (tid & 7) * 4;
    const size_t ydir = (size_t)dir * (ydebug ? (size_t)SB : (size_t)M);
    v4u a_ry, a_pt, b_ry, b_pt; f32x4 a_q, a_y, b_q, b_y;
#define BC_LOAD(c, RYv, PTv, Qv, Yv) do { const size_t o_ = (size_t)(c) * 4096; RYv = *(const v4u*)(RYg + o_ + g_rp); PTv = *(const v4u*)(PTg + o_ + g_rp); Qv = *(const f32x4*)(Qg + o_ + g_q); \
        const int s_ = (c) * 64 + y_t; const size_t yrow_ = ydebug ? (size_t)s_ : (rb + scan_row(s_, dir)); Yv = *(const f32x4*)(Ybuf + (ydir + yrow_) * 256 + col0 + half * 32 + y_r4); } while (0)
#define BC_PARK(c, RYv, PTv, Qv, Yv) do { LAS unsigned char* d_ = F.lds + ((c) & 1) * BC_BUF; *(LAS v4u*)((LAS bf16*)(d_ + BC_RY) + l_rp) = RYv; *(LAS v4u*)((LAS bf16*)(d_ + BC_PT) + l_rp) = PTv; \
        *(LAS f32x4*)((LAS float*)(d_ + BC_Q) + l_q) = Qv; *(LAS f32x4*)((LAS float*)(d_ + BC_Y) + y_t * 32 + y_r4) = Yv; } while (0)
#define BC_STEP(c, RYv, PTv, Qv, Yv) do { \
        const LAS unsigned char* o_ = F.lds + ((c) & 1) * BC_BUF; const LAS bf16* Sc = SB0 + ((c) & 1) * 32 * CH_LD; LAS bf16* Sn = SB0 + (((c) + 1) & 1) * 32 * CH_LD; \
        const LAS bf16* RYs = (const LAS bf16*)(o_ + BC_RY); const LAS bf16* PTs = (const LAS bf16*)(o_ + BC_PT); const LAS float* Qs = (const LAS float*)(o_ + BC_Q); const LAS float* Ys = (const LAS float*)(o_ + BC_Y); \
        f32x4 yacc, sacc; \
        _Pragma("unroll") for (int rg = 0; rg < 4; ++rg) { yacc[rg] = Ys[(16 * ytb + 4 * fq + rg) * 32 + 16 * yrb + fr]; sacc[rg] = Qs[(16 * srb + 4 * fq + rg) * BC_QLD + 16 * scb + fr]; } \
        _Pragma("unroll") for (int kb = 0; kb < 2; ++kb) { \
            const sbf8 ya = *(const LAS sbf8*)(RYs + (16 * ytb + fr) * CH_LD + kb * 32 + 8 * fq), yb = *(const LAS sbf8*)(Sc + (16 * yrb + fr) * CH_LD + kb * 32 + 8 * fq); \
            const sbf8 sa = *(const LAS sbf8*)(Sc + (16 * srb + fr) * CH_LD + kb * 32 + 8 * fq), sb_ = *(const LAS sbf8*)(PTs + (16 * scb + fr) * CH_LD + kb * 32 + 8 * fq); \
            yacc = __builtin_amdgcn_mfma_f32_16x16x32_bf16(ya, yb, yacc, 0, 0, 0); sacc = __builtin_amdgcn_mfma_f32_16x16x32_bf16(sa, sb_, sacc, 0, 0, 0); } \
        _Pragma("unroll") for (int rg = 0; rg < 4; ++rg) Sn[(16 * srb + 4 * fq + rg) * CH_LD + 16 * scb + fr] = (bf16)f2bf(sacc[rg]); \
        _Pragma("unroll") for (int rg = 0; rg < 4; ++rg) { const int s_ = (c) * 64 + 16 * ytb + 4 * fq + rg; \
            if (cmp) { const float ref_ = cmp[((size_t)dir * M + rb + scan_row(s_, dir)) * 256 + col0 + half * 32 + 16 * yrb + fr]; dm = fmaxf(dm, fabsf(yacc[rg] - ref_)); } \
            else { const size_t yrow_ = ydebug ? (size_t)s_ : (rb + scan_row(s_, dir)); Ybuf[(ydir + yrow_) * 256 + col0 + half * 32 + 16 * yrb + fr] = yacc[rg]; } } \
        if ((c) + 1 < NCHUNK) BC_PARK((c) + 1, RYv, PTv, Qv, Yv); \
        if ((c) + 3 < NCHUNK) BC_LOAD((c) + 3, RYv, PTv, Qv, Yv); \
        LDS_BARRIER(); } while (0)
    BC_LOAD(0, a_ry, a_pt, a_q, a_y); BC_LOAD(1, b_ry, b_pt, b_q, b_y);
    BC_PARK(0, a_ry, a_pt, a_q, a_y);
    BC_LOAD(2, a_ry, a_pt, a_q, a_y);
    LDS_BARRIER();
    for (int c = 0; c < NCHUNK; c += 2) {
        BC_STEP(c, b_ry, b_pt, b_q, b_y);
        BC_STEP(c + 1, a_ry, a_pt, a_q, a_y);
    }
#undef BC_LOAD
#undef BC_PARK
#undef BC_STEP
    if (cmp) { dm = fmaxf(dm, __shfl_xor(dm, 1)); dm = fmaxf(dm, __shfl_xor(dm, 2)); dm = fmaxf(dm, __shfl_xor(dm, 4)); dm = fmaxf(dm, __shfl_xor(dm, 8)); dm = fmaxf(dm, __shfl_xor(dm, 16)); dm = fmaxf(dm, __shfl_xor(dm, 32));
        if (lane == 0) atomicMax(dmax, __builtin_bit_cast(unsigned, dm)); }
    __syncthreads();
}

__device__ __forceinline__ void scanA_phase(const Frame& F) {
    float* Y = (float*)(F.ws + WS_AR + AR_Y);
    if (F.G == 256) {
        const int x = F.bid & 7;
        for (int lt = F.bid >> 3; lt < 4 * NCHUNK; lt += 32) { const int cl = lt / NCHUNK, bh = 2 * x + (cl >> 1), dir = cl & 1;
            scanA_run(F, (dir * 4 + (bh >> 2)) * 4 + (bh & 3), lt % NCHUNK, Y, 0); }
        return;
    }
    for (int it = F.bid; it < 32 * NCHUNK; it += F.G) scanA_run(F, it / NCHUNK, it % NCHUNK, Y, 0);
}
__device__ __forceinline__ void mixer_phase(const Frame& F, int l) {
    typedef attn_body::bf16 abf;
    const abf* U = (const abf*)(F.ws + WS_AR + AR_QKV); abf* MIX = (abf*)(F.ws + WS_AR + AR_MIX);
    char* shm = (char*)F.lds;
    const int g = F.bid >> 3;
    const bool scan_cu = (F.G == 256) && ((g & 3) == 3);
#if SCAN_CHUNKED
    if (scan_cu) { const int sc = (g >> 2) * 8 + (F.bid & 7), x = sc & 7, t = sc >> 3, bh = 2 * x + (t >> 2);
        scanBC_task(F, (((t >> 1) & 1) * 4 + (bh >> 2)) * 4 + (bh & 3), t & 1, (float*)(F.ws + WS_AR + AR_Y), 0, nullptr, nullptr); }
    if (F.G != 256) for (int tk = F.bid; tk < 64; tk += F.G) scanBC_task(F, tk >> 1, tk & 1, (float*)(F.ws + WS_AR + AR_Y), 0, nullptr, nullptr);
    if (F.G == 256) {
        unsigned* ctr = (unsigned*)(F.ws + WS_CTL) + 9216 + l * 64 + (F.bid & 7) * 8;
        volatile LAS unsigned* qw = (volatile LAS unsigned*)(F.lds + MISC_OFF + 64);
        const int pair = F.bid & 7, b = pair >> 1, kvh = pair & 1; const size_t r0 = (size_t)b * SB;
        for (;;) {
            if (F.tid == 0) qw[0] = __hip_atomic_fetch_add(ctr, 1u, __ATOMIC_RELAXED, __HIP_MEMORY_SCOPE_AGENT);
            __syncthreads();
            const int j = (int)qw[0];
            __syncthreads();
            if (j >= 64) break;
            const int h = kvh * 4 + (j >> 4), qb = j & 15; const size_t q0 = r0 + CT + (size_t)qb * 256;
            attn_body::attn_unit<8>(U + q0 * QKVP + h * 64, U + r0 * QKVP + K_OFF + kvh * 64, U + r0 * QKVP + V_OFF + kvh * 64, MIX + q0 * D + h * 64, SB / 64, shm);
        }
    } else
    for (int u = F.bid; u < 512; u += F.G) {
        const int pair = u & 7, j = u >> 3, b = pair >> 1, kvh = pair & 1, h = kvh * 4 + (j >> 4), qb = j & 15;
        const size_t r0 = (size_t)b * SB, q0 = r0 + CT + (size_t)qb * 256;
        attn_body::attn_unit<8>(U + q0 * QKVP + h * 64, U + r0 * QKVP + K_OFF + kvh * 64, U + r0 * QKVP + V_OFF + kvh * 64, MIX + q0 * D + h * 64, SB / 64, shm);
    }
    if (l + 1 < NL && !scan_cu && (g >> 2) < 2) {
        const int hi4 = (g & 3) + 0;
        if ((g >> 2) == 0 ? true : (g & 3) == 0) {
            const int hh = (g >> 2) == 0 ? hi4 : 3;
            const int pair = F.bid & 7, b = pair >> 1, kvh = pair & 1, h = kvh * 4 + hh;
            const size_t r0 = (size_t)b * SB;
            attn_body::attn_unit<8>(U + r0 * QKVP + h * 64, U + r0 * QKVP + K_OFF + kvh * 64, U + r0 * QKVP + V_OFF + kvh * 64, MIX + r0 * D + h * 64, CT / 64, shm);
        }
    }
#else
    if (scan_cu) { scan_task(F, (g >> 2) * 8 + (F.bid & 7)); return; }
    const int pair = F.bid & 7, b = pair >> 1, kvh = pair & 1;
    const size_t r0 = (size_t)b * SB;
    const int a = g - (g >> 2);
    for (int jj = a; jj < 64; jj += 24) {
        const int h = kvh * 4 + (jj >> 4), qb = jj & 15;
        const size_t q0 = r0 + CT + (size_t)qb * 256;
        attn_body::attn_unit<8>(U + q0 * QKVP + h * 64, U + r0 * QKVP + K_OFF + kvh * 64, U + r0 * QKVP + V_OFF + kvh * 64, MIX + q0 * D + h * 64, SB / 64, shm);
    }
    if (l + 1 < NL && a >= 20) {
        const int h = kvh * 4 + (a - 20);
        attn_body::attn_unit<8>(U + r0 * QKVP + h * 64, U + r0 * QKVP + K_OFF + kvh * 64, U + r0 * QKVP + V_OFF + kvh * 64, MIX + r0 * D + h * 64, CT / 64, shm);
    }
#endif
}

__device__ __forceinline__ void scan_mixer_phase(const Frame& F, int l) {
    typedef attn_body::bf16 abf;
    const abf* U = (const abf*)(F.ws + WS_AR + AR_QKV); abf* MIX = (abf*)(F.ws + WS_AR + AR_MIX);
    char* shm = (char*)F.lds;
    float* Y = (float*)(F.ws + WS_AR + AR_Y);
    const int g = F.bid >> 3, x = F.bid & 7;
    const bool scan_cu = (g & 3) == 3;
    { int t0, nt_;
      if (scan_cu) { t0 = 5 * (g >> 2); nt_ = 5; } else { const int a = g - (g >> 2); t0 = 40 + (a < 16 ? 10 * a : 160 + 9 * (a - 16)); nt_ = a < 16 ? 10 : 9; }
      AIn ain;
      { const int cl = t0 / NCHUNK, bh = 2 * x + (cl >> 1), dir = cl & 1; scanA_issue(F, (dir * 4 + (bh >> 2)) * 4 + (bh & 3), t0 % NCHUNK, ain); }
      for (int lt = t0; lt < t0 + nt_; ++lt) { const int cl = lt / NCHUNK, bh = 2 * x + (cl >> 1), dir = cl & 1;
          const int l2 = lt + 1, cl2 = l2 / NCHUNK, bh2 = 2 * x + (cl2 >> 1), dir2 = cl2 & 1;
          scanA_task(F, (dir * 4 + (bh >> 2)) * 4 + (bh & 3), lt % NCHUNK, Y, 0, ain, l2 < t0 + nt_, (dir2 * 4 + (bh2 >> 2)) * 4 + (bh2 & 3), l2 % NCHUNK); } }
    unsigned* arrive = (unsigned*)(F.ws + WS_CTL) + 9600 + l * 64;
    asm volatile("s_waitcnt vmcnt(0)" ::: "memory");
    __syncthreads();
    if (F.tid == 0) { __builtin_amdgcn_fence(__ATOMIC_RELEASE, "agent"); asm volatile("s_waitcnt vmcnt(0)" ::: "memory"); __hip_atomic_fetch_add(arrive + 32 + x, 1u, __ATOMIC_RELAXED, __HIP_MEMORY_SCOPE_AGENT); }
    if (l + 1 < NL && !scan_cu && (g >> 2) < 2 && ((g >> 2) == 0 || (g & 3) == 0)) {
        const int hh = (g >> 2) == 0 ? (g & 3) : 3;
        const int b = x >> 1, kvh = x & 1, h = kvh * 4 + hh; const size_t r0 = (size_t)b * SB;
        attn_body::attn_unit<8>(U + r0 * QKVP + h * 64, U + r0 * QKVP + K_OFF + kvh * 64, U + r0 * QKVP + V_OFF + kvh * 64, MIX + r0 * D + h * 64, CT / 64, shm);
    }
    unsigned* ctr = (unsigned*)(F.ws + WS_CTL) + 9216 + l * 64 + x * 8;
    volatile LAS unsigned* qw = (volatile LAS unsigned*)(F.lds + MISC_OFF + 64);
    const int b = x >> 1, kvh = x & 1; const size_t r0 = (size_t)b * SB;
#define AQ_TAKE(jv) do { if (F.tid == 0) qw[0] = __hip_atomic_fetch_add(ctr, 1u, __ATOMIC_RELAXED, __HIP_MEMORY_SCOPE_AGENT); __syncthreads(); jv = (int)qw[0]; __syncthreads(); } while (0)
#define AQ_UNIT(jv) do { const int h_ = kvh * 4 + ((jv) >> 4), qb_ = (jv) & 15; const size_t q0_ = r0 + CT + (size_t)qb_ * 256; \
        attn_body::attn_unit<8>(U + q0_ * QKVP + h_ * 64, U + r0 * QKVP + K_OFF + kvh * 64, U + r0 * QKVP + V_OFF + kvh * 64, MIX + q0_ * D + h_ * 64, SB / 64, shm); } while (0)
    int j0; AQ_TAKE(j0);
    if (j0 < 64) AQ_UNIT(j0);
    if (scan_cu) {
        if (F.tid == 0) { unsigned sp = 0;
            while (__hip_atomic_load(arrive + 32 + x, __ATOMIC_RELAXED, __HIP_MEMORY_SCOPE_AGENT) < 32u) { __builtin_amdgcn_s_sleep(2); if (++sp > (1u << 22)) break; }
            __builtin_amdgcn_fence(__ATOMIC_ACQUIRE, "agent"); asm volatile("s_waitcnt vmcnt(0)" ::: "memory"); }
        __syncthreads();
        const int sc = (g >> 2) * 8 + x, t = sc >> 3, bh = 2 * x + (t >> 2);
        scanBC_task(F, (((t >> 1) & 1) * 4 + (bh >> 2)) * 4 + (bh & 3), t & 1, Y, 0, nullptr, nullptr);
        asm volatile("s_waitcnt vmcnt(0)" ::: "memory");
        __syncthreads();
        if (F.tid == 0) { __builtin_amdgcn_fence(__ATOMIC_RELEASE, "agent"); asm volatile("s_waitcnt vmcnt(0)" ::: "memory"); __hip_atomic_fetch_add(arrive + 16, 1u, __ATOMIC_RELAXED, __HIP_MEMORY_SCOPE_AGENT); }
    }
    if (j0 < 64) for (;;) { int j; AQ_TAKE(j); if (j >= 64) break; AQ_UNIT(j); }
#undef AQ_TAKE
#undef AQ_UNIT
    if (F.tid == 0) { unsigned sp = 0;
        while (__hip_atomic_load(arrive + 16, __ATOMIC_RELAXED, __HIP_MEMORY_SCOPE_AGENT) < 64u) { __builtin_amdgcn_s_sleep(2); if (++sp > (1u << 22)) break; }
        __builtin_amdgcn_fence(__ATOMIC_ACQUIRE, "agent"); asm volatile("s_waitcnt vmcnt(0)" ::: "memory"); }
    __syncthreads();
    rwkv_out_phase(F, l);
}

__global__ void __launch_bounds__(128) k_attn_simple(const bf16* __restrict__ U, bf16* __restrict__ MIX) {
    __shared__ float Ks[64][64];
    __shared__ float Vs[64][64];
    const int qb = blockIdx.x % 34, b = blockIdx.x / 34, h = blockIdx.y, kvh = h >> 2, tid = threadIdx.x;
    const size_t rb = (size_t)b * SB;
    const int row = qb * 128 + tid;
    const int nk = (qb < 2) ? CT : SB;
    float q[64], o[64];
#pragma unroll
    for (int d = 0; d < 64; ++d) { q[d] = bf2f(U[(rb + row) * QKVP + h * 64 + d]); o[d] = 0.f; }
    float m = -1e30f, l = 0.f;
    for (int k0 = 0; k0 < nk; k0 += 64) {
        __syncthreads();
        for (int i = tid; i < 64 * 64; i += 128) { const int j = i >> 6, d = i & 63;
            Ks[j][d] = bf2f(U[(rb + k0 + j) * QKVP + K_OFF + kvh * 64 + d]);
            Vs[j][d] = bf2f(U[(rb + k0 + j) * QKVP + V_OFF + kvh * 64 + d]); }
        __syncthreads();
        for (int j = 0; j < 64; ++j) {
            float s = 0.f;
#pragma unroll
            for (int d = 0; d < 64; ++d) s += q[d] * Ks[j][d];
            const float mn = fmaxf(m, s);
            const float corr = exp2f(m - mn), p = exp2f(s - mn);
            l = l * corr + p; m = mn;
#pragma unroll
            for (int d = 0; d < 64; ++d) o[d] = o[d] * corr + p * Vs[j][d];
        }
    }
    const float il = 1.f / l;
#pragma unroll
    for (int d = 0; d < 64; ++d) MIX[(rb + row) * D + h * 64 + d] = (bf16)f2bf(o[d] * il);
}

__global__ void __launch_bounds__(64) k_scan_simple(const bf16* __restrict__ r_i, const bf16* __restrict__ v_i, const bf16* __restrict__ kk_i,
                                                    const float* __restrict__ w_i, const bf16* __restrict__ ke_i, const bf16* __restrict__ kka_i, float* __restrict__ y_o) {
    __shared__ float sh[16][5][64];
    __shared__ float sv[16][64];
    const int h = blockIdx.x, dir = blockIdx.y, b = blockIdx.z, v = threadIdx.x;
    const size_t dofs = (size_t)dir * M * 256;
    float S[64];
#pragma unroll
    for (int k = 0; k < 64; ++k) S[k] = 0.f;
    for (int s0 = 0; s0 < SB; s0 += 16) {
        __syncthreads();
#pragma unroll
        for (int i = 0; i < 16; ++i) {
            const int s = s0 + i;
            const int sr = s < CT ? (dir == 0 ? s : CT - 1 - s) : (dir == 0 ? s : CT + (TL - 1 - (s - CT)));
            const size_t o = ((size_t)b * SB + sr) * 256 + h * 64 + v;
            sh[i][0][v] = __expf(w_i[dofs + o]); sh[i][1][v] = bf2f(kk_i[o]); sh[i][2][v] = bf2f(kka_i[dofs + o]); sh[i][3][v] = bf2f(ke_i[dofs + o]); sh[i][4][v] = bf2f(r_i[o]); sv[i][v] = bf2f(v_i[o]);
        }
        __syncthreads();
        for (int i = 0; i < 16; ++i) {
            const int s = s0 + i;
            const int sr = s < CT ? (dir == 0 ? s : CT - 1 - s) : (dir == 0 ? s : CT + (TL - 1 - (s - CT)));
            float sa = 0.f;
#pragma unroll
            for (int k = 0; k < 64; ++k) sa += S[k] * sh[i][1][k];
            const float vv = sv[i][v];
            float y = 0.f;
#pragma unroll
            for (int k = 0; k < 64; ++k) { S[k] = S[k] * sh[i][0][k] - sa * sh[i][2][k] + vv * sh[i][3][k]; y += S[k] * sh[i][4][k]; }
            y_o[dofs + ((size_t)b * SB + sr) * 256 + h * 64 + v] = y;
        }
    }
}

struct CtxSplitOrder {
    int G, c, ntk, nks, nsub;
    __device__ void init(int G_, int c_, int ntk_, int nctx) { G = G_; c = c_; ntk = ntk_; nks = ntk_ / 4; nsub = nctx * 4 * nks; }
    __device__ bool next(int i, pg8::Unit& u) const {
        const int Lx = i * G + c;
        if (Lx < 256) {
            int wgid = Lx; { const int q = 256 / 8, xcd = wgid % 8, off = wgid / 8; wgid = xcd * q + off; }
            const int nig = 8 * 4, gid = wgid / nig, fm = gid * 8;
            const int pm64 = fm + ((wgid % nig) % 8); u.pn = (wgid % nig) / 8;
            u.pm = pm64 + pm64 / 16 + 1; u.k0t = 0; u.nt = ntk; u.slot = -1; return true;
        }
        const int sub = Lx - 256; if (sub >= nsub) return false;
        const int ks = sub % nks, ct = sub / nks;
        u.pm = (ct >> 2) * 17; u.pn = ct & 3; u.k0t = ks * 4; u.nt = 4; u.slot = ks; return true;
    }
    __device__ __forceinline__ void a_ready(const pg8::Unit&) const {}
    __device__ __forceinline__ void done(const pg8::Unit&) const {}
};

constexpr int NPL = 11, NPHASE = 2 + NPL * NL;
#define PH_IN(k) (lo <= (k) && (k) < hi)
#if PROBE_MASK
#define PH_STAMP(k) do { if (blockIdx.x == 0 && threadIdx.x == 0) ((unsigned long long*)(F.ws + WS_CTL + 32768))[(k) + 1] = __builtin_amdgcn_s_memrealtime(); } while (0)
#else
#define PH_STAMP(k) do { } while (0)
#endif
#define PH_SEAM(k) do { if (PH_IN(k) && PH_IN((k) + 1)) xcd_barrier(bar); PH_STAMP(k); } while (0)
template <int L> __device__ __forceinline__ void layer_phases(const Frame& F, const int lo, const int hi, const XcdBarrier& bar) {
    constexpr int pb = 2 + NPL * L;
    bf16* XN = (bf16*)(F.ws + WS_AR + AR_XN); bf16* U = (bf16*)(F.ws + WS_AR + AR_U); bf16* MIX = (bf16*)(F.ws + WS_AR + AR_MIX);
    float* MIXO = (float*)(F.ws + WS_AR + AR_MIXO); bf16* H = (bf16*)(F.ws + WS_AR + AR_H); bf16* ACT = (bf16*)(F.ws + WS_AR + AR_ACT); float* FO = (float*)(F.ws + WS_AR + AR_FO);
    bf16* t_in = (bf16*)(F.ws + WS_WIN); bf16* t_out = (bf16*)(F.ws + WS_WOUT); bf16* t_up = (bf16*)(F.ws + WS_WUP); bf16* t_dn = (bf16*)(F.ws + WS_WDN);
    if (PH_IN(pb + 0)) { pg8::Gemm g{XN, t_in, M, NINP, D}; pg8::StaticOrder S; S.init(M, NINP, F.G, F.bid, D);
        pg8::EpiBf16<0> E{U, NINP, nullptr, 0, 0, 1.f};
        pg8::gemm_phase<pg8::EpiBf16<0>, pg8::StaticOrder, true, true>(F.lds, g, S, E); }
    PH_SEAM(pb + 0);
    if (PH_IN(pb + 1)) prep_phase(F, L);
    PH_SEAM(pb + 1);
#if SCAN_CHUNKED && !SCAN_DEBUG
    const bool merged = F.G == 256 && PH_IN(pb + 2) && PH_IN(pb + 3) && PH_IN(pb + 4);
    if (merged) { scan_mixer_phase(F, L); PH_STAMP(pb + 2); }
    else
#else
    const bool merged = false;
#endif
    {
    if (PH_IN(pb + 2)) {
#if SCAN_CHUNKED
        scanA_phase(F);
#endif
    }
    PH_SEAM(pb + 2);
    if (PH_IN(pb + 3)) mixer_phase(F, L);
    }
    if (!merged) PH_SEAM(pb + 3); else PH_STAMP(pb + 3);
#if SCAN_DEBUG && !SCAN_CHUNKED
    if (L == 0 && PH_IN(pb + 3)) {
        float* YD = (float*)(F.ws + WS_AR + AR_U + SCA_END);
        unsigned* dmax = (unsigned*)(F.ws + WS_CTL) + 9000;
        for (int it = F.bid; it < 8 * NCHUNK; it += F.G) { const int cl = it / NCHUNK, c = it % NCHUNK; const int ch = (cl >> 2) * 16 + (cl & 3);
            scanA_run(F, ch, c, YD, 1); }
        xcd_barrier(bar);
        if (F.bid < 16) { const int cl = F.bid >> 1, ch = (cl >> 2) * 16 + (cl & 3);
            scanBC_task(F, ch, F.bid & 1, YD, 1, (const float*)(F.ws + WS_AR + AR_Y), dmax); }
        xcd_barrier(bar);
    }
#endif
    if (PH_IN(pb + 4) && !merged) rwkv_out_phase(F, L);
    PH_SEAM(pb + 4);
    if (PH_IN(pb + 5)) { pg8::Gemm g{MIX, t_out, M, D, D}; CtxSplitOrder S; S.init(F.G, F.bid, D / 64, L + 1 < NL ? 4 : 0);
        pg8::EpiBf16P E{(bf16*)MIXO, D, (float*)(F.ws + WS_AR + AR_PART)};
        pg8::gemm_phase<pg8::EpiBf16P, CtxSplitOrder, true, true>(F.lds, g, S, E); }
    PH_SEAM(pb + 5);
    if (PH_IN(pb + 6)) norm_phase(F, 1, MIXO, INP(I_NMPOST) + L * D, L, 2, INP(I_NFPRE) + L * D, L, 3, 4, L + 1 < NL ? D / 256 : 0);
    PH_SEAM(pb + 6);
    if (PH_IN(pb + 7)) { pg8::Gemm g{XN, t_up, M, DFF2, D}; pg8::StaticOrder S; S.init(M, DFF2, F.G, F.bid, D);
        pg8::EpiBf16<0> E{H, DFF2, nullptr, 0, 0, 1.f};
        pg8::gemm_phase<pg8::EpiBf16<0>, pg8::StaticOrder, true, true>(F.lds, g, S, E); }
    PH_SEAM(pb + 7);
    if (PH_IN(pb + 8)) act_phase(F, L);
    PH_SEAM(pb + 8);
    if (PH_IN(pb + 9)) { pg8::Gemm g{ACT, t_dn, M, D, DFF}; CtxSplitOrder S; S.init(F.G, F.bid, DFF / 64, L + 1 < NL ? 4 : 0);
        pg8::EpiBf16P E{(bf16*)FO, D, (float*)(F.ws + WS_AR + AR_PART)};
        pg8::gemm_phase<pg8::EpiBf16P, CtxSplitOrder, true, true>(F.lds, g, S, E); }
    PH_SEAM(pb + 9);
    if (PH_IN(pb + 10)) {
        if (L + 1 < NL) { norm_phase(F, 1, FO, INP(I_NFPOST) + L * D, L, 5, INP(I_NMPRE) + (L + 1 < NL ? L + 1 : L) * D, L + 1, 0, 1, DFF / 256); __syncthreads(); convert_weights(F, L + 1); }
        else norm_phase(F, 2, FO, INP(I_NFPOST) + L * D, L, 5, nullptr, 0, 0, 0, 0);
    }
    if (L + 1 < NL) PH_SEAM(pb + 10); else PH_STAMP(pb + 10);
}
__global__ void __launch_bounds__(NTHR, 2) mk_fwd(Args args) {
    extern __shared__ __attribute__((aligned(16))) unsigned char lds_raw[];
    Frame F;
    F.lds = (LAS unsigned char*)lds_raw;
    F.tid = threadIdx.x; F.lane = F.tid & 63; F.wave = __builtin_amdgcn_readfirstlane(F.tid >> 6);
    F.bid = blockIdx.x; F.G = gridDim.x; F.ws = args.ws; F.out = args.out;
    volatile LAS unsigned* MISC = (volatile LAS unsigned*)(F.lds + MISC_OFF);
    for (int u = F.tid; u < (LDS_BYTES - LDSCTL_OFF) / 4; u += NTHR) ((LAS unsigned*)(F.lds + LDSCTL_OFF))[u] = 0u;
    __syncthreads();
    if (F.tid == 0) {
#pragma unroll
        for (int i = 0; i < 29; ++i) ((unsigned long long LAS*)(F.lds + PTR_OFF))[i] = (unsigned long long)args.in[i];
    }
    __syncthreads();
    const int lo = args.ph_lo, hi = args.ph_hi;
    XcdBarrier bar; bar.bar = (unsigned*)(F.ws + WS_CTL) + CW_BAR; bar.x = 0; bar.st = nullptr;
    if (hi - lo > 1) bar = xcd_barrier_post((unsigned*)(F.ws + WS_CTL) + CW_BAR, MISC + 8);
#if PROBE_MASK
    if (blockIdx.x == 0 && threadIdx.x == 0) ((unsigned long long*)(F.ws + WS_CTL + 32768))[0] = __builtin_amdgcn_s_memrealtime();
#endif
    if (PH_IN(0)) phase_pro_a(F);
#if ONE_LAUNCH
    if (PH_IN(0) && PH_IN(1)) cg::this_grid().sync();
    PH_STAMP(0);
#else
    PH_SEAM(0);
#endif
    if (PH_IN(1)) norm_phase(F, 0, nullptr, nullptr, 0, 0, INP(I_NMPRE), 0, 0, 1, 0);
    PH_SEAM(1);
    layer_phases<0>(F, lo, hi, bar);
    layer_phases<1>(F, lo, hi, bar);
    layer_phases<2>(F, lo, hi, bar);
    layer_phases<3>(F, lo, hi, bar);
#if SCAN_DEBUG
    xcd_barrier(bar);
    if (blockIdx.x == 0 && threadIdx.x == 0) { const unsigned* dmax = (const unsigned*)(F.ws + WS_CTL) + 9000;
        F.out[0] += 1000.f * __builtin_bit_cast(float, __hip_atomic_load(dmax + (SCAN_DEBUG == 2 ? 1 : 0), __ATOMIC_RELAXED, __HIP_MEMORY_SCOPE_AGENT)); }
#endif
#if PROBE_MASK
    if (blockIdx.x == 0 && threadIdx.x == 0) {
        asm volatile("s_waitcnt vmcnt(0)" ::: "memory");
        volatile unsigned long long* ts = (volatile unsigned long long*)(F.ws + WS_CTL + 32768);
        unsigned long long tot = 0;
        for (int k = 0; k < NPHASE; ++k) {
            const int bit = k == 0 ? 12 : k == 1 ? 13 : (k - 2) % NPL;
            if ((PROBE_MASK >> bit) & 1) tot += ts[k + 1] - ts[k];
        }
        const unsigned long long t0 = __builtin_amdgcn_s_memrealtime();
        while (__builtin_amdgcn_s_memrealtime() - t0 < tot * PROBE_AMP) __builtin_amdgcn_s_sleep(8);
    }
#endif
}

extern "C" void kernel_launch(void* const* d_in, const int* in_sizes, int n_in, void* d_out, int out_size, void* d_ws, size_t ws_size, hipStream_t stream) {
    static int grid = 0;
    if (grid == 0) {
        if (n_in != 29 || ws_size < WS_END) { fprintf(stderr, "kernel_launch: unexpected n_in %d or ws %zu < %zu\n", n_in, ws_size, (size_t)WS_END); grid = -1; return; }
        int dev = 0, cus = 0, per_cu = 0;
        hipGetDevice(&dev); hipDeviceGetAttribute(&cus, hipDeviceAttributeMultiprocessorCount, dev);
        hipFuncSetAttribute((const void*)mk_fwd, hipFuncAttributeMaxDynamicSharedMemorySize, LDS_BYTES);
        hipOccupancyMaxActiveBlocksPerMultiprocessor(&per_cu, (const void*)mk_fwd, NTHR, LDS_BYTES);
        if (per_cu < 1) { fprintf(stderr, "kernel_launch: occupancy query says %d blocks per CU\n", per_cu); grid = -1; return; }
        grid = cus;
    }
    if (grid < 0) return;
    hipMemsetAsync((char*)d_ws + WS_CTL, 0, CTL_ZERO_BYTES, stream);
    Args a{};
    for (int i = 0; i < 29; ++i) a.in[i] = (const float*)d_in[i];
    a.out = (float*)d_out; a.ws = (unsigned char*)d_ws;
    unsigned char* ws = (unsigned char*)d_ws;
    auto launch = [&](int lo, int hi) { a.ph_lo = lo; a.ph_hi = hi; hipLaunchKernelGGL(mk_fwd, dim3(grid), dim3(NTHR), LDS_BYTES, stream, a); };
#if ONE_LAUNCH
    { a.ph_lo = 0; a.ph_hi = NPHASE; void* kargs[] = {&a};
      hipLaunchCooperativeKernel((const void*)mk_fwd, dim3(grid), dim3(NTHR), kargs, LDS_BYTES, stream); }
#else
    launch(0, 1); launch(1, 2);
    for (int l = 0; l < NL; ++l) { const int pb = 2 + NPL * l; for (int p = 0; p < NPL; ++p) launch(pb + p, pb + p + 1); }
#endif
}
```

```cpp
#include <hip/hip_runtime.h>
#include <hip/hip_bf16.h>
#include <hip/hip_cooperative_groups.h>
#include <cstdio>
#include <cstdint>
#include <math.h>
namespace cg = cooperative_groups;

namespace pg8 {
#define PG8_LAS __attribute__((address_space(3)))
typedef unsigned short bf16_t;
typedef short bf16x8 __attribute__((ext_vector_type(8)));
typedef float f32x4 __attribute__((ext_vector_type(4)));
typedef unsigned u32x4 __attribute__((ext_vector_type(4)));
constexpr int BM = 256, BK = 64, HALF = 128, HTB = HALF * BK * 2  , STAGE_BYTES = 8 * HTB, NXCD = 8, WGM = 8;

__host__ __device__ __forceinline__ int lds_byte(int r, int c) { const int st = (r >> 4) * 2 + (c >> 5), rr = r & 15, cc = c & 31, ob = rr * 64 + cc * 2; return st * 1024 + (ob ^ (((ob >> 9) & 1) << 5)); }
__host__ __device__ __forceinline__ void stage_rc(int b, int& R, int& C) { const int st = b / 1024, sb = b % 1024, swz = sb ^ (((sb >> 9) & 1) << 5); R = (st >> 1) * 16 + swz / 64; C = (st & 1) * 32 + (swz % 64) / 2; }
__host__ __device__ __forceinline__ int perm32(int rho) { const int n = rho >> 4, i = rho & 15; return 8 * (i >> 2) + 4 * n + (i & 3); }

struct Unit { int pm, pn, k0t, nt, slot; };
struct Gemm { const bf16_t* A; const bf16_t* Bt; int M, N, K; };

struct StaticOrder {
    int nM, nN, nwg, G, c, ntk;
    __host__ __device__ void init(int M, int N, int G_, int c_, int K_ = 0) { nM = M / BM; nN = N / BM; nwg = nM * nN; G = G_; c = c_; ntk = K_ / BK; }
    __host__ __device__ bool next(int i, Unit& u) const {
        const long L = (long)i * G + c; if (L >= nwg) return false;
        int wgid = (int)L; { const int q = nwg / NXCD, r = nwg % NXCD, xcd = wgid % NXCD, off = wgid / NXCD; wgid = (xcd < r ? xcd * (q + 1) : r * (q + 1) + (xcd - r) * q) + off; }
        const int nig = WGM * nN, gid = wgid / nig, fm = gid * WGM, gsz = (nM - fm) < WGM ? (nM - fm) : WGM;
        u.pm = fm + ((wgid % nig) % gsz); u.pn = (wgid % nig) / gsz; u.k0t = 0; u.nt = ntk; u.slot = -1; return true;
    }
    __device__ __forceinline__ void a_ready(const Unit&) const {}
    __device__ __forceinline__ void done(const Unit&) const {}
};

__device__ __forceinline__ unsigned cvt_pk_bf16(float lo, float hi) { unsigned r; asm volatile("v_cvt_pk_bf16_f32 %0, %1, %2" : "=v"(r) : "v"(lo), "v"(hi)); return r; }
typedef float f32x2 __attribute__((ext_vector_type(2)));
__device__ __forceinline__ f32x2 gelu_pk(f32x2 v) {
    const f32x2 av = __builtin_elementwise_abs(v), d = av * 0.2316418882f + 1.0f;
    f32x2 t; t.x = __builtin_amdgcn_rcpf(d.x); t.y = __builtin_amdgcn_rcpf(d.y);
    f32x2 q = t * 0.5307027145f + (-0.7265760135f); q = q * t + 0.7107068705f; q = q * t + (-0.142248368f); q = q * t + 0.127414796f; q = q * t;
    const f32x2 s = (v * v) * (-0.72134752044f);
    f32x2 e; e.x = __builtin_amdgcn_exp2f(s.x); e.y = __builtin_amdgcn_exp2f(s.y);
    const f32x2 m = v * (q * e), r = v - m;
    f32x2 o; o.x = v.x < 0.f ? m.x : r.x; o.y = v.y < 0.f ? m.y : r.y; return o;
}

template <int ACT  > struct EpiBf16 {
    static constexpr bool PERM = true, AFTER_DRAIN = false; static_assert(ACT == 0 || ACT == 1, "EpiBf16: ACT is 0 (none) or 1 (gelu_pk)");
    bf16_t* O; int ldc; const float* bias; int split_cols; size_t split_stride; float scale0;
    __device__ __forceinline__ void operator()(const f32x4 (&acc)[2][2][4][2], const Unit& u, int wr, int wc, int fr, int fq) const {
        const int row0 = u.pm * BM + wr * 64 + fr; int colt = u.pn * BM; bf16_t* base = O;
        float sc = 1.f; if (split_cols) { const int t = colt / split_cols; base += (size_t)t * split_stride; colt -= t * split_cols; if (t == 0) sc = scale0; }
        const int col0 = colt + wc * 32 + 8 * fq, bcol0 = u.pn * BM + wc * 32 + 8 * fq;
        f32x4 bv[2][2];
#pragma unroll
        for (int bj = 0; bj < 2; ++bj)
#pragma unroll
            for (int n = 0; n < 2; ++n) bv[bj][n] = bias ? *(const f32x4*)(bias + bcol0 + bj * HALF + 4 * n) : (f32x4){0.f, 0.f, 0.f, 0.f};
#pragma unroll
        for (int ai = 0; ai < 2; ++ai)
#pragma unroll
            for (int m = 0; m < 4; ++m) { bf16_t* rowp = base + (size_t)(row0 + ai * HALF + m * 16) * ldc + col0;
#pragma unroll
                for (int bj = 0; bj < 2; ++bj) { f32x4 v0 = acc[ai][bj][m][0] + bv[bj][0], v1 = acc[ai][bj][m][1] + bv[bj][1];
                    if (ACT == 1) { f32x2 a = gelu_pk((f32x2){v0[0], v0[1]}), b = gelu_pk((f32x2){v0[2], v0[3]}), c = gelu_pk((f32x2){v1[0], v1[1]}), d = gelu_pk((f32x2){v1[2], v1[3]});
                        v0 = (f32x4){a.x, a.y, b.x, b.y}; v1 = (f32x4){c.x, c.y, d.x, d.y}; }
                    v0 = v0 * sc; v1 = v1 * sc; u32x4 w; w.x = cvt_pk_bf16(v0[0], v0[1]); w.y = cvt_pk_bf16(v0[2], v0[3]); w.z = cvt_pk_bf16(v1[0], v1[1]); w.w = cvt_pk_bf16(v1[2], v1[3]);
                    *(u32x4*)(rowp + bj * HALF) = w; } }
    }
};

struct EpiF32 {
    static constexpr bool PERM = false, AFTER_DRAIN = false;
    float* C; int ldc; const float* bias; float* part;
    __device__ __forceinline__ void operator()(const f32x4 (&acc)[2][2][4][2], const Unit& u, int wr, int wc, int fr, int fq) const {
        const int row0 = (u.slot >= 0 ? (u.slot * 4 + u.pm / 17) * BM : u.pm * BM) + wr * 64 + fr, col0 = u.pn * BM + wc * 32 + 4 * fq;
        float* const Cb = u.slot >= 0 ? part : C;
        f32x4 bv[2][2];
#pragma unroll
        for (int bj = 0; bj < 2; ++bj)
#pragma unroll
            for (int n = 0; n < 2; ++n) bv[bj][n] = bias ? *(const f32x4*)(bias + col0 + bj * HALF + n * 16) : (f32x4){0.f, 0.f, 0.f, 0.f};
#pragma unroll
        for (int ai = 0; ai < 2; ++ai)
#pragma unroll
            for (int m = 0; m < 4; ++m) { float* rowp = Cb + (size_t)(row0 + ai * HALF + m * 16) * ldc + col0;
#pragma unroll
                for (int bj = 0; bj < 2; ++bj)
#pragma unroll
                    for (int n = 0; n < 2; ++n) *(f32x4*)(rowp + bj * HALF + n * 16) = acc[ai][bj][m][n] + bv[bj][n]; }
    }
};

struct EpiBf16P {
    static constexpr bool PERM = true, AFTER_DRAIN = false;
    bf16_t* O; int ldc; float* part;
    __device__ __forceinline__ void operator()(const f32x4 (&acc)[2][2][4][2], const Unit& u, int wr, int wc, int fr, int fq) const {
        const int col0 = u.pn * BM + wc * 32 + 8 * fq;
        if (u.slot < 0) {
            const int row0 = u.pm * BM + wr * 64 + fr;
#pragma unroll
            for (int ai = 0; ai < 2; ++ai)
#pragma unroll
                for (int m = 0; m < 4; ++m) { bf16_t* rowp = O + (size_t)(row0 + ai * HALF + m * 16) * ldc + col0;
#pragma unroll
                    for (int bj = 0; bj < 2; ++bj) { const f32x4 v0 = acc[ai][bj][m][0], v1 = acc[ai][bj][m][1];
                        u32x4 w; w.x = cvt_pk_bf16(v0[0], v0[1]); w.y = cvt_pk_bf16(v0[2], v0[3]); w.z = cvt_pk_bf16(v1[0], v1[1]); w.w = cvt_pk_bf16(v1[2], v1[3]);
                        *(u32x4*)(rowp + bj * HALF) = w; } }
        } else {
            const int row0 = (u.slot * 4 + u.pm / 17) * BM + wr * 64 + fr;
#pragma unroll
            for (int ai = 0; ai < 2; ++ai)
#pragma unroll
                for (int m = 0; m < 4; ++m) { float* rowp = part + (size_t)(row0 + ai * HALF + m * 16) * ldc + col0;
#pragma unroll
                    for (int bj = 0; bj < 2; ++bj) { *(f32x4*)(rowp + bj * HALF) = acc[ai][bj][m][0]; *(f32x4*)(rowp + bj * HALF + 4) = acc[ai][bj][m][1]; } }
        }
    }
};
template <class Epi, class Sched, bool ALIGN_EPI = false, bool SP2 = false>
__device__ __forceinline__ void gemm_phase(PG8_LAS unsigned char* lds, const Gemm g, const Sched& S, const Epi& E) {
    const int tid = threadIdx.x, wid = __builtin_amdgcn_readfirstlane(tid >> 6), lane = tid & 63, wr = wid >> 2, wc = wid & 3, fr = lane & 15, fq = lane >> 4;
    const int K = g.K;
    unsigned voffA[2], voffB[2];
#pragma unroll
    for (int i = 0; i < 2; ++i) { int R, C; stage_rc(tid * 16 + i * 8192, R, C); const int Rb = Epi::PERM ? ((R & ~31) + perm32(R & 31)) : R;
        voffA[i] = (unsigned)(R * K + C) * 2u; voffB[i] = (unsigned)(Rb * K + C) * 2u; }
    const size_t kstep = (size_t)(BK * 2);
    const size_t hstep = (size_t)HALF * K * 2;
    const size_t tstep = 2 * hstep;
    const unsigned ldsw = (unsigned)wid * 1024u;
    const int aoff = lds_byte(wr * 64 + fr, fq * 8), boff = lds_byte(wc * 32 + fr, fq * 8);
#define PG8_SA(b, h) (((b) * 2 + (h)) * HTB)
#define PG8_SB(b, h) ((4 + (b) * 2 + (h)) * HTB)
#define PG8_STAGE(bufoff, gbase, voff) do { _Pragma("unroll") for (int _i = 0; _i < 2; ++_i) \
        __builtin_amdgcn_global_load_lds((const unsigned*)((const char*)(gbase) + (voff)[_i]), (PG8_LAS unsigned*)(lds + (bufoff) + ldsw + _i * 8192), 16, 0, 0); } while (0)
#define PG8_LDA(dst, b, h) do { _Pragma("unroll") for (int m = 0; m < 4; ++m) _Pragma("unroll") for (int k = 0; k < 2; ++k) dst[m][k] = *(const PG8_LAS bf16x8*)(lds + PG8_SA(b, h) + aoff + m * 2048 + k * 1024); } while (0)
#define PG8_LDB(dst, b, h) do { _Pragma("unroll") for (int n = 0; n < 2; ++n) _Pragma("unroll") for (int k = 0; k < 2; ++k) dst[n][k] = *(const PG8_LAS bf16x8*)(lds + PG8_SB(b, h) + boff + n * 2048 + k * 1024); } while (0)
#define PG8_MMA(ai, bj, At, Bt) do { __builtin_amdgcn_s_setprio(1); _Pragma("unroll") for (int m = 0; m < 4; ++m) _Pragma("unroll") for (int n = 0; n < 2; ++n) _Pragma("unroll") for (int k = 0; k < 2; ++k) \
        acc[ai][bj][m][n] = __builtin_amdgcn_mfma_f32_16x16x32_bf16(Bt[n][k], At[m][k], acc[ai][bj][m][n], 0, 0, 0); __builtin_amdgcn_s_setprio(0); } while (0)
#define PG8_WAIT_V(n) asm volatile("s_waitcnt vmcnt(" #n ")" ::: "memory")
#define PG8_WAIT_L(n) asm volatile("s_waitcnt lgkmcnt(" #n ")" ::: "memory")
#define PG8_BAR __builtin_amdgcn_s_barrier()
#define PG8_SCHED __builtin_amdgcn_sched_barrier(0)
    Unit cur, nxt; int ui = 0;
    if (!S.next(0, cur)) return;
    f32x4 acc[2][2][4][2];
#pragma unroll
    for (int a = 0; a < 2; ++a)
#pragma unroll
        for (int b = 0; b < 2; ++b)
#pragma unroll
            for (int m = 0; m < 4; ++m)
#pragma unroll
                for (int n = 0; n < 2; ++n) acc[a][b][m][n] = (f32x4){0.f, 0.f, 0.f, 0.f};
    bf16x8 At[4][2], B0[2][2], B1[2][2];
    const char* cA = (const char*)g.A + (size_t)cur.pm * tstep + (size_t)cur.k0t * kstep; const char* cB = (const char*)g.Bt + (size_t)cur.pn * tstep + (size_t)cur.k0t * kstep;
    S.a_ready(cur);
    if constexpr (SP2) {
        PG8_STAGE(PG8_SB(0, 0), cB, voffB); PG8_STAGE(PG8_SB(0, 1), cB + hstep, voffB); PG8_STAGE(PG8_SA(0, 0), cA, voffA); PG8_STAGE(PG8_SA(0, 1), cA + hstep, voffA);
        if (wr == 1) PG8_BAR;
        PG8_WAIT_V(2); PG8_BAR;
        PG8_STAGE(PG8_SB(1, 0), cB + kstep, voffB); PG8_STAGE(PG8_SA(1, 0), cA + kstep, voffA); PG8_STAGE(PG8_SB(1, 1), cB + hstep + kstep, voffB);
        PG8_WAIT_V(6); PG8_BAR;
    } else {
        PG8_STAGE(PG8_SB(0, 0), cB, voffB); PG8_STAGE(PG8_SA(0, 0), cA, voffA); PG8_STAGE(PG8_SB(0, 1), cB + hstep, voffB); PG8_STAGE(PG8_SA(0, 1), cA + hstep, voffA);
        if (wr == 1) PG8_BAR;
        PG8_WAIT_V(4); PG8_BAR;
        PG8_STAGE(PG8_SB(1, 0), cB + kstep, voffB); PG8_STAGE(PG8_SA(1, 0), cA + kstep, voffA); PG8_STAGE(PG8_SB(1, 1), cB + hstep + kstep, voffB);
        PG8_WAIT_V(6); PG8_BAR;
    }
    for (;;) {
        const bool has_next = S.next(ui + 1, nxt);
        const char* nA = has_next ? (const char*)g.A + (size_t)nxt.pm * tstep + (size_t)nxt.k0t * kstep : cA; const char* nB = has_next ? (const char*)g.Bt + (size_t)nxt.pn * tstep + (size_t)nxt.k0t * kstep : cB;
        const int nt = cur.nt;
        for (int t = 0; t < nt; t += 2) {
            const bool last = (t == nt - 2);
            const char* a1 = cA + (size_t)(t + 1) * kstep;
            const char* a2 = last ? nA : cA + (size_t)(t + 2) * kstep; const char* b2 = last ? nB : cB + (size_t)(t + 2) * kstep;
            const char* a3 = a2 + kstep; const char* b3 = b2 + kstep;
            if (last && has_next) S.a_ready(nxt);
            if constexpr (SP2) {
            PG8_LDB(B0, 0, 0); PG8_LDB(B1, 0, 1); PG8_SCHED; PG8_LDA(At, 0, 0); PG8_STAGE(PG8_SA(1, 1), a1 + hstep, voffA);
            PG8_WAIT_V(8); PG8_WAIT_L(0); PG8_BAR; PG8_MMA(0, 0, At, B0); PG8_MMA(0, 1, At, B1); PG8_BAR; PG8_SCHED;
            PG8_LDA(At, 0, 1); PG8_STAGE(PG8_SB(0, 0), b2, voffB); PG8_STAGE(PG8_SB(0, 1), b2 + hstep, voffB); PG8_STAGE(PG8_SA(0, 0), a2, voffA);
            PG8_WAIT_V(8); PG8_WAIT_L(0); PG8_BAR; PG8_MMA(1, 0, At, B0); PG8_MMA(1, 1, At, B1); PG8_BAR; PG8_SCHED;
            PG8_LDB(B0, 1, 0); PG8_LDB(B1, 1, 1); PG8_SCHED; PG8_LDA(At, 1, 0); PG8_STAGE(PG8_SA(0, 1), a2 + hstep, voffA);
            PG8_WAIT_V(8); PG8_WAIT_L(0); PG8_BAR; PG8_MMA(0, 0, At, B0); PG8_MMA(0, 1, At, B1); PG8_BAR; PG8_SCHED;
            PG8_LDA(At, 1, 1); PG8_STAGE(PG8_SB(1, 0), b3, voffB); PG8_STAGE(PG8_SB(1, 1), b3 + hstep, voffB); PG8_STAGE(PG8_SA(1, 0), a3, voffA);
            PG8_WAIT_V(8); PG8_WAIT_L(0); PG8_BAR; PG8_MMA(1, 0, At, B0); PG8_MMA(1, 1, At, B1); PG8_BAR; PG8_SCHED;
            } else {
            PG8_LDB(B0, 0, 0); PG8_SCHED; PG8_LDA(At, 0, 0); PG8_STAGE(PG8_SA(1, 1), a1 + hstep, voffA);
            PG8_WAIT_L(8); PG8_BAR; PG8_WAIT_L(0); PG8_MMA(0, 0, At, B0); PG8_BAR; PG8_SCHED;
            PG8_LDB(B1, 0, 1); PG8_STAGE(PG8_SB(0, 0), b2, voffB);
            PG8_BAR; PG8_WAIT_L(0); PG8_MMA(0, 1, At, B1); PG8_BAR;
            PG8_LDA(At, 0, 1); PG8_STAGE(PG8_SA(0, 0), a2, voffA);
            PG8_BAR; PG8_WAIT_L(0); PG8_MMA(1, 0, At, B0); PG8_BAR; PG8_SCHED;
            PG8_STAGE(PG8_SB(0, 1), b2 + hstep, voffB);
            PG8_WAIT_V(6); PG8_BAR; PG8_MMA(1, 1, At, B1); PG8_BAR;
            PG8_LDB(B0, 1, 0); PG8_SCHED; PG8_LDA(At, 1, 0); PG8_STAGE(PG8_SA(0, 1), a2 + hstep, voffA);
            PG8_WAIT_L(8); PG8_BAR; PG8_WAIT_L(0); PG8_MMA(0, 0, At, B0); PG8_BAR; PG8_SCHED;
            PG8_LDB(B1, 1, 1); PG8_STAGE(PG8_SB(1, 0), b3, voffB);
            PG8_BAR; PG8_WAIT_L(0); PG8_MMA(0, 1, At, B1); PG8_BAR;
            PG8_LDA(At, 1, 1); PG8_STAGE(PG8_SA(1, 0), a3, voffA);
            PG8_BAR; PG8_WAIT_L(0); PG8_MMA(1, 0, At, B0); PG8_BAR; PG8_SCHED;
            PG8_STAGE(PG8_SB(1, 1), b3 + hstep, voffB);
            PG8_WAIT_V(6); PG8_BAR; PG8_MMA(1, 1, At, B1); PG8_BAR;
            }
        }
        if constexpr (ALIGN_EPI) { if (wr == 0) PG8_BAR; }
        if constexpr (!Epi::AFTER_DRAIN) { E(acc, cur, wr, wc, fr, fq); S.done(cur); }
        if (!has_next) break;
#pragma unroll
        for (int a = 0; a < 2; ++a)
#pragma unroll
            for (int b = 0; b < 2; ++b)
#pragma unroll
                for (int m = 0; m < 4; ++m)
#pragma unroll
                    for (int n = 0; n < 2; ++n) acc[a][b][m][n] = (f32x4){0.f, 0.f, 0.f, 0.f};
        cur = nxt; cA = nA; cB = nB; ++ui;
        if constexpr (ALIGN_EPI) { if (wr == 1) PG8_BAR; }
    }
    PG8_WAIT_V(0);
    if constexpr (!ALIGN_EPI) { if (wr == 0) PG8_BAR; }
    PG8_BAR;
    if constexpr (Epi::AFTER_DRAIN) { E.fused(acc, cur, wr, wc, fr, fq, lds, wid, lane); S.done(cur); }
#undef PG8_SA
#undef PG8_SB
#undef PG8_STAGE
#undef PG8_LDA
#undef PG8_LDB
#undef PG8_MMA
#undef PG8_WAIT_V
#undef PG8_WAIT_L
#undef PG8_BAR
#undef PG8_SCHED
}
}

#ifndef ATTN_FAST
#define ATTN_FAST 1
#endif
#ifndef SCAN_FAST
#define SCAN_FAST 1
#endif
#ifndef PROBE_MASK
#define PROBE_MASK 0
#endif
#ifndef PROBE_AMP
#define PROBE_AMP 8
#endif
#ifndef PROBE_SUB
#define PROBE_SUB -1
#endif
#if PROBE_SUB >= 0
#define SUBT(k) do { if (F.bid == 0 && F.wave == 0) { volatile __attribute__((address_space(3))) unsigned* a_ = (volatile __attribute__((address_space(3))) unsigned*)(F.lds + 131072 + 2048); \
        const unsigned n_ = (unsigned)__builtin_amdgcn_s_memrealtime(); a_[(k)] += n_ - a_[31]; a_[31] = n_; } } while (0)
#else
#define SUBT(k) do { } while (0)
#endif
#ifndef SCAN_CHUNKED
#define SCAN_CHUNKED 1
#endif
#ifndef PREP_REP
#define PREP_REP 0
#endif
#ifndef SCANA_REP
#define SCANA_REP 0
#endif
#ifndef SCAN_DEBUG
#define SCAN_DEBUG 0
#endif
#ifndef ONE_LAUNCH
#define ONE_LAUNCH 1
#endif
constexpr int NWAVES = 8, NTHR = 512;
constexpr int D = 1024, NB = 4, TL = 4096, CT = 256, SB = CT + TL  , NL = 4;
constexpr int M = NB * SB;
constexpr int NIN = 2688, NINP = 2816, DFF = 2816, DFF2 = 5632;
constexpr int R_IN = 1152, R_OFF = 768, C_OFF = 1920, K_OFF = 512, V_OFF = 640;
constexpr float NORM_EPS = 1e-6f, GN_EPS = 64e-5f, DECAY_SCALE = 0.606531f;
constexpr float C2 = 0.125f * 1.4426950408889634f;

typedef unsigned short bf16;
typedef unsigned v4u __attribute__((ext_vector_type(4)));
typedef unsigned v2u __attribute__((ext_vector_type(2)));
typedef float f32x4 __attribute__((ext_vector_type(4)));
#define LAS __attribute__((address_space(3)))
#define GAS __attribute__((address_space(1)))
typedef GAS unsigned gu32;
#define RLX_AGENT __ATOMIC_RELAXED, __HIP_MEMORY_SCOPE_AGENT

constexpr size_t MiB = 1u << 20;
constexpr size_t WS_CTL = 0, CTL_ZERO_BYTES = 1 * MiB;
constexpr size_t WS_MODS = 1 * MiB;
constexpr size_t WS_ROPE = WS_MODS + 512 * 1024;
constexpr size_t WS_LR = WS_ROPE + 1 * MiB;
constexpr size_t WS_XCUR = 3 * MiB;
constexpr size_t SZ_XCUR = (size_t)M * D * 4;
constexpr size_t WS_WIN = WS_XCUR + SZ_XCUR;
constexpr size_t WS_WOUT = WS_WIN + (size_t)NINP * D * 2;
constexpr size_t WS_WUP = WS_WOUT + (size_t)D * D * 2;
constexpr size_t WS_WDN = WS_WUP + (size_t)DFF2 * D * 2;
constexpr size_t WS_AR = WS_WDN + (size_t)D * DFF * 2;
constexpr size_t SZ_BF_MD = (size_t)M * D * 2;
constexpr size_t SZ_BF_M256 = (size_t)M * 256 * 2;
constexpr size_t AR_XN = 0;
constexpr size_t AR_Y = 0;
constexpr size_t AR_U = AR_XN + SZ_BF_MD;
constexpr size_t AR_MIXO = AR_U;
constexpr size_t AR_R = AR_U + (size_t)M * NINP * 2;
constexpr size_t AR_V = AR_R + SZ_BF_M256;
constexpr size_t AR_KK = AR_V + SZ_BF_M256;
constexpr size_t AR_G = AR_KK + SZ_BF_M256;
constexpr size_t AR_KE = AR_G + SZ_BF_M256;
constexpr size_t AR_KKA = AR_KE + 2 * SZ_BF_M256;
constexpr size_t AR_W = AR_KKA + 2 * SZ_BF_M256;
constexpr size_t AR_MIX = AR_W + (size_t)2 * M * 256 * 4;
constexpr size_t AR_QKV = AR_MIX + SZ_BF_MD;
constexpr int QKVP = 768;
constexpr size_t AR_END1 = AR_QKV + (size_t)M * QKVP * 2;
constexpr size_t AR_ACT = 0;
constexpr size_t AR_H = AR_ACT + (size_t)M * DFF * 2;
constexpr size_t AR_FO = AR_H;
constexpr size_t AR_PART = AR_H + (size_t)M * D * 4;
constexpr size_t AR_END2 = AR_H + (size_t)M * DFF2 * 2;
constexpr size_t WS_END = WS_AR + (AR_END1 > AR_END2 ? AR_END1 : AR_END2);
static_assert(WS_END <= 384 * MiB, "workspace budget");
constexpr int CW_BAR = 4096;

constexpr int LDS_BYTES = 147456;
constexpr int RING_BYTES = 131072, LDSCTL_OFF = RING_BYTES, MISC_OFF = LDSCTL_OFF + 320;

typedef float cvt_f32x2 __attribute__((ext_vector_type(2))); typedef __bf16 cvt_bf16x2 __attribute__((ext_vector_type(2)));
__device__ __forceinline__ unsigned pk2(float lo, float hi) { cvt_f32x2 v = {lo, hi}; cvt_bf16x2 b = __builtin_convertvector(v, cvt_bf16x2); return __builtin_bit_cast(unsigned, b); }
__device__ __forceinline__ unsigned f2bf(float f) { return pk2(f, f) & 0xffffu; }
__device__ __forceinline__ float bf2f(unsigned short b) { return __builtin_bit_cast(float, ((unsigned)b) << 16); }
__device__ __forceinline__ float bflo(unsigned w) { return __builtin_bit_cast(float, w << 16); }
__device__ __forceinline__ float bfhi(unsigned w) { return __builtin_bit_cast(float, w & 0xffff0000u); }
__device__ __forceinline__ float sigm(float x) { return __builtin_amdgcn_rcpf(1.f + __expf(-x)); }
#define LDS_WAIT() asm volatile("s_waitcnt lgkmcnt(0)" ::: "memory")
#define LDS_BARRIER() do { asm volatile("s_waitcnt lgkmcnt(0)" ::: "memory"); __builtin_amdgcn_s_barrier(); asm volatile("" ::: "memory"); } while (0)
__device__ __forceinline__ float red16(float x) {
    float r;
    asm("s_nop 1\n\tv_add_f32_dpp %0, %1, %1 quad_perm:[1,0,3,2] row_mask:0xf bank_mask:0xf\n\ts_nop 1\n\t"
        "v_add_f32_dpp %0, %0, %0 quad_perm:[2,3,0,1] row_mask:0xf bank_mask:0xf\n\ts_nop 1\n\t"
        "v_add_f32_dpp %0, %0, %0 row_half_mirror row_mask:0xf bank_mask:0xf\n\ts_nop 1\n\t"
        "v_add_f32_dpp %0, %0, %0 row_mirror row_mask:0xf bank_mask:0xf\n\ts_nop 0" : "=&v"(r) : "v"(x));
    return r;
}
__device__ __forceinline__ float sum8(float x) {
    float r;
    asm("s_nop 1\n\tv_add_f32_dpp %0, %1, %1 quad_perm:[1,0,3,2] row_mask:0xf bank_mask:0xf\n\ts_nop 1\n\t"
        "v_add_f32_dpp %0, %0, %0 quad_perm:[2,3,0,1] row_mask:0xf bank_mask:0xf\n\ts_nop 1\n\t"
        "v_add_f32_dpp %0, %0, %0 row_half_mirror row_mask:0xf bank_mask:0xf\n\ts_nop 0" : "=&v"(r) : "v"(x));
    return r;
}
__device__ __forceinline__ float wave_sum(float v) { v = red16(v); v += __shfl_xor(v, 16); v += __shfl_xor(v, 32); return v; }

#define XB_TMO      128
#define XB_XCNT(j)  (256  + 64 * (j))
#define XB_XSUB(j)  (1280 + 64 * (j))
#define XB_XGEN(j)  (2304 + 64 * (j))
#define XB_TOP      3328
#define XB_TOPGEN   3392
#define XCD_BAR_WORDS 3456
#define XB_SPIN_CAP (1u << 18)
__device__ __forceinline__ unsigned xb_ld(unsigned* p)              { return __hip_atomic_load(p, __ATOMIC_RELAXED, __HIP_MEMORY_SCOPE_AGENT); }
__device__ __forceinline__ unsigned xb_add(unsigned* p, unsigned v) { return __hip_atomic_fetch_add(p, v, __ATOMIC_RELAXED, __HIP_MEMORY_SCOPE_AGENT); }
__device__ __forceinline__ unsigned xb_xcc_id() { return (unsigned)__builtin_amdgcn_s_getreg((3 << 11) | 20) & 0xFu; }
#define XB_SPIN(cond, bar) do { unsigned _sp = 0; while (cond) { __builtin_amdgcn_s_sleep(1); \
    if ((++_sp & 255u) == 0u) { if (xb_ld(&(bar)[XB_TMO])) break; if (_sp > XB_SPIN_CAP) { atomicAdd(&(bar)[XB_TMO], 1u); break; } } } } while (0)
struct XcdBarrier { unsigned* bar; unsigned x; volatile LAS unsigned* st; };
__device__ __forceinline__ XcdBarrier xcd_barrier_post(unsigned* bar, volatile LAS unsigned* st) {
    XcdBarrier b; b.bar = bar; b.x = xb_xcc_id(); b.st = st;
    if (threadIdx.x == 0) (void)xb_add(&bar[XB_XCNT(b.x)], 1u);
    return b;
}
__device__ __forceinline__ void xcd_barrier_complete(unsigned* bar, unsigned x, unsigned& nloc, unsigned& nx) {
    const unsigned G = gridDim.x * gridDim.y * gridDim.z;
    unsigned sum, cnt, mine, sp = 0u;
    for (;;) {
        sum = 0u; cnt = 0u; mine = 0u;
#pragma unroll
        for (unsigned j = 0; j < 16; ++j) { const unsigned c = xb_ld(&bar[XB_XCNT(j)]); sum += c; cnt += (c > 0u) ? 1u : 0u; mine = (j == x) ? c : mine; }
        if (sum == G) break;
        __builtin_amdgcn_s_sleep(1);
        if ((++sp & 255u) == 0u) { if (xb_ld(&bar[XB_TMO])) break; if (sp > XB_SPIN_CAP) { atomicAdd(&bar[XB_TMO], 1u); break; } }
    }
    nloc = mine > 0u ? mine : 1u; nx = cnt > 0u ? cnt : 1u;
}
__device__ __forceinline__ void xcd_barrier(const XcdBarrier& b) {
    asm volatile("s_waitcnt vmcnt(0)" ::: "memory");
    __syncthreads();
    if (threadIdx.x == 0) {
        unsigned* bar = b.bar;
        __builtin_amdgcn_s_waitcnt(0);
        unsigned nloc = b.st[0], nx = b.st[1];
        if (nloc == 0u) { xcd_barrier_complete(bar, b.x, nloc, nx); b.st[0] = nloc; b.st[1] = nx; }
        const unsigned old = xb_add(&bar[XB_XSUB(b.x)], 1u);
        const unsigned gen = old / nloc;
        if (old + 1u == (gen + 1u) * nloc) {
            __builtin_amdgcn_fence(__ATOMIC_RELEASE, "agent");
            asm volatile("s_waitcnt vmcnt(0)" ::: "memory");
            const unsigned og = xb_add(&bar[XB_TOP], 1u);
            const unsigned tg = og / nx;
            if (og + 1u == (tg + 1u) * nx) xb_add(&bar[XB_TOPGEN], 1u);
            else XB_SPIN(xb_ld(&bar[XB_TOPGEN]) == tg, bar);
            __builtin_amdgcn_fence(__ATOMIC_ACQUIRE, "agent");
            xb_add(&bar[XB_XGEN(b.x)], 1u);
            asm volatile("s_waitcnt vmcnt(0)" ::: "memory");
        } else {
            XB_SPIN(xb_ld(&bar[XB_XGEN(b.x)]) == gen, bar);
            __builtin_amdgcn_fence(__ATOMIC_ACQUIRE, "agent");
            asm volatile("s_waitcnt vmcnt(0)" ::: "memory");
        }
    }
    __syncthreads();
}

struct Args {
    const float* in[29];
    float* out; unsigned char* ws;
    int ph_lo, ph_hi;
};
enum { I_X = 0, I_C, I_CTX, I_CCTX, I_ADAW, I_ADAB, I_NMPRE, I_NMPOST, I_NFPRE, I_NFPOST, I_WIN, I_WOUT, I_QN, I_KN, I_MU, I_W0, I_WUP, I_A0, I_AUP, I_GUP,
       I_KK, I_KA, I_RK, I_LNW, I_LNB, I_SCW, I_FUP, I_FCONV, I_FDN };

struct Frame {
    LAS unsigned char* lds;
    int tid, lane, wave, bid, G;
    unsigned char* ws;
    float* out;
};
constexpr int PTR_OFF = LDSCTL_OFF + 1024;
#define INP(i) ((const float*)(const GAS float*)(((const unsigned long long LAS*)(F.lds + PTR_OFF))[i]))

__device__ __forceinline__ void transpose_item(const float* W, int K, int N, bf16* WT, LAS float* scr, int item, int lane) {
    const int nblk = N / 32, kb = item / nblk, nb = item % nblk, k0 = 64 * kb, n0 = 32 * nb;
#pragma unroll 8
    for (int i = 0; i < 32; ++i) { const int kk = 2 * i + (lane >> 5); scr[kk * 33 + (lane & 31)] = W[(size_t)(k0 + kk) * N + n0 + (lane & 31)]; }
    LDS_WAIT(); asm volatile("" ::: "memory");
    const int c = lane & 7;
#pragma unroll
    for (int j = 0; j < 4; ++j) { const int n = (lane >> 3) + 8 * j; const LAS float* s = scr + (8 * c) * 33 + n;
        v4u o; o.x = pk2(s[0 * 33], s[1 * 33]); o.y = pk2(s[2 * 33], s[3 * 33]); o.z = pk2(s[4 * 33], s[5 * 33]); o.w = pk2(s[6 * 33], s[7 * 33]);
        *(v4u*)(WT + (size_t)(n0 + n) * K + k0 + 8 * c) = o; }
    LDS_WAIT(); asm volatile("" ::: "memory");
}
__device__ __forceinline__ void convert_weights(const Frame& F, int l) {
    LAS float* scr = (LAS float*)(F.lds + F.wave * 8448);
    const int gw = F.bid * NWAVES + F.wave, NGW = F.G * NWAVES;
    const float* w_in = INP(I_WIN) + (size_t)l * D * NIN; const float* w_out = INP(I_WOUT) + (size_t)l * D * D;
    const float* w_up = INP(I_FUP) + (size_t)l * D * DFF2; const float* w_dn = INP(I_FDN) + (size_t)l * DFF * D;
    bf16* t_in = (bf16*)(F.ws + WS_WIN); bf16* t_out = (bf16*)(F.ws + WS_WOUT); bf16* t_up = (bf16*)(F.ws + WS_WUP); bf16* t_dn = (bf16*)(F.ws + WS_WDN);
    constexpr int I_1 = (D / 64) * (NIN / 32), I_2 = (D / 64) * (D / 32), I_3 = (D / 64) * (DFF2 / 32), I_4 = (DFF / 64) * (D / 32);
    for (int it = gw; it < I_1 + I_2 + I_3 + I_4; it += NGW) {
        int r = it;
        if (r < I_1) { transpose_item(w_in, D, NIN, t_in, scr, r, F.lane); continue; } r -= I_1;
        if (r < I_2) { transpose_item(w_out, D, D, t_out, scr, r, F.lane); continue; } r -= I_2;
        if (r < I_3) { transpose_item(w_up, D, DFF2, t_up, scr, r, F.lane); continue; } r -= I_3;
        transpose_item(w_dn, DFF, D, t_dn, scr, r, F.lane);
    }
    {
        const float* wup = INP(I_WUP) + (size_t)l * 2 * 64 * 256; const float* aup = INP(I_AUP) + (size_t)l * 2 * 64 * 256; const float* gup = INP(I_GUP) + (size_t)l * 128 * 256;
        bf16* lr = (bf16*)(F.ws + WS_LR);
        for (int it = gw; it < 48; it += NGW) {
            if (it < 16) transpose_item(wup + (size_t)(it >> 3) * 64 * 256, 64, 256, lr + (size_t)(it >> 3) * 256 * 64, scr, it & 7, F.lane);
            else if (it < 32) transpose_item(aup + (size_t)((it - 16) >> 3) * 64 * 256, 64, 256, lr + 2 * 256 * 64 + (size_t)((it - 16) >> 3) * 256 * 64, scr, it & 7, F.lane);
            else transpose_item(gup, 128, 256, lr + 4 * 256 * 64, scr, it - 32, F.lane);
        }
    }
    v4u z = {0u, 0u, 0u, 0u};
    for (int i = F.bid * NTHR + F.tid; i < (NINP - NIN) * D / 8; i += F.G * NTHR) *(v4u*)(t_in + (size_t)NIN * D + (size_t)i * 8) = z;
}

__device__ __forceinline__ void phase_pro_a(const Frame& F) {
    convert_weights(F, 0);
    __syncthreads();
    float* rope = (float*)(F.ws + WS_ROPE);
    for (int e = F.bid * NTHR + F.tid; e < TL * 32; e += F.G * NTHR) {
        const int pos = e >> 5, i = e & 31;
        const float inv = powf(10000.0f, -(float)(i & 15) / 16.0f);
        const float p = (i < 16) ? (float)(pos / 64) : (float)(pos % 64);
        const float ang = p * inv;
        rope[2 * e] = cosf(ang); rope[2 * e + 1] = sinf(ang);
    }
    LAS float* sc = (LAS float*)F.lds;
    LAS float* red = (LAS float*)(F.lds + 20480);
    for (int i = F.tid; i < 5 * 1024; i += NTHR) { const int r = i >> 10, k = i & 1023; const float v = r < 4 ? INP(I_C)[r * 1024 + k] : INP(I_CCTX)[k]; sc[i] = v / (1.f + expf(-v)); }
    __syncthreads();
    float* mods = (float*)(F.ws + WS_MODS);
    for (int item = F.bid; item < NL * 96; item += F.G) {
        const int l = item / 96, jg = item % 96;
        const int c4 = (F.lane & 15) * 4, kq = F.lane >> 4;
        const float* w = INP(I_ADAW) + (size_t)l * 1024 * 6144 + jg * 64 + c4;
        f32x4 a0 = {0.f, 0.f, 0.f, 0.f}, a1 = a0, a2 = a0, a3 = a0, a4 = a0;
        const int kb = F.wave * 128;
#pragma unroll 8
        for (int i = 0; i < 32; ++i) { const int k = kb + 4 * i + kq; const f32x4 wv = *(const f32x4*)(w + (size_t)k * 6144);
            a0 += wv * sc[k]; a1 += wv * sc[1024 + k]; a2 += wv * sc[2048 + k]; a3 += wv * sc[3072 + k]; a4 += wv * sc[4096 + k]; }
#pragma unroll
        for (int e = 0; e < 4; ++e) {
            a0[e] += __shfl_xor(a0[e], 16); a0[e] += __shfl_xor(a0[e], 32); a1[e] += __shfl_xor(a1[e], 16); a1[e] += __shfl_xor(a1[e], 32);
            a2[e] += __shfl_xor(a2[e], 16); a2[e] += __shfl_xor(a2[e], 32); a3[e] += __shfl_xor(a3[e], 16); a3[e] += __shfl_xor(a3[e], 32);
            a4[e] += __shfl_xor(a4[e], 16); a4[e] += __shfl_xor(a4[e], 32); }
        if (kq == 0) {
            *(LAS f32x4*)(red + (F.wave * 5 + 0) * 64 + c4) = a0; *(LAS f32x4*)(red + (F.wave * 5 + 1) * 64 + c4) = a1; *(LAS f32x4*)(red + (F.wave * 5 + 2) * 64 + c4) = a2;
            *(LAS f32x4*)(red + (F.wave * 5 + 3) * 64 + c4) = a3; *(LAS f32x4*)(red + (F.wave * 5 + 4) * 64 + c4) = a4; }
        __syncthreads();
        if (F.tid < 320) { const int r = F.tid >> 6, j = F.tid & 63; float s_ = 0.f;
#pragma unroll
            for (int w8 = 0; w8 < 8; ++w8) s_ += red[(w8 * 5 + r) * 64 + j];
            mods[((size_t)l * 5 + r) * 6144 + jg * 64 + j] = s_ + INP(I_ADAB)[l * 6144 + jg * 64 + j]; }
        __syncthreads();
    }
}

__device__ __forceinline__ void norm_phase(const Frame& F, int mode, const float* o, const float* g_post, int lmod_gate, int i_gate,
                                           const float* g_next, int lmod_next, int i_shift, int i_scale, int nks  ) {
    const int gw = F.bid * NWAVES + F.wave, NGW = F.G * NWAVES;
    float* xcur = (float*)(F.ws + WS_XCUR); bf16* xn = (bf16*)(F.ws + WS_AR + AR_XN);
    const float* mods = (const float*)(F.ws + WS_MODS);
    const int b = gw & 3, w4 = gw >> 2, NW4 = NGW >> 2;
    f32x4 c_gp[4], c_gt[4], c_gn[4], c_sh[4], c_sc[4];
#pragma unroll
    for (int j = 0; j < 4; ++j) { const int c0 = 4 * F.lane + 256 * j; const f32x4 z4 = {0.f, 0.f, 0.f, 0.f};
        c_gp[j] = mode >= 1 ? *(const f32x4*)(g_post + c0) : z4; c_gt[j] = mode >= 1 ? *(const f32x4*)(mods + ((size_t)lmod_gate * 5 + b) * 6144 + i_gate * 1024 + c0) : z4;
        c_gn[j] = mode <= 1 ? *(const f32x4*)(g_next + c0) : z4;
        c_sh[j] = mode <= 1 ? *(const f32x4*)(mods + ((size_t)lmod_next * 5 + b) * 6144 + i_shift * 1024 + c0) : z4;
        c_sc[j] = mode <= 1 ? *(const f32x4*)(mods + ((size_t)lmod_next * 5 + b) * 6144 + i_scale * 1024 + c0) : z4; }
    for (int s0_ = w4; s0_ < SB; s0_ += 2 * NW4) {
        f32x4 x[2][4]; bool val[2], ctxr[2]; int mrow[2], srow[2];
#pragma unroll
        for (int u = 0; u < 2; ++u) { srow[u] = s0_ + u * NW4; val[u] = srow[u] < SB; if (!val[u]) srow[u] = s0_; mrow[u] = b * SB + srow[u]; ctxr[u] = srow[u] < CT; }
        if (mode == 0) {
#pragma unroll
            for (int u = 0; u < 2; ++u) { const int s = srow[u];
                const float* src = ctxr[u] ? INP(I_CTX) + ((size_t)b * CT + s) * D : INP(I_X) + ((size_t)b * TL + (s - CT)) * D;
#pragma unroll
                for (int j = 0; j < 4; ++j) x[u][j] = *(const f32x4*)(src + 4 * F.lane + 256 * j); }
        } else {
            f32x4 ov[2][4], xv[2][4]; float ss[2] = {0.f, 0.f};
#pragma unroll
            for (int u = 0; u < 2; ++u)
#pragma unroll
                for (int j = 0; j < 4; ++j) xv[u][j] = *(const f32x4*)(xcur + (size_t)mrow[u] * D + 4 * F.lane + 256 * j);
#pragma unroll
            for (int u = 0; u < 2; ++u)
#pragma unroll
                for (int j = 0; j < 4; ++j) {
                    if (ctxr[u]) { const float* pp = (const float*)(F.ws + WS_AR + AR_PART) + ((size_t)b * 256 + srow[u]) * D + 4 * F.lane + 256 * j; f32x4 a = {0.f, 0.f, 0.f, 0.f};
                        for (int ks = 0; ks < nks; ++ks) a += *(const f32x4*)(pp + (size_t)ks * 4 * 256 * D);
                        ov[u][j] = a; }
                    else { const v2u w_ = *(const v2u*)((const bf16*)o + (size_t)mrow[u] * D + 4 * F.lane + 256 * j); ov[u][j] = (f32x4){bflo(w_.x), bfhi(w_.x), bflo(w_.y), bfhi(w_.y)}; }
                    ss[u] += ov[u][j][0] * ov[u][j][0] + ov[u][j][1] * ov[u][j][1] + ov[u][j][2] * ov[u][j][2] + ov[u][j][3] * ov[u][j][3]; }
#pragma unroll
            for (int u = 0; u < 2; ++u) { ss[u] = wave_sum(ss[u]);
                const float rs = rsqrtf(ss[u] * (1.f / D) + NORM_EPS);
#pragma unroll
                for (int j = 0; j < 4; ++j) { const int c0 = 4 * F.lane + 256 * j;
                    const f32x4 gt = ctxr[u] ? *(const f32x4*)(mods + ((size_t)lmod_gate * 5 + 4) * 6144 + i_gate * 1024 + c0) : c_gt[j];
                    x[u][j] = xv[u][j] + gt * (ov[u][j] * rs * c_gp[j]); } }
        }
        if (mode == 2) {
#pragma unroll
            for (int u = 0; u < 2; ++u) if (val[u] && !ctxr[u]) {
#pragma unroll
                for (int j = 0; j < 4; ++j) *(f32x4*)(F.out + ((size_t)b * TL + (srow[u] - CT)) * D + 4 * F.lane + 256 * j) = x[u][j]; }
            continue;
        }
#pragma unroll
        for (int u = 0; u < 2; ++u) {
            float ss = 0.f;
#pragma unroll
            for (int j = 0; j < 4; ++j) { if (val[u]) *(f32x4*)(xcur + (size_t)mrow[u] * D + 4 * F.lane + 256 * j) = x[u][j]; ss += x[u][j][0] * x[u][j][0] + x[u][j][1] * x[u][j][1] + x[u][j][2] * x[u][j][2] + x[u][j][3] * x[u][j][3]; }
            ss = wave_sum(ss);
            const float rs = rsqrtf(ss * (1.f / D) + NORM_EPS);
#pragma unroll
            for (int j = 0; j < 4; ++j) { const int c0 = 4 * F.lane + 256 * j;
                const f32x4 sh = ctxr[u] ? *(const f32x4*)(mods + ((size_t)lmod_next * 5 + 4) * 6144 + i_shift * 1024 + c0) : c_sh[j];
                const f32x4 scl = ctxr[u] ? *(const f32x4*)(mods + ((size_t)lmod_next * 5 + 4) * 6144 + i_scale * 1024 + c0) : c_sc[j];
                const f32x4 y = x[u][j] * rs * c_gn[j] * (scl + 1.f) + sh;
                v2u w; w.x = pk2(y[0], y[1]); w.y = pk2(y[2], y[3]);
                if (val[u]) *(v2u*)(xn + (size_t)mrow[u] * D + c0) = w; }
        }
    }
}

typedef short pbf16x8 __attribute__((ext_vector_type(8)));
constexpr int PZ_LD = 1156  , PA_LD = 136, P_TH = 16 * PZ_LD * 4, P_AD = P_TH + 16 * PA_LD * 2, P_SG = P_AD + 16 * PA_LD * 2, P_KN = P_SG + 16 * PA_LD * 2;
__device__ __forceinline__ void unpack8(const v4u& w, float (&x)[8]) {
#pragma unroll
    for (int q = 0; q < 4; ++q) { x[2 * q] = bflo(w[q]); x[2 * q + 1] = bfhi(w[q]); }
}
__device__ __forceinline__ v4u pack8(const float (&x)[8]) { v4u w;
#pragma unroll
    for (int q = 0; q < 4; ++q) w[q] = pk2(x[2 * q], x[2 * q + 1]);
    return w; }
__device__ __forceinline__ void prep_phase(const Frame& F, int l) {
    LAS float* ZS = (LAS float*)F.lds;
    LAS bf16* TH = (LAS bf16*)(F.lds + P_TH); LAS bf16* AD = (LAS bf16*)(F.lds + P_AD); LAS bf16* SG = (LAS bf16*)(F.lds + P_SG);
    LAS float* KN = (LAS float*)(F.lds + P_KN);
    const bf16* U = (const bf16*)(F.ws + WS_AR + AR_U);
    bf16* QKV = (bf16*)(F.ws + WS_AR + AR_QKV);
    const float* rope = (const float*)(F.ws + WS_ROPE);
    const float* qn = INP(I_QN) + l * 64; const float* kn = INP(I_KN) + l * 64;
    const float* mu = INP(I_MU) + (size_t)l * 2 * R_IN;
    const float* w0 = INP(I_W0) + l * 512; const float* a0 = INP(I_A0) + l * 512;
    const float* k_k = INP(I_KK) + l * 256; const float* k_a = INP(I_KA) + l * 256;
    const float* scw = INP(I_SCW) + (size_t)l * 3 * 256;
    const bf16* lr = (const bf16*)(F.ws + WS_LR);
    bf16* R_o = (bf16*)(F.ws + WS_AR + AR_R); bf16* V_o = (bf16*)(F.ws + WS_AR + AR_V); bf16* KK_o = (bf16*)(F.ws + WS_AR + AR_KK); bf16* G_o = (bf16*)(F.ws + WS_AR + AR_G);
    bf16* KE_o = (bf16*)(F.ws + WS_AR + AR_KE); bf16* KKA_o = (bf16*)(F.ws + WS_AR + AR_KKA); float* W_o = (float*)(F.ws + WS_AR + AR_W);
    bf16* MIX = (bf16*)(F.ws + WS_AR + AR_MIX);
    const int lane = F.lane, wv = F.wave, tid = F.tid, fr = lane & 15, fq = lane >> 4;
    LAS float* CM = (LAS float*)(F.lds + P_KN + 256); LAS float* CP = CM + 2 * R_IN; LAS float* CS = CP + 6 * 256; LAS float* CG = CS + 3 * 256;
    for (int i = tid; i < 2 * R_IN; i += NTHR) CM[i] = mu[i];
    for (int i = tid; i < 256; i += NTHR) { CP[i] = k_k[i]; CP[256 + i] = k_a[i]; CP[512 + i] = w0[i]; CP[768 + i] = w0[256 + i]; CP[1024 + i] = a0[i]; CP[1280 + i] = a0[256 + i]; }
    for (int i = tid; i < 768; i += NTHR) CS[i] = scw[i];
    if (tid < 64) { CG[tid] = qn[tid]; CG[64 + tid] = kn[tid]; }
    __syncthreads();
    const bool bact = tid < 432; const int bch = bact ? tid % 144 : 0, btq = bact ? tid / 144 : 0, bc0 = bch * 8;
    const bool bisk = bact && bc0 >= 256 && bc0 < 512;
    const int ad0 = (lane & 7) * 8;
    const int dc0 = (tid & 31) * 8;
    const bool xaff = F.G == 256;
    for (int it_ = xaff ? ((F.bid >> 3) + 32 * (F.bid & 1)) : F.bid; it_ < (xaff ? SB / 16 : M / 16); it_ += (xaff ? 64 : F.G)) {
        const int item = xaff ? ((F.bid & 7) >> 1) * (SB / 16) + it_ : it_;
        const int m0 = item * 16, s0 = m0 % SB;
        const bool isctx = s0 < CT; const int seq_lo = isctx ? 0 : CT, seq_hi = isctx ? CT : SB;
        SUBT(0);
        v4u araw[2][2], avc[2]; f32x4 arp[2][4];
#pragma unroll
        for (int rr = 0; rr < 2; ++rr) { const int t = 2 * wv + rr; const bf16* ur = U + (size_t)(m0 + t) * NINP;
            araw[rr][0] = *(const v4u*)(ur + 8 * lane); araw[rr][1] = *(const v4u*)(ur + K_OFF + 8 * (lane & 15)); avc[rr] = *(const v4u*)(ur + V_OFF + 8 * (lane & 15));
            const int pos = isctx ? 0 : (s0 + t - CT); const float* rp = rope + ((size_t)pos * 32 + (ad0 & 31)) * 2;
#pragma unroll
            for (int e = 0; e < 4; ++e) arp[rr][e] = *(const f32x4*)(rp + 4 * e); }
        v4u dbg, dcg[3], dxc[3];
        { const int t = tid >> 5, s = s0 + t; const bf16* u = U + (size_t)(m0 + t) * NINP + C_OFF + dc0;
          const int dp = s > seq_lo ? -NINP : 0, dn = s < seq_hi - 1 ? NINP : 0;
          dbg = *(const v4u*)u; dcg[1] = *(const v4u*)(u + 256); dxc[1] = *(const v4u*)(u + 512);
          dcg[0] = *(const v4u*)(u + dp + 256); dxc[0] = *(const v4u*)(u + dp + 512); dcg[2] = *(const v4u*)(u + dn + 256); dxc[2] = *(const v4u*)(u + dn + 512); }
#pragma unroll
        for (int rr = 0; rr < 2; ++rr) {
            const int t = 2 * wv + rr, m = m0 + t;
            bf16* orow = QKV + (size_t)m * QKVP;
#pragma unroll
            for (int pass = 0; pass < 2; ++pass) {
                const bool act = pass == 0 || lane < 16;
                const int col = (pass == 0 ? 0 : K_OFF) + 8 * lane;
                float x[8]; unpack8(araw[rr][pass], x);
                float ss = 0.f;
#pragma unroll
                for (int e = 0; e < 8; ++e) ss += x[e] * x[e];
                ss = sum8(ss);
                const float rs = rsqrtf(ss * (1.f / 64.f) + NORM_EPS);
                const f32x4 g0 = *(const LAS f32x4*)(CG + pass * 64 + ad0), g1 = *(const LAS f32x4*)(CG + pass * 64 + ad0 + 4);
                float y[8];
#pragma unroll
                for (int e = 0; e < 4; ++e) { y[e] = x[e] * rs * g0[e]; y[4 + e] = x[4 + e] * rs * g1[e]; }
                float yp[8];
#pragma unroll
                for (int e = 0; e < 8; ++e) yp[e] = __shfl_xor(y[e], 4);
                if (!isctx) {
                    const bool lo_half = ad0 < 32;
#pragma unroll
                    for (int e = 0; e < 8; e += 2) { const f32x4 cs = arp[rr][e >> 1];
                        y[e] = lo_half ? (y[e] * cs[0] - yp[e] * cs[1]) : (y[e] * cs[0] + yp[e] * cs[1]);
                        y[e + 1] = lo_half ? (y[e + 1] * cs[2] - yp[e + 1] * cs[3]) : (y[e + 1] * cs[2] + yp[e + 1] * cs[3]); }
                }
                if (pass == 0) {
#pragma unroll
                    for (int e = 0; e < 8; ++e) y[e] *= C2;
                }
                if (act) *(v4u*)(orow + col) = pack8(y);
            }
            if (lane < 16) *(v4u*)(orow + V_OFF + 8 * lane) = avc[rr];
        }
        SUBT(1);
        { const int t = tid >> 5, s = s0 + t;
          float bg[8], c1[8], x1[8], p[8], pp[8], pn[8];
          unpack8(dbg, bg); unpack8(dcg[1], c1); unpack8(dxc[1], x1);
#pragma unroll
          for (int e = 0; e < 8; ++e) p[e] = c1[e] * x1[e];
          unpack8(dcg[0], c1); unpack8(dxc[0], x1);
          const float mp = s > seq_lo ? 1.f : 0.f, mn = s < seq_hi - 1 ? 1.f : 0.f;
#pragma unroll
          for (int e = 0; e < 8; ++e) pp[e] = c1[e] * x1[e] * mp;
          unpack8(dcg[2], c1); unpack8(dxc[2], x1);
#pragma unroll
          for (int e = 0; e < 8; ++e) pn[e] = c1[e] * x1[e] * mn;
          float o[8];
#pragma unroll
          for (int e = 0; e < 8; ++e) o[e] = bg[e] * (pp[e] * CS[dc0 + e] + p[e] * CS[256 + dc0 + e] + pn[e] * CS[512 + dc0 + e]);
          *(v4u*)(MIX + (size_t)(m0 + t) * D + 768 + dc0) = pack8(o); }
        SUBT(2);
#pragma unroll 1
        for (int hb = 0; hb < 2; ++hb)
        { const int t0 = 6 * btq + 3 * hb, ntok = btq == 2 ? (hb == 0 ? 3 : 1) : 3;
          const f32x4 mu0a = *(const LAS f32x4*)(CM + bc0), mu0b = *(const LAS f32x4*)(CM + bc0 + 4), mu1a = *(const LAS f32x4*)(CM + R_IN + bc0), mu1b = *(const LAS f32x4*)(CM + R_IN + bc0 + 4);
          const f32x4 bkka = bisk ? *(const LAS f32x4*)(CP + bc0 - 256) : (f32x4){0.f, 0.f, 0.f, 0.f}, bkkb = bisk ? *(const LAS f32x4*)(CP + bc0 - 252) : (f32x4){0.f, 0.f, 0.f, 0.f};
          v4u rw[5];
#pragma unroll
          for (int jj = 0; jj < 5; ++jj) { int sr_ = s0 + t0 - 1 + jj; sr_ = sr_ < seq_lo ? seq_lo : (sr_ > seq_hi - 1 ? seq_hi - 1 : sr_);
              const int tt = sr_ - s0; const int tcl = tt > 16 ? 16 : tt;
              rw[jj] = *(const v4u*)(U + (unsigned)(m0 + tcl) * (unsigned)NINP + (unsigned)(R_OFF + bc0)); }
#pragma unroll
          for (int jj = 1; jj <= 3; ++jj) {
              const int t = t0 + jj - 1, s = s0 + t; const bool tv = bact && jj <= ntok;
              float z[8], pv[8], nx[8];
              unpack8(rw[jj], z); unpack8(rw[jj - 1], pv); unpack8(rw[jj + 1], nx);
              const float mp = s > seq_lo ? 1.f : 0.f, mn = s < seq_hi - 1 ? 1.f : 0.f;
#pragma unroll
              for (int e = 0; e < 4; ++e) { z[e] = z[e] + mu0a[e] * (pv[e] * mp - z[e]) + mu1a[e] * (nx[e] * mn - z[e]); z[4 + e] = z[4 + e] + mu0b[e] * (pv[4 + e] * mp - z[4 + e]) + mu1b[e] * (nx[4 + e] * mn - z[4 + e]); }
              if (tv) { *(LAS f32x4*)(ZS + t * PZ_LD + bc0) = (f32x4){z[0], z[1], z[2], z[3]}; *(LAS f32x4*)(ZS + t * PZ_LD + bc0 + 4) = (f32x4){z[4], z[5], z[6], z[7]}; }
              float ss = 0.f;
#pragma unroll
              for (int e = 0; e < 4; ++e) { const float u0 = z[e] * bkka[e], u1 = z[4 + e] * bkkb[e]; ss += u0 * u0 + u1 * u1; }
              ss = sum8(ss);
              if (tv && bisk && (bch & 7) == 0) KN[t * 4 + ((bc0 - 256) >> 6)] = rsqrtf(fmaxf(ss, 1e-12f));
              if (tv && bc0 >= 768) {
                  float q[8];
                  if (bc0 < 896) {
#pragma unroll
                      for (int e = 0; e < 8; ++e) q[e] = 1.f - 2.f * __builtin_amdgcn_rcpf(1.f + __expf(2.f * z[e]));
                      *(LAS v4u*)(TH + t * PA_LD + (bc0 - 768)) = pack8(q);
                  } else if (bc0 < 1024) { *(LAS v4u*)(AD + t * PA_LD + (bc0 - 896)) = pack8(z); }
                  else {
#pragma unroll
                      for (int e = 0; e < 8; ++e) q[e] = sigm(z[e]);
                      *(LAS v4u*)(SG + t * PA_LD + (bc0 - 1024)) = pack8(q);
                  }
              }
          } }
        SUBT(3);
        LDS_BARRIER();
        SUBT(4);
        pbf16x8 bwf[2][2][2], baf[2][2][2], bgf[2][4];
#pragma unroll
        for (int nt = 0; nt < 2; ++nt) { const int cw = 32 * wv + 16 * nt + fr;
#pragma unroll
            for (int d = 0; d < 2; ++d)
#pragma unroll
                for (int kb = 0; kb < 2; ++kb) { bwf[nt][d][kb] = *(const pbf16x8*)(lr + (size_t)d * 256 * 64 + (size_t)cw * 64 + kb * 32 + fq * 8);
                    baf[nt][d][kb] = *(const pbf16x8*)(lr + 2 * 256 * 64 + (size_t)d * 256 * 64 + (size_t)cw * 64 + kb * 32 + fq * 8); }
#pragma unroll
            for (int kb = 0; kb < 4; ++kb) bgf[nt][kb] = *(const pbf16x8*)(lr + 4 * 256 * 64 + (size_t)cw * 128 + kb * 32 + fq * 8); }
        { pbf16x8 tha[2][2], ada[2][2], sga[4];
#pragma unroll
          for (int d = 0; d < 2; ++d)
#pragma unroll
              for (int kb = 0; kb < 2; ++kb) { tha[d][kb] = *(const LAS pbf16x8*)(TH + fr * PA_LD + d * 64 + kb * 32 + fq * 8); ada[d][kb] = *(const LAS pbf16x8*)(AD + fr * PA_LD + d * 64 + kb * 32 + fq * 8); }
#pragma unroll
          for (int kb = 0; kb < 4; ++kb) sga[kb] = *(const LAS pbf16x8*)(SG + fr * PA_LD + kb * 32 + fq * 8);
#pragma unroll
          for (int nt = 0; nt < 2; ++nt) {
              const int n0 = 32 * wv + 16 * nt;
              f32x4 accW[2], accA[2], accG = {0.f, 0.f, 0.f, 0.f};
#pragma unroll
              for (int d = 0; d < 2; ++d) { accW[d] = (f32x4){0.f, 0.f, 0.f, 0.f}; accA[d] = (f32x4){0.f, 0.f, 0.f, 0.f};
#pragma unroll
                  for (int kb = 0; kb < 2; ++kb) {
                      accW[d] = __builtin_amdgcn_mfma_f32_16x16x32_bf16(bwf[nt][d][kb], tha[d][kb], accW[d], 0, 0, 0);
                      accA[d] = __builtin_amdgcn_mfma_f32_16x16x32_bf16(baf[nt][d][kb], ada[d][kb], accA[d], 0, 0, 0);
                  } }
#pragma unroll
              for (int kb = 0; kb < 4; ++kb) accG = __builtin_amdgcn_mfma_f32_16x16x32_bf16(bgf[nt][kb], sga[kb], accG, 0, 0, 0);
              const int t = fr, c0 = n0 + 4 * fq; const unsigned o = (unsigned)(m0 + t) * 256u + (unsigned)c0;
              const f32x4 kv = *(const LAS f32x4*)(ZS + t * PZ_LD + 256 + c0), rv = *(const LAS f32x4*)(ZS + t * PZ_LD + c0), vv = *(const LAS f32x4*)(ZS + t * PZ_LD + 512 + c0);
              const f32x4 kkc = *(const LAS f32x4*)(CP + c0), kac = *(const LAS f32x4*)(CP + 256 + c0), w00 = *(const LAS f32x4*)(CP + 512 + c0), w01 = *(const LAS f32x4*)(CP + 768 + c0), a00 = *(const LAS f32x4*)(CP + 1024 + c0), a01 = *(const LAS f32x4*)(CP + 1280 + c0);
              const float knv = KN[t * 4 + (c0 >> 6)];
              f32x4 kk4, lw0, lw1, ke0, ke1, ka0, ka1;
#pragma unroll
              for (int e = 0; e < 4; ++e) { kk4[e] = kv[e] * kkc[e] * knv;
                  lw0[e] = -DECAY_SCALE * sigm(accW[0][e] + w00[e]); lw1[e] = -DECAY_SCALE * sigm(accW[1][e] + w01[e]);
                  const float av0 = sigm(accA[0][e] + a00[e]), av1 = sigm(accA[1][e] + a01[e]);
                  ke0[e] = kv[e] * (1.f + (av0 - 1.f) * kac[e]); ke1[e] = kv[e] * (1.f + (av1 - 1.f) * kac[e]); ka0[e] = kk4[e] * av0; ka1[e] = kk4[e] * av1; }
#define ST4(P, V) do { v2u w_; w_.x = pk2((V)[0], (V)[1]); w_.y = pk2((V)[2], (V)[3]); *(v2u*)(P) = w_; } while (0)
              ST4(R_o + o, rv); ST4(V_o + o, vv); ST4(KK_o + o, kk4); ST4(G_o + o, accG);
              *(f32x4*)(W_o + o) = lw0; *(f32x4*)(W_o + (unsigned)(M * 256) + o) = lw1;
              ST4(KE_o + o, ke0); ST4(KE_o + (unsigned)(M * 256) + o, ke1); ST4(KKA_o + o, ka0); ST4(KKA_o + (unsigned)(M * 256) + o, ka1);
#undef ST4
          } }
        SUBT(5);
        LDS_BARRIER();
        SUBT(6);
    }
}

__device__ __forceinline__ void rwkv_out_phase(const Frame& F, int l) {
    const float* Y = (const float*)(F.ws + WS_AR + AR_Y);
    const bf16* R_i = (const bf16*)(F.ws + WS_AR + AR_R); const bf16* V_i = (const bf16*)(F.ws + WS_AR + AR_V); const bf16* G_i = (const bf16*)(F.ws + WS_AR + AR_G);
    const bf16* KE_i = (const bf16*)(F.ws + WS_AR + AR_KE);
    bf16* MIX = (bf16*)(F.ws + WS_AR + AR_MIX);
    const int gw = F.bid * NWAVES + F.wave, NGW = F.G * NWAVES;
    const int c0 = 4 * F.lane;
    const f32x4 rk = *(const f32x4*)(INP(I_RK) + l * 256 + c0), lw = *(const f32x4*)(INP(I_LNW) + l * 256 + c0), lb = *(const f32x4*)(INP(I_LNB) + l * 256 + c0);
    for (int m = gw; m < M; m += NGW) {
        const unsigned o = (unsigned)m * 256u + (unsigned)c0;
        const f32x4 y0 = *(const f32x4*)(Y + o), y1 = *(const f32x4*)(Y + (unsigned)(M * 256) + o);
        const v2u rw_ = *(const v2u*)(R_i + o), vw = *(const v2u*)(V_i + o), gw_ = *(const v2u*)(G_i + o), k0 = *(const v2u*)(KE_i + o), k1 = *(const v2u*)(KE_i + (unsigned)(M * 256) + o);
        const f32x4 y = y0 + y1;
        const float mean = red16((y[0] + y[1]) + (y[2] + y[3])) * (1.f / 64.f);
        const f32x4 dl = y - mean;
        const float var = red16((dl[0] * dl[0] + dl[1] * dl[1]) + (dl[2] * dl[2] + dl[3] * dl[3])) * (1.f / 64.f);
        const float rs = rsqrtf(var + GN_EPS);
        const f32x4 rr = {bflo(rw_.x), bfhi(rw_.x), bflo(rw_.y), bfhi(rw_.y)}, vv = {bflo(vw.x), bfhi(vw.x), bflo(vw.y), bfhi(vw.y)}, gg = {bflo(gw_.x), bfhi(gw_.x), bflo(gw_.y), bfhi(gw_.y)};
        const f32x4 ke = (f32x4){bflo(k0.x), bfhi(k0.x), bflo(k0.y), bfhi(k0.y)} + (f32x4){bflo(k1.x), bfhi(k1.x), bflo(k1.y), bfhi(k1.y)};
        const f32x4 tt = rr * ke * rk;
        const float bon = red16((tt[0] + tt[1]) + (tt[2] + tt[3]));
        const f32x4 ov = (dl * rs * lw + lb + vv * bon) * gg;
        v2u w; w.x = pk2(ov[0], ov[1]); w.y = pk2(ov[2], ov[3]);
        *(v2u*)(MIX + (size_t)m * D + 512 + c0) = w;
    }
}

__device__ __forceinline__ void act_phase(const Frame& F, int l) {
    const bf16* H = (const bf16*)(F.ws + WS_AR + AR_H); bf16* ACT = (bf16*)(F.ws + WS_AR + AR_ACT);
    const float* wc = INP(I_FCONV) + (size_t)l * 3 * DFF2;
    constexpr int NCH = DFF / 8;
    const int nitems = (M / 8) * NCH;
    for (int it = F.bid * NTHR + F.tid; it < nitems; it += F.G * NTHR) {
        const int rg = it / NCH, ch = it % NCH, j0 = ch * 8, m0 = rg * 8, s0 = m0 % SB;
        const bool isctx = s0 < CT; const int seq_lo = isctx ? 0 : CT, seq_hi = isctx ? CT : SB;
        v4u gr[10], ur[10];
#pragma unroll
        for (int r = 0; r < 10; ++r) { int s = s0 - 1 + r; s = s < seq_lo ? seq_lo : (s > seq_hi - 1 ? seq_hi - 1 : s);
            const bf16* hr = H + (size_t)(m0 - s0 + s) * DFF2 + j0; gr[r] = *(const v4u*)hr; ur[r] = *(const v4u*)(hr + DFF); }
        { const v4u z4 = {0u, 0u, 0u, 0u};
          if (s0 <= seq_lo) { gr[0] = z4; ur[0] = z4; } if (s0 + 8 >= seq_hi) { gr[9] = z4; ur[9] = z4; } }
        float wg[3][8], wu[3][8];
#pragma unroll
        for (int tp = 0; tp < 3; ++tp) { const f32x4 a0 = *(const f32x4*)(wc + tp * DFF2 + j0), a1 = *(const f32x4*)(wc + tp * DFF2 + j0 + 4), b0 = *(const f32x4*)(wc + tp * DFF2 + DFF + j0), b1 = *(const f32x4*)(wc + tp * DFF2 + DFF + j0 + 4);
#pragma unroll
            for (int e = 0; e < 4; ++e) { wg[tp][e] = a0[e]; wg[tp][4 + e] = a1[e]; wu[tp][e] = b0[e]; wu[tp][4 + e] = b1[e]; } }
#pragma unroll
        for (int r = 0; r < 8; ++r) {
            const int s = s0 + r;
            v4u o;
#pragma unroll
            for (int q = 0; q < 4; ++q) {
                const float ga0 = bflo(gr[r][q]) * wg[0][2 * q] + bflo(gr[r + 1][q]) * wg[1][2 * q] + bflo(gr[r + 2][q]) * wg[2][2 * q];
                const float ga1 = bfhi(gr[r][q]) * wg[0][2 * q + 1] + bfhi(gr[r + 1][q]) * wg[1][2 * q + 1] + bfhi(gr[r + 2][q]) * wg[2][2 * q + 1];
                const float u0 = bflo(ur[r][q]) * wu[0][2 * q] + bflo(ur[r + 1][q]) * wu[1][2 * q] + bflo(ur[r + 2][q]) * wu[2][2 * q];
                const float u1 = bfhi(ur[r][q]) * wu[0][2 * q + 1] + bfhi(ur[r + 1][q]) * wu[1][2 * q + 1] + bfhi(ur[r + 2][q]) * wu[2][2 * q + 1];
                o[q] = pk2(ga0 * __builtin_amdgcn_rcpf(1.f + __expf(-ga0)) * u0, ga1 * __builtin_amdgcn_rcpf(1.f + __expf(-ga1)) * u1);
            }
            *(v4u*)(ACT + (size_t)(m0 + r) * DFF + j0) = o;
        }
    }
}

namespace attn_body {
using bf16=__hip_bfloat16;
using bf16x8=__attribute__((ext_vector_type(8)))short;
using s16x4=__attribute__((ext_vector_type(4)))short;
using f32x16=__attribute__((ext_vector_type(16)))float;
using u32x4=__attribute__((ext_vector_type(4)))unsigned;
constexpr int D=64,QP=768,OP=1024;
constexpr int NW=8,QBLK=32,QB=QBLK*NW,KVBLK=64;
constexpr int ATTN_UNIT_ROWS=QB;
__device__ __forceinline__ int crow(int r,int hi){return (r&3)+8*(r>>2)+4*hi;}
#define SBAR() __builtin_amdgcn_sched_barrier(0)
constexpr int NSLOT=3, SLOTB=8192;
constexpr int LDS_K=0, LDS_V=NSLOT*SLOTB, LDS_WS=2*NSLOT*SLOTB, LDS_OST=LDS_WS+NW*64*4, LDS_BYTES=LDS_OST+NW*4096;
__device__ __forceinline__ void glds16(const void*gsrc,unsigned lds_dst){unsigned keep;
  asm volatile("s_mov_b32 %0, m0\n\ts_mov_b32 m0, %2\n\ts_nop 0\n\tglobal_load_lds_dwordx4 %1, off\n\ts_mov_b32 m0, %0":"=&s"(keep):"v"(gsrc),"s"(lds_dst):"memory");}
__device__ __forceinline__ float max3f(float a,float b,float c){float r;asm("v_max3_f32 %0, %1, %2, %3":"=v"(r):"v"(a),"v"(b),"v"(c));return r;}
__device__ __forceinline__ float max2f(float a,float b){float r;asm("v_max_f32_e32 %0, %1, %2":"=v"(r):"v"(a),"v"(b));return r;}
__device__ __forceinline__ float fadd_s(float a,float b){float r;asm("v_add_f32_e32 %0, %1, %2":"=v"(r):"v"(a),"v"(b));return r;}
__device__ __forceinline__ float fsub_s(float a,float b){float r;asm("v_sub_f32_e32 %0, %1, %2":"=v"(r):"v"(a),"v"(b));return r;}
typedef float f32x2_t __attribute__((ext_vector_type(2))); typedef __bf16 bf16x2_t __attribute__((ext_vector_type(2)));
__device__ __forceinline__ unsigned cvtpk_s(float lo,float hi){f32x2_t v={lo,hi};bf16x2_t b=__builtin_convertvector(v,bf16x2_t);return __builtin_bit_cast(unsigned,b);}
#define WAIT_BAR(N) asm volatile("s_waitcnt vmcnt(" #N ") lgkmcnt(0)\n\ts_barrier":::"memory")

__device__ __forceinline__ void qkt(f32x16&p0,f32x16&p1,const char*Kslot,const bf16x8*qr,const f32x16&negm,int r32,int hi){
  const char*kb=Kslot+hi*1024+r32*16;
  #pragma unroll
  for(int d0=0;d0<4;++d0){
    const bf16x8 b0=*reinterpret_cast<const bf16x8*>(kb+d0*2048);
    const bf16x8 b1=*reinterpret_cast<const bf16x8*>(kb+d0*2048+512);
    if(d0==0){p0=__builtin_amdgcn_mfma_f32_32x32x16_bf16(b0,qr[0],negm,0,0,0);p1=__builtin_amdgcn_mfma_f32_32x32x16_bf16(b1,qr[0],negm,0,0,0);}
    else{p0=__builtin_amdgcn_mfma_f32_32x32x16_bf16(b0,qr[d0],p0,0,0,0);p1=__builtin_amdgcn_mfma_f32_32x32x16_bf16(b1,qr[d0],p1,0,0,0);}}
}
typedef __attribute__((address_space(3))) const char* lds_cptr;
typedef short v4i16_t __attribute__((ext_vector_type(4)));
__device__ __forceinline__ void kload8(bf16x8*kf,lds_cptr kp){
  kf[0]=*(const __attribute__((address_space(3))) bf16x8*)(kp);      kf[1]=*(const __attribute__((address_space(3))) bf16x8*)(kp+512);
  kf[2]=*(const __attribute__((address_space(3))) bf16x8*)(kp+2048); kf[3]=*(const __attribute__((address_space(3))) bf16x8*)(kp+2560);
  kf[4]=*(const __attribute__((address_space(3))) bf16x8*)(kp+4096); kf[5]=*(const __attribute__((address_space(3))) bf16x8*)(kp+4608);
  kf[6]=*(const __attribute__((address_space(3))) bf16x8*)(kp+6144); kf[7]=*(const __attribute__((address_space(3))) bf16x8*)(kp+6656);
}
__device__ __forceinline__ void kload2(bf16x8*kf,lds_cptr kp,int j){ kf[2*j]=*(const __attribute__((address_space(3))) bf16x8*)(kp+j*2048); kf[2*j+1]=*(const __attribute__((address_space(3))) bf16x8*)(kp+j*2048+512); }
__device__ __forceinline__ s16x4 vtr(lds_cptr p){ return __builtin_bit_cast(s16x4,__builtin_amdgcn_ds_read_tr16_b64_v4i16((__attribute__((address_space(3))) v4i16_t*)p)); }
__device__ __forceinline__ float rowmax(const f32x16&p0,const f32x16&p1){
  float a=max3f(p0[0],p0[1],p1[0]),b=max3f(p0[2],p0[3],p1[1]);a=max3f(a,p1[2],p1[3]);
  #pragma unroll
  for(int r=4;r<16;r+=4){a=max3f(a,p0[r],p0[r+1]);b=max3f(b,p0[r+2],p0[r+3]);a=max3f(a,p1[r],p1[r+1]);b=max3f(b,p1[r+2],p1[r+3]);}
  const float m=max2f(a,b);
  auto rr=__builtin_amdgcn_permlane32_swap(__float_as_uint(m),__float_as_uint(m),false,false);
  return max2f(__uint_as_float(rr[0]),__uint_as_float(rr[1]));
}
__device__ __forceinline__ void pv(f32x16*o,int vb,bf16x8 pa0,bf16x8 pa1,bf16x8 pa2,bf16x8 pa3){
  #pragma unroll
  for(int d0=0;d0<2;++d0){s16x4 lo[4],hi[4];
    #pragma unroll
    for(int ks=0;ks<4;++ks){
      asm volatile("ds_read_b64_tr_b16 %0,%1 offset:%c2":"=&v"(lo[ks]):"v"(vb),"i"(d0*4096+ks*1024):"memory");
      asm volatile("ds_read_b64_tr_b16 %0,%1 offset:%c2":"=&v"(hi[ks]):"v"(vb),"i"(d0*4096+ks*1024+512):"memory");}
    asm volatile("s_waitcnt lgkmcnt(0)":::"memory");SBAR();
    #define PK(k) (bf16x8){lo[k][0],lo[k][1],lo[k][2],lo[k][3],hi[k][0],hi[k][1],hi[k][2],hi[k][3]}
    o[d0]=__builtin_amdgcn_mfma_f32_32x32x16_bf16(pa0,PK(0),o[d0],0,0,0);
    o[d0]=__builtin_amdgcn_mfma_f32_32x32x16_bf16(pa1,PK(1),o[d0],0,0,0);
    o[d0]=__builtin_amdgcn_mfma_f32_32x32x16_bf16(pa2,PK(2),o[d0],0,0,0);
    o[d0]=__builtin_amdgcn_mfma_f32_32x32x16_bf16(pa3,PK(3),o[d0],0,0,0);
    #undef PK
  }
}

#ifndef ATTN_STORE16
#define ATTN_STORE16(p,v) (*(u32x4*)(p)=(v))
#endif
template<int THRL> __device__ __forceinline__ void attn_unit(const bf16*Qu,const bf16*__restrict__ Kh,const bf16*__restrict__ Vh,bf16*Ou,const int NT,char*shm){
  const int tid=threadIdx.x,lane=tid&63,r32=lane&31,hi=lane>>5; const int wid=__builtin_amdgcn_readfirstlane(tid>>6);
  const bf16*Qw=Qu+(long)(wid*QBLK)*QP;
  const unsigned lds0=(unsigned)(uintptr_t)shm;
  float*wsf=(float*)(shm+LDS_WS)+wid*64;
  const bf16*ksrc=Kh+(long)lane*QP+wid*8;
  const bf16*vsrc=Vh+(long)(16*(wid&3)+(lane>>2))*QP+(wid>>2)*32+(lane&3)*8;
  const unsigned kdst=lds0+LDS_K+wid*1024, vdst=lds0+LDS_V+wid*1024;
  #define DMA_K(t,slot) glds16(ksrc+(long)(t)*KVBLK*QP,(unsigned)__builtin_amdgcn_readfirstlane(kdst+(slot)))
  #define DMA_V(t,slot) glds16(vsrc+(long)(t)*KVBLK*QP,(unsigned)__builtin_amdgcn_readfirstlane(vdst+(slot)))
  const int vb0=(int)(lds0+LDS_V)+((lane>>4)&1)*32+(lane&3)*8+(4*hi+((lane&15)>>2))*64;
  const char*Kbase=shm+LDS_K; bf16x8 kf[8];
  const lds_cptr shm3=(lds_cptr)shm; const lds_cptr kp0=shm3+LDS_K+hi*1024+r32*16; const lds_cptr vp0=shm3+LDS_V+((lane>>4)&1)*32+(lane&3)*8+(4*hi+((lane&15)>>2))*64;
  DMA_K(0,0);DMA_V(0,0);DMA_K(1,SLOTB);
  bf16x8 qr[4];
  #pragma unroll
  for(int d0=0;d0<4;++d0)qr[d0]=*reinterpret_cast<const bf16x8*>(&Qw[(long)r32*QP+d0*16+hi*8]);
  float mhat=0.f,l_reg=0.f;f32x16 o[2];o[0]=f32x16{};o[1]=f32x16{};f32x16 negm=f32x16{};asm volatile("":"+v"(negm));
  #define CMASK(P0,P1,t) do{}while(0)
  bool resc=false;
  #define START(P0,P1) do{ const float rm=rowmax(P0,P1); resc=false; \
    { const float dl=rm; mhat=fadd_s(mhat,dl); \
      _Pragma("unroll") for(int r=0;r<16;++r){P0[r]=fsub_s(P0[r],dl);P1[r]=fsub_s(P1[r],dl);} \
      _Pragma("unroll") for(int r=0;r<16;++r)negm[r]=-mhat; asm volatile("":"+v"(negm)); } \
    _Pragma("unroll") for(int r=0;r<16;++r)P0[r]=__builtin_amdgcn_exp2f(P0[r]); }while(0)
  #define RESC() do{ if(resc){ asm volatile("s_waitcnt lgkmcnt(0)":::"memory"); \
      _Pragma("unroll") for(int d_=0;d_<2;++d_) _Pragma("unroll") for(int r=0;r<16;++r)o[d_][r]*=wsf[crow(r,hi)]; } }while(0)
  f32x16 pA0,pA1,pB0,pB1;
  int sl_prev=0,sl_cur=0,sl_next=SLOTB;
  #define ROT() do{sl_prev=sl_cur;sl_cur=sl_next;sl_next=(sl_next==(NSLOT-1)*SLOTB)?0:sl_next+SLOTB;}while(0)
  DMA_K(2,2*SLOTB);
  WAIT_BAR(3);
  qkt(pA0,pA1,Kbase,qr,negm,r32,hi);asm volatile("s_nop 15\n\ts_nop 7":"+v"(pA0),"+v"(pA1));CMASK(pA0,pA1,0);
  START(pA0,pA1);
  _Pragma("unroll") for(int r=0;r<16;++r)pA1[r]=__builtin_amdgcn_exp2f(pA1[r]);
  WAIT_BAR(0);
  DMA_K(3,0);DMA_V(1,SLOTB);
  ROT();
  kload8(kf,kp0+sl_cur);
  WAIT_BAR(2);
  s16x4 vlo[8],vhi[8]; u32x4 pw0,pw1,pw2,pw3;
  #define PKW(P,B) cvtpk_s(P[B],P[B+1])
  #define PAF(k) __builtin_bit_cast(bf16x8,pw##k)
  #define VFR(i) (bf16x8){vlo[i][0],vlo[i][1],vlo[i][2],vlo[i][3],vhi[i][0],vhi[i][1],vhi[i][2],vhi[i][3]}
  #define PIN(x) asm volatile("":"+v"(x))
  #define MX3(a,b,c) __builtin_fmaxf(__builtin_fmaxf((a),(b)),(c))
  #define GAPA(MF,A0,A1,A2,A3,W0,W1,PW) do{ MF; sacc+=A0; sacc+=A1; sacc+=A2; sacc+=A3; PIN(sacc); W0; W1; PIN(PW); SBAR(); }while(0)
  #define EX(v) __builtin_amdgcn_exp2f(v)
  #define GAPB(MF,X,B) do{ MF; X[B]=EX(X[B]); X[B+1]=EX(X[B+1]); X[B+2]=EX(X[B+2]); X[B+3]=EX(X[B+3]); PIN(X); SBAR(); }while(0)
  #define VRD(i) do{ vlo[i]=vtr(vp_+(((i)>>2)*4096+((i)&3)*1024)); vhi[i]=vtr(vp_+(((i)>>2)*4096+((i)&3)*1024+512)); }while(0)
  #define KRD(G,j) do{ if(G){ kload2(kf,kp0+sl_next,j); SBAR(); } }while(0)
  #define STEP(C0,C1,P0,P1,t,GK,GV,GL) do{ SBAR(); \
    const lds_cptr vp_=vp0+sl_prev; \
    VRD(0); SBAR(); float sacc=(P0[0]+P0[1]); \
    GAPA(C0=__builtin_amdgcn_mfma_f32_32x32x16_bf16(kf[0],qr[0],negm,0,0,0), P0[2],P0[3],P0[4],P0[5],     pw0[0]=PKW(P0,0), pw0[1]=PKW(P0,2), pw0); \
    VRD(4); SBAR(); GAPA(C1=__builtin_amdgcn_mfma_f32_32x32x16_bf16(kf[1],qr[0],negm,0,0,0), P0[6],P0[7],P0[8],P0[9],     pw0[2]=PKW(P0,4), pw0[3]=PKW(P0,6), pw0); \
    VRD(1); SBAR(); GAPA(C0=__builtin_amdgcn_mfma_f32_32x32x16_bf16(kf[2],qr[1],C0,0,0,0),   P0[10],P0[11],P0[12],P0[13], pw1[0]=PKW(P0,8), pw1[1]=PKW(P0,10), pw1); \
    VRD(5); SBAR(); GAPA(C1=__builtin_amdgcn_mfma_f32_32x32x16_bf16(kf[3],qr[1],C1,0,0,0),   P0[14],P0[15],P1[0],P1[1],   pw1[2]=PKW(P0,12),pw1[3]=PKW(P0,14), pw1); \
    VRD(2); SBAR(); GAPA(C0=__builtin_amdgcn_mfma_f32_32x32x16_bf16(kf[4],qr[2],C0,0,0,0),   P1[2],P1[3],P1[4],P1[5],     pw2[0]=PKW(P1,0), pw2[1]=PKW(P1,2), pw2); \
    VRD(6); SBAR(); GAPA(C1=__builtin_amdgcn_mfma_f32_32x32x16_bf16(kf[5],qr[2],C1,0,0,0),   P1[6],P1[7],P1[8],P1[9],     pw2[2]=PKW(P1,4), pw2[3]=PKW(P1,6), pw2); \
    VRD(3); SBAR(); GAPA(C0=__builtin_amdgcn_mfma_f32_32x32x16_bf16(kf[6],qr[3],C0,0,0,0),   P1[10],P1[11],P1[12],P1[13], pw3[0]=PKW(P1,8), pw3[1]=PKW(P1,10), pw3); \
    VRD(7); SBAR(); GAPA(C1=__builtin_amdgcn_mfma_f32_32x32x16_bf16(kf[7],qr[3],C1,0,0,0),   P1[14],P1[15],0.f,0.f,       pw3[2]=PKW(P1,12),pw3[3]=PKW(P1,14), pw3); \
    l_reg+=sacc; \
    if(GK){DMA_K((t)+3,sl_cur);} if(GV){DMA_V((t)+1,sl_next);} \
    CMASK(C0,C1,t); \
    { float a=MX3(C0[0],C0[1],C1[0]),b=MX3(C0[2],C0[3],C1[1]); a=MX3(a,C1[2],C1[3]); \
      _Pragma("unroll") for(int r=4;r<16;r+=4){a=MX3(a,C0[r],C0[r+1]);b=MX3(b,C0[r+2],C0[r+3]);a=MX3(a,C1[r],C1[r+1]);b=MX3(b,C1[r+2],C1[r+3]);} \
      float rm=__builtin_fmaxf(a,b); { auto rr=__builtin_amdgcn_permlane32_swap(__float_as_uint(rm),__float_as_uint(rm),false,false); rm=__builtin_fmaxf(__uint_as_float(rr[0]),__uint_as_float(rr[1])); } \
      resc=false; \
      if(__builtin_expect(__any(rm>(float)THRL),0)){ const float dl=__builtin_fmaxf(rm,0.f); mhat+=dl; \
        _Pragma("unroll") for(int r=0;r<16;++r){C0[r]-=dl;C1[r]-=dl;} \
        _Pragma("unroll") for(int r=0;r<16;++r)negm[r]=-mhat; asm volatile("":"+v"(negm)); \
        const float f=__builtin_amdgcn_exp2f(-dl); l_reg*=f; if(hi==0)wsf[r32]=f; resc=true; } } \
    SBAR(); \
    GAPB(o[0]=__builtin_amdgcn_mfma_f32_32x32x16_bf16(PAF(0),VFR(0),o[0],0,0,0), C0,0); \
    GAPB(o[1]=__builtin_amdgcn_mfma_f32_32x32x16_bf16(PAF(0),VFR(4),o[1],0,0,0), C0,4); \
    KRD(GL,0); GAPB(o[0]=__builtin_amdgcn_mfma_f32_32x32x16_bf16(PAF(1),VFR(1),o[0],0,0,0), C0,8); \
    KRD(GL,1); GAPB(o[1]=__builtin_amdgcn_mfma_f32_32x32x16_bf16(PAF(1),VFR(5),o[1],0,0,0), C0,12); \
    KRD(GL,2); GAPB(o[0]=__builtin_amdgcn_mfma_f32_32x32x16_bf16(PAF(2),VFR(2),o[0],0,0,0), C1,0); \
    KRD(GL,3); GAPB(o[1]=__builtin_amdgcn_mfma_f32_32x32x16_bf16(PAF(2),VFR(6),o[1],0,0,0), C1,4); \
    GAPB(o[0]=__builtin_amdgcn_mfma_f32_32x32x16_bf16(PAF(3),VFR(3),o[0],0,0,0), C1,8); \
    GAPB(o[1]=__builtin_amdgcn_mfma_f32_32x32x16_bf16(PAF(3),VFR(7),o[1],0,0,0), C1,12); \
    }while(0)
  int t=1;
  for(;t+5<NT;t+=2){
    STEP(pB0,pB1,pA0,pA1,t,true,true,true);     WAIT_BAR(2); RESC(); ROT();
    STEP(pA0,pA1,pB0,pB1,t+1,true,true,true);   WAIT_BAR(2); RESC(); ROT();
  }
  #define ENDW(tt) do{ if((tt)+3<NT){WAIT_BAR(2);} else if((tt)+2<NT){WAIT_BAR(1);} else {WAIT_BAR(0);} }while(0)
  for(;t+1<NT;t+=2){
    STEP(pB0,pB1,pA0,pA1,t,(t+3<NT),(t+1<NT),(t+1<NT));       ENDW(t);   RESC(); ROT();
    STEP(pA0,pA1,pB0,pB1,t+1,(t+4<NT),(t+2<NT),(t+2<NT));     ENDW(t+1); RESC(); ROT();
  }
  STEP(pB0,pB1,pA0,pA1,NT-1,false,false,false); RESC();
  { float sacc=pB0[0]+pB0[1]; _Pragma("unroll") for(int r=2;r<16;++r)sacc+=pB0[r]; _Pragma("unroll") for(int r=0;r<16;++r)sacc+=pB1[r]; l_reg+=sacc;
    pw0=(u32x4){PKW(pB0,0),PKW(pB0,2),PKW(pB0,4),PKW(pB0,6)};pw1=(u32x4){PKW(pB0,8),PKW(pB0,10),PKW(pB0,12),PKW(pB0,14)};pw2=(u32x4){PKW(pB1,0),PKW(pB1,2),PKW(pB1,4),PKW(pB1,6)};pw3=(u32x4){PKW(pB1,8),PKW(pB1,10),PKW(pB1,12),PKW(pB1,14)};
    SBAR(); pv(o,vb0+sl_cur,PAF(0),PAF(1),PAF(2),PAF(3)); }
  #undef PKW
  #undef PAF
  #undef VFR
  #undef PIN
  #undef MX3
  #undef GAPA
  #undef GAPB
  #undef EX
  #undef VRD
  #undef KRD
  #undef STEP
  #undef ENDW
  {auto rr=__builtin_amdgcn_permlane32_swap(__float_as_uint(l_reg),__float_as_uint(l_reg),false,false);l_reg=__uint_as_float(rr[0])+__uint_as_float(rr[1]);}
  if(hi==0)wsf[32+r32]=l_reg;asm volatile("s_waitcnt lgkmcnt(0)":::"memory");
  float rli[16];
  #pragma unroll
  for(int r=0;r<16;++r)rli[r]=__builtin_amdgcn_rcpf(wsf[32+crow(r,hi)]);
  bf16*Ow=Ou+(long)(wid*QBLK)*OP;
  { bf16*stg=(bf16*)(shm+LDS_OST)+wid*2048;
    #pragma unroll
    for(int r=0;r<16;++r){const int orow=crow(r,hi);
      #pragma unroll
      for(int d0=0;d0<2;++d0)stg[orow*64+d0*32+r32]=__float2bfloat16(o[d0][r]*rli[r]);}
    asm volatile("s_waitcnt lgkmcnt(0)":::"memory");
    #pragma unroll
    for(int i=0;i<4;++i){const int row=i*8+(lane>>3),ch=lane&7; const u32x4 v=*(const u32x4*)(stg+row*64+ch*8); ATTN_STORE16(Ow+(long)row*OP+ch*8,v);} }
  asm volatile("s_waitcnt lgkmcnt(0)\n\ts_barrier":::"memory");
  #undef DMA_K
  #undef DMA_V
  #undef CMASK
  #undef START
  #undef RESC
  #undef ROT
}
constexpr int ATTN_LDS_BYTES=LDS_BYTES;
#undef SBAR
#undef WAIT_BAR
}

__device__ __forceinline__ int scan_row(int s, int dir) { return s < CT ? (dir ? CT - 1 - s : s) : (dir ? CT + (TL - 1 - (s - CT)) : s); }
typedef short sbf8 __attribute__((ext_vector_type(8)));
constexpr int CH_LD = 72;
constexpr int CA_LL = 0, CA_GT = 16384, CA_GC = 129536, CA_MA = 18944, CA_NKV = CA_MA + 18432, CA_MT = 55808, CA_MN = 83456, CA_MW = 111104;
constexpr int NA_LD = 68, TB_LD = 17;
constexpr int NCHUNK = SB / 64;
constexpr size_t SCA_PT = 0, SCA_RY = (size_t)32 * NCHUNK * 4096 * 2, SCA_Q = 2 * SCA_RY, SCA_END = SCA_Q + (size_t)32 * NCHUNK * 4096 * 4;
static_assert(SCA_END <= (size_t)M * NINP * 2, "stage-A outputs fit the U region");
__device__ __forceinline__ f32x4 mma_nt64(const LAS bf16* A, const LAS bf16* B, int ti, int tj, int fr, int fq, f32x4 acc) {
#pragma unroll
    for (int kb = 0; kb < 2; ++kb) {
        const sbf8 a = *(const LAS sbf8*)(A + (16 * ti + fr) * CH_LD + kb * 32 + 8 * fq);
        const sbf8 b = *(const LAS sbf8*)(B + (16 * tj + fr) * CH_LD + kb * 32 + 8 * fq);
        acc = __builtin_amdgcn_mfma_f32_16x16x32_bf16(a, b, acc, 0, 0, 0);
    }
    return acc;
}
__device__ __forceinline__ float quad_sum(float x) {
    float r;
    asm("s_nop 1\n\tv_add_f32_dpp %0, %1, %1 quad_perm:[1,0,3,2] row_mask:0xf bank_mask:0xf\n\ts_nop 1\n\t"
        "v_add_f32_dpp %0, %0, %0 quad_perm:[2,3,0,1] row_mask:0xf bank_mask:0xf\n\ts_nop 0" : "=&v"(r) : "v"(x));
    return r;
}
struct AIn { f32x4 lw0, lw1; v4u kk, ka, ke, rr, vv; };
__device__ __forceinline__ void scanA_issue(const Frame& F, int ch, int c, AIn& in) {
    const int dir = ch >> 4, b = (ch >> 2) & 3, h = ch & 3;
    const size_t rb = (size_t)b * SB, dofs = (size_t)dir * M * 256; const int col0 = h * 64, s_base = c * 64, tid = F.tid;
    size_t z_ = 0; asm volatile("" : "+s"(z_));
    unsigned char* wsb = F.ws + z_;
    const float* LWg = (const float*)(wsb + WS_AR + AR_W) + dofs;
    const bf16* KKg = (const bf16*)(wsb + WS_AR + AR_KK); const bf16* KAg = (const bf16*)(wsb + WS_AR + AR_KKA) + dofs; const bf16* KEg = (const bf16*)(wsb + WS_AR + AR_KE) + dofs;
    const bf16* Rg = (const bf16*)(wsb + WS_AR + AR_R); const bf16* Vg = (const bf16*)(wsb + WS_AR + AR_V);
    { const int t = tid >> 3, k0 = (tid & 7) * 8; const size_t g = (rb + scan_row(s_base + t, dir)) * 256 + col0 + k0;
      in.lw0 = *(const f32x4*)(LWg + g); in.lw1 = *(const f32x4*)(LWg + g + 4);
      in.kk = *(const v4u*)(KKg + g); in.ka = *(const v4u*)(KAg + g); in.ke = *(const v4u*)(KEg + g); in.rr = *(const v4u*)(Rg + g); in.vv = *(const v4u*)(Vg + g); }
}
__device__ __forceinline__ void scanA_task(const Frame& F, int ch, int c, float* Y0dst, size_t y0_row_stride_sel  , AIn& in, bool has_next, int nch, int nc) {
    const int dir = ch >> 4, b = (ch >> 2) & 3, h = ch & 3;
    const size_t rb = (size_t)b * SB, dofs = (size_t)dir * M * 256; const int col0 = h * 64;
    const float* LWg = (const float*)(F.ws + WS_AR + AR_W) + dofs;
    const bf16* KKg = (const bf16*)(F.ws + WS_AR + AR_KK); const bf16* KAg = (const bf16*)(F.ws + WS_AR + AR_KKA) + dofs; const bf16* KEg = (const bf16*)(F.ws + WS_AR + AR_KE) + dofs;
    const bf16* Rg = (const bf16*)(F.ws + WS_AR + AR_R); const bf16* Vg = (const bf16*)(F.ws + WS_AR + AR_V);
    unsigned char* ob = F.ws + WS_AR + AR_U; const size_t tsk = (size_t)ch * NCHUNK + c;
    bf16* PTg = (bf16*)(ob + SCA_PT) + tsk * 4096; bf16* RYg = (bf16*)(ob + SCA_RY) + tsk * 4096; float* Qg = (float*)(ob + SCA_Q) + tsk * 4096;
    LAS float* LL = (LAS float*)(F.lds + CA_LL); LAS float* GT = (LAS float*)(F.lds + CA_GT); LAS float* GC = (LAS float*)(F.lds + CA_GC);
    LAS bf16* KKG = (LAS bf16*)(F.lds + CA_MA); LAS bf16* RG = KKG + 64 * CH_LD; LAS bf16* AG = RG + 64 * CH_LD; LAS bf16* KG = AG + 64 * CH_LD;
    LAS float* NKV = (LAS float*)(F.lds + CA_NKV);
    LAS bf16* AHT = (LAS bf16*)(F.lds + CA_MT); LAS bf16* KHT = AHT + 64 * CH_LD; LAS bf16* VT = KHT + 64 * CH_LD;
    LAS bf16* NK = (LAS bf16*)(F.lds + CA_MN); LAS bf16* MA = NK + 64 * CH_LD; LAS bf16* MK = MA + 64 * CH_LD;
    LAS bf16* W1T = (LAS bf16*)(F.lds + CA_MW); LAS bf16* W2T = W1T + 64 * CH_LD;
    int tid_ = F.tid; asm volatile("" : "+v"(tid_));
    const int tid = tid_, lane = tid & 63, wv = F.wave, fr = lane & 15, fq = lane >> 4;
    const int s_base = c * 64;
    SUBT(8);
    for (int rep1 = 0; rep1 < (SCANA_REP == 1 ? 2 : 1); ++rep1) {
    { const int t = tid >> 3, k0 = (tid & 7) * 8;
      *(LAS f32x4*)(LL + t * 64 + k0) = in.lw0; *(LAS f32x4*)(LL + t * 64 + k0 + 4) = in.lw1; }
    LDS_BARRIER();
    { const int k = tid & 63, g = tid >> 6; float v[8];
#pragma unroll
      for (int j = 0; j < 8; ++j) v[j] = LL[(8 * g + j) * 64 + k];
#pragma unroll
      for (int j = 1; j < 8; ++j) v[j] += v[j - 1];
      GT[g * 64 + k] = v[7];
      LDS_BARRIER();
      float off = 0.f;
#pragma unroll
      for (int g2 = 0; g2 < 7; ++g2) off += (g2 < g) ? GT[g2 * 64 + k] : 0.f;
#pragma unroll
      for (int j = 0; j < 8; ++j) LL[(8 * g + j) * 64 + k] = v[j] + off; }
    LDS_BARRIER();
    }
    SUBT(9);
    for (int rep2 = 0; rep2 < (SCANA_REP == 2 ? 2 : 1); ++rep2) {
    { const int t = tid >> 3, k0 = (tid & 7) * 8;
      float kk[8], ka[8], ke[8], rr[8], o1[8], o2[8], o3[8], o4[8];
      unpack8(in.kk, kk); unpack8(in.ka, ka); unpack8(in.ke, ke); unpack8(in.rr, rr);
#pragma unroll
      for (int e = 0; e < 8; ++e) { const float Lt = LL[t * 64 + k0 + e], Lp = t > 0 ? LL[(t - 1) * 64 + k0 + e] : 0.f;
          const float e3 = __expf(-Lt);
          o1[e] = kk[e] * __expf(Lp); o2[e] = rr[e] * __expf(Lt); o3[e] = ka[e] * e3; o4[e] = ke[e] * e3; }
      *(LAS v4u*)(KKG + t * CH_LD + k0) = pack8(o1); *(LAS v4u*)(RG + t * CH_LD + k0) = pack8(o2); *(LAS v4u*)(AG + t * CH_LD + k0) = pack8(o3); *(LAS v4u*)(KG + t * CH_LD + k0) = pack8(o4);
      LAS bf16* RAW = (LAS bf16*)(F.lds + CA_MN);
      *(LAS v4u*)(RAW + t * 64 + k0) = in.ka; *(LAS v4u*)(RAW + 4096 + t * 64 + k0) = in.ke; *(LAS v4u*)(RAW + 8192 + t * 64 + k0) = in.vv; }
    LDS_BARRIER();
    { const int k = tid & 63, t0 = (tid >> 6) * 8; const float LC = LL[63 * 64 + k];
      float o1[8], o2[8], o3[8];
#pragma unroll
      for (int j = 0; j < 8; ++j) { const LAS bf16* RAW = (const LAS bf16*)(F.lds + CA_MN);
          const float e4 = __expf(LC - LL[(t0 + j) * 64 + k]);
          o1[j] = bf2f(RAW[(t0 + j) * 64 + k]) * e4; o2[j] = bf2f(RAW[4096 + (t0 + j) * 64 + k]) * e4; o3[j] = bf2f(RAW[8192 + (t0 + j) * 64 + k]); }
      *(LAS v4u*)(AHT + k * CH_LD + t0) = pack8(o1); *(LAS v4u*)(KHT + k * CH_LD + t0) = pack8(o2); *(LAS v4u*)(VT + k * CH_LD + t0) = pack8(o3);
      if (t0 == 0) GC[k] = __expf(LC); }
    }
    LDS_BARRIER();
    if (has_next) scanA_issue(F, nch, nc, in);
    SUBT(10);
    const int ti = wv & 3;
    for (int rep3 = 0; rep3 < (SCANA_REP == 3 ? 2 : 1); ++rep3)
#pragma unroll
    for (int jj = 0; jj < 2; ++jj) {
        const int tj = 2 * (wv >> 2) + jj;
        const f32x4 z4 = {0.f, 0.f, 0.f, 0.f};
        f32x4 na = z4, nk = z4, ma = z4, mk = z4;
        if (tj <= ti) { na = mma_nt64(KKG, AG, ti, tj, fr, fq, z4); nk = mma_nt64(KKG, KG, ti, tj, fr, fq, z4); ma = mma_nt64(RG, AG, ti, tj, fr, fq, z4); mk = mma_nt64(RG, KG, ti, tj, fr, fq, z4); }
        const int i = 16 * tj + fr;
#pragma unroll
        for (int rg = 0; rg < 4; ++rg) { const int t = 16 * ti + 4 * fq + rg;
            const bool lo = i < t, le = i <= t;
            LL[t * NA_LD + i] = lo ? na[rg] : 0.f;
            NK[t * CH_LD + i] = (bf16)f2bf(lo ? nk[rg] : 0.f); MA[t * CH_LD + i] = (bf16)f2bf(le ? ma[rg] : 0.f); MK[t * CH_LD + i] = (bf16)f2bf(le ? mk[rg] : 0.f); }
    }
    LDS_BARRIER();
    SUBT(11);
    f32x4 mkv[2];
#pragma unroll
    for (int jj = 0; jj < 2; ++jj) {
        const int tj = 2 * (wv >> 2) + jj; const f32x4 z4 = {0.f, 0.f, 0.f, 0.f};
        const f32x4 nkv = mma_nt64(NK, VT, ti, tj, fr, fq, z4); mkv[jj] = mma_nt64(MK, VT, ti, tj, fr, fq, z4);
#pragma unroll
        for (int rg = 0; rg < 4; ++rg) NKV[(16 * ti + 4 * fq + rg) * 64 + 16 * tj + fr] = nkv[rg];
    }
    LDS_BARRIER();
    SUBT(12);
    { LAS float* NaR = LL;
      LAS float* TB = (LAS float*)(F.lds + CA_MN + 18432);
      LAS float* XW = wv < 5 ? (LAS float*)(F.lds + CA_NKV) + wv * 768 : (LAS float*)(F.lds + CA_MN) + (wv - 5) * 768;
      const int col = 16 * wv + fr;
      float Rr[4][4];
#pragma unroll
      for (int bb = 0; bb < 4; ++bb)
#pragma unroll
          for (int rg = 0; rg < 4; ++rg) { const int t = 16 * bb + 4 * fq + rg; Rr[bb][rg] = wv < 4 ? bf2f(KKG[t * CH_LD + col]) : NKV[t * 64 + (col - 64)]; }
      if (wv < 4 && lane < 16) {
          const int bb = wv, c = lane; float Tc[16];
#pragma unroll
          for (int r = 0; r < 16; ++r) {
              float acc = (r == c) ? 1.f : 0.f;
#pragma unroll
              for (int i4 = 0; i4 < r; i4 += 4) { const f32x4 dv = *(const LAS f32x4*)(NaR + (16 * bb + r) * NA_LD + 16 * bb + i4);
#pragma unroll
                  for (int e = 0; e < 4; ++e) if (i4 + e < r) acc -= dv[e] * Tc[i4 + e]; }
              Tc[r] = acc; TB[(bb * 16 + r) * TB_LD + c] = acc;
          }
      }
      LDS_BARRIER();
      LAS bf16* WT = wv < 4 ? (W1T + col * CH_LD) : (W2T + (col - 64) * CH_LD);
#pragma unroll
      for (int bb = 0; bb < 4; ++bb) {
          f32x4 z = {0.f, 0.f, 0.f, 0.f};
#pragma unroll
          for (int st = 0; st < 4 * bb; ++st) z = __builtin_amdgcn_mfma_f32_16x16x4f32(NaR[(16 * bb + fr) * NA_LD + 4 * st + fq], XW[(4 * st + fq) * 16 + fr], z, 0, 0, 0);
          LAS float* RW = XW + (bb < 3 ? 16 * bb : 0) * 16;
#pragma unroll
          for (int rg = 0; rg < 4; ++rg) RW[(4 * fq + rg) * 16 + fr] = Rr[bb][rg] - z[rg];
          asm volatile("s_waitcnt lgkmcnt(0)" ::: "memory");
          f32x4 xb = {0.f, 0.f, 0.f, 0.f};
#pragma unroll
          for (int st = 0; st < 4; ++st) xb = __builtin_amdgcn_mfma_f32_16x16x4f32(TB[(bb * 16 + fr) * TB_LD + 4 * st + fq], RW[(4 * st + fq) * 16 + fr], xb, 0, 0, 0);
          asm volatile("s_waitcnt lgkmcnt(0)" ::: "memory");
          if (bb < 3) {
#pragma unroll
              for (int rg = 0; rg < 4; ++rg) XW[(16 * bb + 4 * fq + rg) * 16 + fr] = xb[rg];
          }
          v2u w_; w_.x = pk2(xb[0], xb[1]); w_.y = pk2(xb[2], xb[3]);
          *(LAS v2u*)(WT + 16 * bb + 4 * fq) = w_;
          asm volatile("s_waitcnt lgkmcnt(0)" ::: "memory");
      } }
    LDS_BARRIER();
    SUBT(13);
#pragma unroll
    for (int jj = 0; jj < 2; ++jj) {
        const int tj = 2 * (wv >> 2) + jj; const f32x4 z4 = {0.f, 0.f, 0.f, 0.f};
        const f32x4 a1 = mma_nt64(MA, W1T, ti, tj, fr, fq, z4), a2 = mma_nt64(MA, W2T, ti, tj, fr, fq, z4);
        const f32x4 a3 = mma_nt64(AHT, W1T, ti, tj, fr, fq, z4);
        const f32x4 a4 = mma_nt64(VT, KHT, ti, tj, fr, fq, z4), a5 = mma_nt64(W2T, AHT, ti, tj, fr, fq, z4);
        const int cc = 16 * tj + fr;
#pragma unroll
        for (int rg = 0; rg < 4; ++rg) { const int r_ = 16 * ti + 4 * fq + rg;
            RYg[r_ * 64 + cc] = (bf16)f2bf(bf2f(RG[r_ * CH_LD + cc]) - a1[rg]);
            const size_t yrow = y0_row_stride_sel ? (size_t)(s_base + r_) : (rb + scan_row(s_base + r_, dir));
            Y0dst[((size_t)dir * (y0_row_stride_sel ? (size_t)SB : (size_t)M) + yrow) * 256 + col0 + cc] = mkv[jj][rg] - a2[rg];
            PTg[r_ * 64 + cc] = (bf16)f2bf((r_ == cc ? GC[cc] : 0.f) - a3[rg]);
            Qg[r_ * 64 + cc] = a4[rg] - a5[rg]; }
    }
    SUBT(14);
    LDS_BARRIER();
    SUBT(15);
}

constexpr int BC_RY = 0, BC_PT = 9216, BC_Q = 18432, BC_QLD = 68, BC_Y = BC_Q + 32 * BC_QLD * 4, BC_BUF = BC_Y + 64 * 32 * 4  , BC_S = 2 * BC_BUF;
__device__ __forceinline__ void scanBC_task(const Frame& F, int ch, int half, float* Ybuf, int ydebug, const float* cmp, unsigned* dmax) {
    const int dir = ch >> 4, b = (ch >> 2) & 3, h = ch & 3;
    const size_t rb = (size_t)b * SB; const int col0 = h * 64;
    unsigned char* ob = F.ws + WS_AR + AR_U;
    const bf16* PTg = (const bf16*)(ob + SCA_PT) + (size_t)ch * NCHUNK * 4096; const bf16* RYg = (const bf16*)(ob + SCA_RY) + (size_t)ch * NCHUNK * 4096;
    const float* Qg = (const float*)(ob + SCA_Q) + (size_t)ch * NCHUNK * 4096;
    LAS bf16* SB0 = (LAS bf16*)(F.lds + BC_S);
    const int tid = F.tid, lane = F.lane, wv = F.wave, fr = lane & 15, fq = lane >> 4;
    const int srb = wv & 1, scb = wv >> 1, ytb = wv & 3, yrb = wv >> 2;
    for (int i = tid; i < 2 * 32 * CH_LD / 2; i += NTHR) ((LAS unsigned*)SB0)[i] = 0u;
    float dm = 0.f;
    const int g_rp = (tid >> 3) * 64 + (tid & 7) * 8, l_rp = (tid >> 3) * CH_LD + (tid & 7) * 8;
    const int g_q = (half * 32 + (tid >> 4)) * 64 + (tid & 15) * 4, l_q = (tid >> 4) * BC_QLD + (tid & 15) * 4;
    const int y_t = tid >> 3, y_r4 = (tid & 7) * 4;
    const size_t ydir = (size_t)dir * (ydebug ? (size_t)SB : (size_t)M);
    v4u a_ry, a_pt, b_ry, b_pt; f32x4 a_q, a_y, b_q, b_y;
#define BC_LOAD(c, RYv, PTv, Qv, Yv) do { const size_t o_ = (size_t)(c) * 4096; RYv = *(const v4u*)(RYg + o_ + g_rp); PTv = *(const v4u*)(PTg + o_ + g_rp); Qv = *(const f32x4*)(Qg + o_ + g_q); \
        const int s_ = (c) * 64 + y_t; const size_t yrow_ = ydebug ? (size_t)s_ : (rb + scan_row(s_, dir)); Yv = *(const f32x4*)(Ybuf + (ydir + yrow_) * 256 + col0 + half * 32 + y_r4); } while (0)
#define BC_PARK(c, RYv, PTv, Qv, Yv) do { LAS unsigned char* d_ = F.lds + ((c) & 1) * BC_BUF; *(LAS v4u*)((LAS bf16*)(d_ + BC_RY) + l_rp) = RYv; *(LAS v4u*)((LAS bf16*)(d_ + BC_PT) + l_rp) = PTv; \
        *(LAS f32x4*)((LAS float*)(d_ + BC_Q) + l_q) = Qv; *(LAS f32x4*)((LAS float*)(d_ + BC_Y) + y_t * 32 + y_r4) = Yv; } while (0)
#define BC_STEP(c, RYv, PTv, Qv, Yv) do { \
        const LAS unsigned char* o_ = F.lds + ((c) & 1) * BC_BUF; const LAS bf16* Sc = SB0 + ((c) & 1) * 32 * CH_LD; LAS bf16* Sn = SB0 + (((c) + 1) & 1) * 32 * CH_LD; \
        const LAS bf16* RYs = (const LAS bf16*)(o_ + BC_RY); const LAS bf16* PTs = (const LAS bf16*)(o_ + BC_PT); const LAS float* Qs = (const LAS float*)(o_ + BC_Q); const LAS float* Ys = (const LAS float*)(o_ + BC_Y); \
        f32x4 yacc, sacc; \
        _Pragma("unroll") for (int rg = 0; rg < 4; ++rg) { yacc[rg] = Ys[(16 * ytb + 4 * fq + rg) * 32 + 16 * yrb + fr]; sacc[rg] = Qs[(16 * srb + 4 * fq + rg) * BC_QLD + 16 * scb + fr]; } \
        _Pragma("unroll") for (int kb = 0; kb < 2; ++kb) { \
            const sbf8 ya = *(const LAS sbf8*)(RYs + (16 * ytb + fr) * CH_LD + kb * 32 + 8 * fq), yb = *(const LAS sbf8*)(Sc + (16 * yrb + fr) * CH_LD + kb * 32 + 8 * fq); \
            const sbf8 sa = *(const LAS sbf8*)(Sc + (16 * srb + fr) * CH_LD + kb * 32 + 8 * fq), sb_ = *(const LAS sbf8*)(PTs + (16 * scb + fr) * CH_LD + kb * 32 + 8 * fq); \
            yacc = __builtin_amdgcn_mfma_f32_16x16x32_bf16(ya, yb, yacc, 0, 0, 0); sacc = __builtin_amdgcn_mfma_f32_16x16x32_bf16(sa, sb_, sacc, 0, 0, 0); } \
        _Pragma("unroll") for (int rg = 0; rg < 4; ++rg) Sn[(16 * srb + 4 * fq + rg) * CH_LD + 16 * scb + fr] = (bf16)f2bf(sacc[rg]); \
        _Pragma("unroll") for (int rg = 0; rg < 4; ++rg) { const int s_ = (c) * 64 + 16 * ytb + 4 * fq + rg; \
            if (cmp) { const float ref_ = cmp[((size_t)dir * M + rb + scan_row(s_, dir)) * 256 + col0 + half * 32 + 16 * yrb + fr]; dm = fmaxf(dm, fabsf(yacc[rg] - ref_)); } \
            else { const size_t yrow_ = ydebug ? (size_t)s_ : (rb + scan_row(s_, dir)); Ybuf[(ydir + yrow_) * 256 + col0 + half * 32 + 16 * yrb + fr] = yacc[rg]; } } \
        if ((c) + 1 < NCHUNK) BC_PARK((c) + 1, RYv, PTv, Qv, Yv); \
        if ((c) + 3 < NCHUNK) BC_LOAD((c) + 3, RYv, PTv, Qv, Yv); \
        LDS_BARRIER(); } while (0)
    BC_LOAD(0, a_ry, a_pt, a_q, a_y); BC_LOAD(1, b_ry, b_pt, b_q, b_y);
    BC_PARK(0, a_ry, a_pt, a_q, a_y);
    BC_LOAD(2, a_ry, a_pt, a_q, a_y);
    LDS_BARRIER();
    for (int c = 0; c < NCHUNK; c += 2) {
        BC_STEP(c, b_ry, b_pt, b_q, b_y);
        BC_STEP(c + 1, a_ry, a_pt, a_q, a_y);
    }
#undef BC_LOAD
#undef BC_PARK
#undef BC_STEP
    if (cmp) { dm = fmaxf(dm, __shfl_xor(dm, 1)); dm = fmaxf(dm, __shfl_xor(dm, 2)); dm = fmaxf(dm, __shfl_xor(dm, 4)); dm = fmaxf(dm, __shfl_xor(dm, 8)); dm = fmaxf(dm, __shfl_xor(dm, 16)); dm = fmaxf(dm, __shfl_xor(dm, 32));
        if (lane == 0) atomicMax(dmax, __builtin_bit_cast(unsigned, dm)); }
    __syncthreads();
}

__device__ __forceinline__ void scan_mixer_phase(const Frame& F, int l) {
    typedef attn_body::bf16 abf;
    const abf* U = (const abf*)(F.ws + WS_AR + AR_QKV); abf* MIX = (abf*)(F.ws + WS_AR + AR_MIX);
    char* shm = (char*)F.lds;
    float* Y = (float*)(F.ws + WS_AR + AR_Y);
    const int g = F.bid >> 3, x = F.bid & 7;
    const bool scan_cu = (g & 3) == 3;
    { int t0, nt_;
      if (scan_cu) { t0 = 5 * (g >> 2); nt_ = 5; } else { const int a = g - (g >> 2); t0 = 40 + (a < 16 ? 10 * a : 160 + 9 * (a - 16)); nt_ = a < 16 ? 10 : 9; }
      AIn ain;
      { const int cl = t0 / NCHUNK, bh = 2 * x + (cl >> 1), dir = cl & 1; scanA_issue(F, (dir * 4 + (bh >> 2)) * 4 + (bh & 3), t0 % NCHUNK, ain); }
      for (int lt = t0; lt < t0 + nt_; ++lt) { const int cl = lt / NCHUNK, bh = 2 * x + (cl >> 1), dir = cl & 1;
          const int l2 = lt + 1, cl2 = l2 / NCHUNK, bh2 = 2 * x + (cl2 >> 1), dir2 = cl2 & 1;
          scanA_task(F, (dir * 4 + (bh >> 2)) * 4 + (bh & 3), lt % NCHUNK, Y, 0, ain, l2 < t0 + nt_, (dir2 * 4 + (bh2 >> 2)) * 4 + (bh2 & 3), l2 % NCHUNK); } }
    unsigned* arrive = (unsigned*)(F.ws + WS_CTL) + 9600 + l * 64;
    asm volatile("s_waitcnt vmcnt(0)" ::: "memory");
    __syncthreads();
    if (F.tid == 0) { __builtin_amdgcn_fence(__ATOMIC_RELEASE, "agent"); asm volatile("s_waitcnt vmcnt(0)" ::: "memory"); __hip_atomic_fetch_add(arrive + 32 + x, 1u, __ATOMIC_RELAXED, __HIP_MEMORY_SCOPE_AGENT); }
    if (l + 1 < NL && !scan_cu && (g >> 2) < 2 && ((g >> 2) == 0 || (g & 3) == 0)) {
        const int hh = (g >> 2) == 0 ? (g & 3) : 3;
        const int b = x >> 1, kvh = x & 1, h = kvh * 4 + hh; const size_t r0 = (size_t)b * SB;
        attn_body::attn_unit<8>(U + r0 * QKVP + h * 64, U + r0 * QKVP + K_OFF + kvh * 64, U + r0 * QKVP + V_OFF + kvh * 64, MIX + r0 * D + h * 64, CT / 64, shm);
    }
    unsigned* ctr = (unsigned*)(F.ws + WS_CTL) + 9216 + l * 64 + x * 8;
    volatile LAS unsigned* qw = (volatile LAS unsigned*)(F.lds + MISC_OFF + 64);
    const int b = x >> 1, kvh = x & 1; const size_t r0 = (size_t)b * SB;
#define AQ_TAKE(jv) do { if (F.tid == 0) qw[0] = __hip_atomic_fetch_add(ctr, 1u, __ATOMIC_RELAXED, __HIP_MEMORY_SCOPE_AGENT); __syncthreads(); jv = (int)qw[0]; __syncthreads(); } while (0)
#define AQ_UNIT(jv) do { const int h_ = kvh * 4 + ((jv) >> 4), qb_ = (jv) & 15; const size_t q0_ = r0 + CT + (size_t)qb_ * 256; \
        attn_body::attn_unit<8>(U + q0_ * QKVP + h_ * 64, U + r0 * QKVP + K_OFF + kvh * 64, U + r0 * QKVP + V_OFF + kvh * 64, MIX + q0_ * D + h_ * 64, SB / 64, shm); } while (0)
    int j0; AQ_TAKE(j0);
    if (j0 < 64) AQ_UNIT(j0);
    if (scan_cu) {
        if (F.tid == 0) { unsigned sp = 0;
            while (__hip_atomic_load(arrive + 32 + x, __ATOMIC_RELAXED, __HIP_MEMORY_SCOPE_AGENT) < 32u) { __builtin_amdgcn_s_sleep(2); if (++sp > (1u << 22)) break; }
            __builtin_amdgcn_fence(__ATOMIC_ACQUIRE, "agent"); asm volatile("s_waitcnt vmcnt(0)" ::: "memory"); }
        __syncthreads();
        const int sc = (g >> 2) * 8 + x, t = sc >> 3, bh = 2 * x + (t >> 2);
        scanBC_task(F, (((t >> 1) & 1) * 4 + (bh >> 2)) * 4 + (bh & 3), t & 1, Y, 0, nullptr, nullptr);
        asm volatile("s_waitcnt vmcnt(0)" ::: "memory");
        __syncthreads();
        if (F.tid == 0) { __builtin_amdgcn_fence(__ATOMIC_RELEASE, "agent"); asm volatile("s_waitcnt vmcnt(0)" ::: "memory"); __hip_atomic_fetch_add(arrive + 16, 1u, __ATOMIC_RELAXED, __HIP_MEMORY_SCOPE_AGENT); }
    }
    if (j0 < 64) for (;;) { int j; AQ_TAKE(j); if (j >= 64) break; AQ_UNIT(j); }
#undef AQ_TAKE
#undef AQ_UNIT
    if (F.tid == 0) { unsigned sp = 0;
        while (__hip_atomic_load(arrive + 16, __ATOMIC_RELAXED, __HIP_MEMORY_SCOPE_AGENT) < 64u) { __builtin_amdgcn_s_sleep(2); if (++sp > (1u << 22)) break; }
        __builtin_amdgcn_fence(__ATOMIC_ACQUIRE, "agent"); asm volatile("s_waitcnt vmcnt(0)" ::: "memory"); }
    __syncthreads();
    rwkv_out_phase(F, l);
}

struct CtxSplitOrder {
    int G, c, ntk, nks, nsub;
    __device__ void init(int G_, int c_, int ntk_, int nctx) { G = G_; c = c_; ntk = ntk_; nks = ntk_ / 4; nsub = nctx * 4 * nks; }
    __device__ bool next(int i, pg8::Unit& u) const {
        const int Lx = i * G + c;
        if (Lx < 256) {
            int wgid = Lx; { const int q = 256 / 8, xcd = wgid % 8, off = wgid / 8; wgid = xcd * q + off; }
            const int nig = 8 * 4, gid = wgid / nig, fm = gid * 8;
            const int pm64 = fm + ((wgid % nig) % 8); u.pn = (wgid % nig) / 8;
            u.pm = pm64 + pm64 / 16 + 1; u.k0t = 0; u.nt = ntk; u.slot = -1; return true;
        }
        const int sub = Lx - 256; if (sub >= nsub) return false;
        const int ks = sub % nks, ct = sub / nks;
        u.pm = (ct >> 2) * 17; u.pn = ct & 3; u.k0t = ks * 4; u.nt = 4; u.slot = ks; return true;
    }
    __device__ __forceinline__ void a_ready(const pg8::Unit&) const {}
    __device__ __forceinline__ void done(const pg8::Unit&) const {}
};

constexpr int NPL = 11, NPHASE = 2 + NPL * NL;
#define PH_IN(k) (lo <= (k) && (k) < hi)
#if PROBE_MASK
#define PH_STAMP(k) do { if (blockIdx.x == 0 && threadIdx.x == 0) ((unsigned long long*)(F.ws + WS_CTL + 32768))[(k) + 1] = __builtin_amdgcn_s_memrealtime(); } while (0)
#else
#define PH_STAMP(k) do { } while (0)
#endif
#define PH_SEAM(k) do { if (PH_IN(k) && PH_IN((k) + 1)) xcd_barrier(bar); PH_STAMP(k); } while (0)
template <int L> __device__ __forceinline__ void layer_phases(const Frame& F, const int lo, const int hi, const XcdBarrier& bar) {
    constexpr int pb = 2 + NPL * L;
    bf16* XN = (bf16*)(F.ws + WS_AR + AR_XN); bf16* U = (bf16*)(F.ws + WS_AR + AR_U); bf16* MIX = (bf16*)(F.ws + WS_AR + AR_MIX);
    float* MIXO = (float*)(F.ws + WS_AR + AR_MIXO); bf16* H = (bf16*)(F.ws + WS_AR + AR_H); bf16* ACT = (bf16*)(F.ws + WS_AR + AR_ACT); float* FO = (float*)(F.ws + WS_AR + AR_FO);
    bf16* t_in = (bf16*)(F.ws + WS_WIN); bf16* t_out = (bf16*)(F.ws + WS_WOUT); bf16* t_up = (bf16*)(F.ws + WS_WUP); bf16* t_dn = (bf16*)(F.ws + WS_WDN);
    if (PH_IN(pb + 0)) { pg8::Gemm g{XN, t_in, M, NINP, D}; pg8::StaticOrder S; S.init(M, NINP, F.G, F.bid, D);
        pg8::EpiBf16<0> E{U, NINP, nullptr, 0, 0, 1.f};
        pg8::gemm_phase<pg8::EpiBf16<0>, pg8::StaticOrder, true, true>(F.lds, g, S, E); }
    PH_SEAM(pb + 0);
    if (PH_IN(pb + 1)) prep_phase(F, L);
    PH_SEAM(pb + 1);
    if (PH_IN(pb + 2)) scan_mixer_phase(F, L);
    PH_STAMP(pb + 2); PH_STAMP(pb + 3);
    PH_SEAM(pb + 4);
    if (PH_IN(pb + 5)) { pg8::Gemm g{MIX, t_out, M, D, D}; CtxSplitOrder S; S.init(F.G, F.bid, D / 64, L + 1 < NL ? 4 : 0);
        pg8::EpiBf16P E{(bf16*)MIXO, D, (float*)(F.ws + WS_AR + AR_PART)};
        pg8::gemm_phase<pg8::EpiBf16P, CtxSplitOrder, true, true>(F.lds, g, S, E); }
    PH_SEAM(pb + 5);
    if (PH_IN(pb + 6)) norm_phase(F, 1, MIXO, INP(I_NMPOST) + L * D, L, 2, INP(I_NFPRE) + L * D, L, 3, 4, L + 1 < NL ? D / 256 : 0);
    PH_SEAM(pb + 6);
    if (PH_IN(pb + 7)) { pg8::Gemm g{XN, t_up, M, DFF2, D}; pg8::StaticOrder S; S.init(M, DFF2, F.G, F.bid, D);
        pg8::EpiBf16<0> E{H, DFF2, nullptr, 0, 0, 1.f};
        pg8::gemm_phase<pg8::EpiBf16<0>, pg8::StaticOrder, true, true>(F.lds, g, S, E); }
    PH_SEAM(pb + 7);
    if (PH_IN(pb + 8)) act_phase(F, L);
    PH_SEAM(pb + 8);
    if (PH_IN(pb + 9)) { pg8::Gemm g{ACT, t_dn, M, D, DFF}; CtxSplitOrder S; S.init(F.G, F.bid, DFF / 64, L + 1 < NL ? 4 : 0);
        pg8::EpiBf16P E{(bf16*)FO, D, (float*)(F.ws + WS_AR + AR_PART)};
        pg8::gemm_phase<pg8::EpiBf16P, CtxSplitOrder, true, true>(F.lds, g, S, E); }
    PH_SEAM(pb + 9);
    if (PH_IN(pb + 10)) {
        if (L + 1 < NL) { norm_phase(F, 1, FO, INP(I_NFPOST) + L * D, L, 5, INP(I_NMPRE) + (L + 1 < NL ? L + 1 : L) * D, L + 1, 0, 1, DFF / 256); __syncthreads(); convert_weights(F, L + 1); }
        else norm_phase(F, 2, FO, INP(I_NFPOST) + L * D, L, 5, nullptr, 0, 0, 0, 0);
    }
    if (L + 1 < NL) PH_SEAM(pb + 10); else PH_STAMP(pb + 10);
}
__global__ void __launch_bounds__(NTHR, 2) mk_fwd(Args args) {
    extern __shared__ __attribute__((aligned(16))) unsigned char lds_raw[];
    Frame F;
    F.lds = (LAS unsigned char*)lds_raw;
    F.tid = threadIdx.x; F.lane = F.tid & 63; F.wave = __builtin_amdgcn_readfirstlane(F.tid >> 6);
    F.bid = blockIdx.x; F.G = gridDim.x; F.ws = args.ws; F.out = args.out;
    volatile LAS unsigned* MISC = (volatile LAS unsigned*)(F.lds + MISC_OFF);
    for (int u = F.tid; u < (LDS_BYTES - LDSCTL_OFF) / 4; u += NTHR) ((LAS unsigned*)(F.lds + LDSCTL_OFF))[u] = 0u;
    __syncthreads();
    if (F.tid == 0) {
#pragma unroll
        for (int i = 0; i < 29; ++i) ((unsigned long long LAS*)(F.lds + PTR_OFF))[i] = (unsigned long long)args.in[i];
    }
    __syncthreads();
    const int lo = args.ph_lo, hi = args.ph_hi;
    XcdBarrier bar; bar.bar = (unsigned*)(F.ws + WS_CTL) + CW_BAR; bar.x = 0; bar.st = nullptr;
    if (hi - lo > 1) bar = xcd_barrier_post((unsigned*)(F.ws + WS_CTL) + CW_BAR, MISC + 8);
#if PROBE_MASK
    if (blockIdx.x == 0 && threadIdx.x == 0) ((unsigned long long*)(F.ws + WS_CTL + 32768))[0] = __builtin_amdgcn_s_memrealtime();
#endif
    if (PH_IN(0)) phase_pro_a(F);
#if ONE_LAUNCH
    if (PH_IN(0) && PH_IN(1)) cg::this_grid().sync();
    PH_STAMP(0);
#else
    PH_SEAM(0);
#endif
    if (PH_IN(1)) norm_phase(F, 0, nullptr, nullptr, 0, 0, INP(I_NMPRE), 0, 0, 1, 0);
    PH_SEAM(1);
    layer_phases<0>(F, lo, hi, bar);
    layer_phases<1>(F, lo, hi, bar);
    layer_phases<2>(F, lo, hi, bar);
    layer_phases<3>(F, lo, hi, bar);
#if PROBE_SUB >= 0
    if (blockIdx.x == 0 && threadIdx.x == 0) {
        const unsigned long long tot = ((volatile LAS unsigned*)(F.lds + 131072 + 2048))[PROBE_SUB];
        const unsigned long long t0 = __builtin_amdgcn_s_memrealtime();
        while (__builtin_amdgcn_s_memrealtime() - t0 < tot * PROBE_AMP) __builtin_amdgcn_s_sleep(8);
    }
#endif
#if PROBE_MASK
    if (blockIdx.x == 0 && threadIdx.x == 0) {
        asm volatile("s_waitcnt vmcnt(0)" ::: "memory");
        volatile unsigned long long* ts = (volatile unsigned long long*)(F.ws + WS_CTL + 32768);
        unsigned long long tot = 0;
        for (int k = 0; k < NPHASE; ++k) {
            const int bit = k == 0 ? 12 : k == 1 ? 13 : (k - 2) % NPL;
            if ((PROBE_MASK >> bit) & 1) tot += ts[k + 1] - ts[k];
        }
        const unsigned long long t0 = __builtin_amdgcn_s_memrealtime();
        while (__builtin_amdgcn_s_memrealtime() - t0 < tot * PROBE_AMP) __builtin_amdgcn_s_sleep(8);
    }
#endif
}

extern "C" void kernel_launch(void* const* d_in, const int* in_sizes, int n_in, void* d_out, int out_size, void* d_ws, size_t ws_size, hipStream_t stream) {
    static int grid = 0;
    if (grid == 0) {
        if (n_in != 29 || ws_size < WS_END) { fprintf(stderr, "kernel_launch: unexpected n_in %d or ws %zu < %zu\n", n_in, ws_size, (size_t)WS_END); grid = -1; return; }
        int dev = 0, cus = 0, per_cu = 0;
        hipGetDevice(&dev); hipDeviceGetAttribute(&cus, hipDeviceAttributeMultiprocessorCount, dev);
        hipFuncSetAttribute((const void*)mk_fwd, hipFuncAttributeMaxDynamicSharedMemorySize, LDS_BYTES);
        hipOccupancyMaxActiveBlocksPerMultiprocessor(&per_cu, (const void*)mk_fwd, NTHR, LDS_BYTES);
        if (per_cu < 1) { fprintf(stderr, "kernel_launch: occupancy query says %d blocks per CU\n", per_cu); grid = -1; return; }
        grid = cus;
        if (grid != 256) { fprintf(stderr, "kernel_launch: built for a 256-CU device (the phase program's work maps assume 256 workgroups), found %d CUs\n", cus); grid = -1; return; }
    }
    if (grid < 0) return;
    hipMemsetAsync((char*)d_ws + WS_CTL, 0, CTL_ZERO_BYTES, stream);
    Args a{};
    for (int i = 0; i < 29; ++i) a.in[i] = (const float*)d_in[i];
    a.out = (float*)d_out; a.ws = (unsigned char*)d_ws;
    { a.ph_lo = 0; a.ph_hi = NPHASE; void* kargs[] = {&a};
      hipLaunchCooperativeKernel((const void*)mk_fwd, dim3(grid), dim3(NTHR), kargs, LDS_BYTES, stream); }
}
```

```cpp
#include <hip/hip_runtime.h>
#include <hip/hip_bf16.h>
#include <hip/hip_cooperative_groups.h>
#include <cstdio>
#include <cstdint>
#include <math.h>
namespace cg = cooperative_groups;

namespace pg8 {
#define PG8_LAS __attribute__((address_space(3)))
typedef unsigned short bf16_t;
typedef short bf16x8 __attribute__((ext_vector_type(8)));
typedef float f32x4 __attribute__((ext_vector_type(4)));
typedef unsigned u32x4 __attribute__((ext_vector_type(4)));
constexpr int BM = 256, BK = 64, HALF = 128, HTB = HALF * BK * 2  , STAGE_BYTES = 8 * HTB, NXCD = 8, WGM = 8;

__host__ __device__ __forceinline__ int lds_byte(int r, int c) { const int st = (r >> 4) * 2 + (c >> 5), rr = r & 15, cc = c & 31, ob = rr * 64 + cc * 2; return st * 1024 + (ob ^ (((ob >> 9) & 1) << 5)); }
__host__ __device__ __forceinline__ void stage_rc(int b, int& R, int& C) { const int st = b / 1024, sb = b % 1024, swz = sb ^ (((sb >> 9) & 1) << 5); R = (st >> 1) * 16 + swz / 64; C = (st & 1) * 32 + (swz % 64) / 2; }
__host__ __device__ __forceinline__ int perm32(int rho) { const int n = rho >> 4, i = rho & 15; return 8 * (i >> 2) + 4 * n + (i & 3); }

struct Unit { int pm, pn, k0t, nt, slot; };
struct Gemm { const bf16_t* A; const bf16_t* Bt; int M, N, K; };

struct StaticOrder {
    int nM, nN, nwg, G, c, ntk;
    __host__ __device__ void init(int M, int N, int G_, int c_, int K_ = 0) { nM = M / BM; nN = N / BM; nwg = nM * nN; G = G_; c = c_; ntk = K_ / BK; }
    __host__ __device__ bool next(int i, Unit& u) const {
        const long L = (long)i * G + c; if (L >= nwg) return false;
        int wgid = (int)L; { const int q = nwg / NXCD, r = nwg % NXCD, xcd = wgid % NXCD, off = wgid / NXCD; wgid = (xcd < r ? xcd * (q + 1) : r * (q + 1) + (xcd - r) * q) + off; }
        const int nig = WGM * nN, gid = wgid / nig, fm = gid * WGM, gsz = (nM - fm) < WGM ? (nM - fm) : WGM;
        u.pm = fm + ((wgid % nig) % gsz); u.pn = (wgid % nig) / gsz; u.k0t = 0; u.nt = ntk; u.slot = -1; return true;
    }
    __device__ __forceinline__ void a_ready(const Unit&) const {}
    __device__ __forceinline__ void done(const Unit&) const {}
};

__device__ __forceinline__ unsigned cvt_pk_bf16(float lo, float hi) { unsigned r; asm volatile("v_cvt_pk_bf16_f32 %0, %1, %2" : "=v"(r) : "v"(lo), "v"(hi)); return r; }
typedef float f32x2 __attribute__((ext_vector_type(2)));
__device__ __forceinline__ f32x2 gelu_pk(f32x2 v) {
    const f32x2 av = __builtin_elementwise_abs(v), d = av * 0.2316418882f + 1.0f;
    f32x2 t; t.x = __builtin_amdgcn_rcpf(d.x); t.y = __builtin_amdgcn_rcpf(d.y);
    f32x2 q = t * 0.5307027145f + (-0.7265760135f); q = q * t + 0.7107068705f; q = q * t + (-0.142248368f); q = q * t + 0.127414796f; q = q * t;
    const f32x2 s = (v * v) * (-0.72134752044f);
    f32x2 e; e.x = __builtin_amdgcn_exp2f(s.x); e.y = __builtin_amdgcn_exp2f(s.y);
    const f32x2 m = v * (q * e), r = v - m;
    f32x2 o; o.x = v.x < 0.f ? m.x : r.x; o.y = v.y < 0.f ? m.y : r.y; return o;
}

template <int ACT  > struct EpiBf16 {
    static constexpr bool PERM = true, AFTER_DRAIN = false; static_assert(ACT == 0 || ACT == 1, "EpiBf16: ACT is 0 (none) or 1 (gelu_pk)");
    bf16_t* O; int ldc; const float* bias; int split_cols; size_t split_stride; float scale0;
    __device__ __forceinline__ void operator()(const f32x4 (&acc)[2][2][4][2], const Unit& u, int wr, int wc, int fr, int fq) const {
        const int row0 = u.pm * BM + wr * 64 + fr; int colt = u.pn * BM; bf16_t* base = O;
        float sc = 1.f; if (split_cols) { const int t = colt / split_cols; base += (size_t)t * split_stride; colt -= t * split_cols; if (t == 0) sc = scale0; }
        const int col0 = colt + wc * 32 + 8 * fq, bcol0 = u.pn * BM + wc * 32 + 8 * fq;
        f32x4 bv[2][2];
#pragma unroll
        for (int bj = 0; bj < 2; ++bj)
#pragma unroll
            for (int n = 0; n < 2; ++n) bv[bj][n] = bias ? *(const f32x4*)(bias + bcol0 + bj * HALF + 4 * n) : (f32x4){0.f, 0.f, 0.f, 0.f};
#pragma unroll
        for (int ai = 0; ai < 2; ++ai)
#pragma unroll
            for (int m = 0; m < 4; ++m) { bf16_t* rowp = base + (size_t)(row0 + ai * HALF + m * 16) * ldc + col0;
#pragma unroll
                for (int bj = 0; bj < 2; ++bj) { f32x4 v0 = acc[ai][bj][m][0] + bv[bj][0], v1 = acc[ai][bj][m][1] + bv[bj][1];
                    if (ACT == 1) { f32x2 a = gelu_pk((f32x2){v0[0], v0[1]}), b = gelu_pk((f32x2){v0[2], v0[3]}), c = gelu_pk((f32x2){v1[0], v1[1]}), d = gelu_pk((f32x2){v1[2], v1[3]});
                        v0 = (f32x4){a.x, a.y, b.x, b.y}; v1 = (f32x4){c.x, c.y, d.x, d.y}; }
                    v0 = v0 * sc; v1 = v1 * sc; u32x4 w; w.x = cvt_pk_bf16(v0[0], v0[1]); w.y = cvt_pk_bf16(v0[2], v0[3]); w.z = cvt_pk_bf16(v1[0], v1[1]); w.w = cvt_pk_bf16(v1[2], v1[3]);
                    *(u32x4*)(rowp + bj * HALF) = w; } }
    }
};

struct EpiF32 {
    static constexpr bool PERM = false, AFTER_DRAIN = false;
    float* C; int ldc; const float* bias; float* part;
    __device__ __forceinline__ void operator()(const f32x4 (&acc)[2][2][4][2], const Unit& u, int wr, int wc, int fr, int fq) const {
        const int row0 = (u.slot >= 0 ? (u.slot * 4 + u.pm / 17) * BM : u.pm * BM) + wr * 64 + fr, col0 = u.pn * BM + wc * 32 + 4 * fq;
        float* const Cb = u.slot >= 0 ? part : C;
        f32x4 bv[2][2];
#pragma unroll
        for (int bj = 0; bj < 2; ++bj)
#pragma unroll
            for (int n = 0; n < 2; ++n) bv[bj][n] = bias ? *(const f32x4*)(bias + col0 + bj * HALF + n * 16) : (f32x4){0.f, 0.f, 0.f, 0.f};
#pragma unroll
        for (int ai = 0; ai < 2; ++ai)
#pragma unroll
            for (int m = 0; m < 4; ++m) { float* rowp = Cb + (size_t)(row0 + ai * HALF + m * 16) * ldc + col0;
#pragma unroll
                for (int bj = 0; bj < 2; ++bj)
#pragma unroll
                    for (int n = 0; n < 2; ++n) *(f32x4*)(rowp + bj * HALF + n * 16) = acc[ai][bj][m][n] + bv[bj][n]; }
    }
};

struct EpiBf16P {
    static constexpr bool PERM = true, AFTER_DRAIN = false;
    bf16_t* O; int ldc; float* part;
    __device__ __forceinline__ void operator()(const f32x4 (&acc)[2][2][4][2], const Unit& u, int wr, int wc, int fr, int fq) const {
        const int col0 = u.pn * BM + wc * 32 + 8 * fq;
        if (u.slot < 0) {
            const int row0 = u.pm * BM + wr * 64 + fr;
#pragma unroll
            for (int ai = 0; ai < 2; ++ai)
#pragma unroll
                for (int m = 0; m < 4; ++m) { bf16_t* rowp = O + (size_t)(row0 + ai * HALF + m * 16) * ldc + col0;
#pragma unroll
                    for (int bj = 0; bj < 2; ++bj) { const f32x4 v0 = acc[ai][bj][m][0], v1 = acc[ai][bj][m][1];
                        u32x4 w; w.x = cvt_pk_bf16(v0[0], v0[1]); w.y = cvt_pk_bf16(v0[2], v0[3]); w.z = cvt_pk_bf16(v1[0], v1[1]); w.w = cvt_pk_bf16(v1[2], v1[3]);
                        *(u32x4*)(rowp + bj * HALF) = w; } }
        } else {
            const int row0 = (u.slot * 4 + u.pm / 17) * BM + wr * 64 + fr;
#pragma unroll
            for (int ai = 0; ai < 2; ++ai)
#pragma unroll
                for (int m = 0; m < 4; ++m) { float* rowp = part + (size_t)(row0 + ai * HALF + m * 16) * ldc + col0;
#pragma unroll
                    for (int bj = 0; bj < 2; ++bj) { *(f32x4*)(rowp + bj * HALF) = acc[ai][bj][m][0]; *(f32x4*)(rowp + bj * HALF + 4) = acc[ai][bj][m][1]; } }
        }
    }
};
template <class Epi, class Sched, bool ALIGN_EPI = false, bool SP2 = false>
__device__ __forceinline__ void gemm_phase(PG8_LAS unsigned char* lds, const Gemm g, const Sched& S, const Epi& E) {
    const int tid = threadIdx.x, wid = __builtin_amdgcn_readfirstlane(tid >> 6), lane = tid & 63, wr = wid >> 2, wc = wid & 3, fr = lane & 15, fq = lane >> 4;
    const int K = g.K;
    unsigned voffA[2], voffB[2];
#pragma unroll
    for (int i = 0; i < 2; ++i) { int R, C; stage_rc(tid * 16 + i * 8192, R, C); const int Rb = Epi::PERM ? ((R & ~31) + perm32(R & 31)) : R;
        voffA[i] = (unsigned)(R * K + C) * 2u; voffB[i] = (unsigned)(Rb * K + C) * 2u; }
    const size_t kstep = (size_t)(BK * 2);
    const size_t hstep = (size_t)HALF * K * 2;
    const size_t tstep = 2 * hstep;
    const unsigned ldsw = (unsigned)wid * 1024u;
    const int aoff = lds_byte(wr * 64 + fr, fq * 8), boff = lds_byte(wc * 32 + fr, fq * 8);
#define PG8_SA(b, h) (((b) * 2 + (h)) * HTB)
#define PG8_SB(b, h) ((4 + (b) * 2 + (h)) * HTB)
#define PG8_STAGE(bufoff, gbase, voff) do { _Pragma("unroll") for (int _i = 0; _i < 2; ++_i) \
        __builtin_amdgcn_global_load_lds((const unsigned*)((const char*)(gbase) + (voff)[_i]), (PG8_LAS unsigned*)(lds + (bufoff) + ldsw + _i * 8192), 16, 0, 0); } while (0)
#define PG8_LDA(dst, b, h) do { _Pragma("unroll") for (int m = 0; m < 4; ++m) _Pragma("unroll") for (int k = 0; k < 2; ++k) dst[m][k] = *(const PG8_LAS bf16x8*)(lds + PG8_SA(b, h) + aoff + m * 2048 + k * 1024); } while (0)
#define PG8_LDB(dst, b, h) do { _Pragma("unroll") for (int n = 0; n < 2; ++n) _Pragma("unroll") for (int k = 0; k < 2; ++k) dst[n][k] = *(const PG8_LAS bf16x8*)(lds + PG8_SB(b, h) + boff + n * 2048 + k * 1024); } while (0)
#define PG8_MMA(ai, bj, At, Bt) do { __builtin_amdgcn_s_setprio(1); _Pragma("unroll") for (int m = 0; m < 4; ++m) _Pragma("unroll") for (int n = 0; n < 2; ++n) _Pragma("unroll") for (int k = 0; k < 2; ++k) \
        acc[ai][bj][m][n] = __builtin_amdgcn_mfma_f32_16x16x32_bf16(Bt[n][k], At[m][k], acc[ai][bj][m][n], 0, 0, 0); __builtin_amdgcn_s_setprio(0); } while (0)
#define PG8_WAIT_V(n) asm volatile("s_waitcnt vmcnt(" #n ")" ::: "memory")
#define PG8_WAIT_L(n) asm volatile("s_waitcnt lgkmcnt(" #n ")" ::: "memory")
#define PG8_BAR __builtin_amdgcn_s_barrier()
#define PG8_SCHED __builtin_amdgcn_sched_barrier(0)
    Unit cur, nxt; int ui = 0;
    if (!S.next(0, cur)) return;
    f32x4 acc[2][2][4][2];
#pragma unroll
    for (int a = 0; a < 2; ++a)
#pragma unroll
        for (int b = 0; b < 2; ++b)
#pragma unroll
            for (int m = 0; m < 4; ++m)
#pragma unroll
                for (int n = 0; n < 2; ++n) acc[a][b][m][n] = (f32x4){0.f, 0.f, 0.f, 0.f};
    bf16x8 At[4][2], B0[2][2], B1[2][2];
    const char* cA = (const char*)g.A + (size_t)cur.pm * tstep + (size_t)cur.k0t * kstep; const char* cB = (const char*)g.Bt + (size_t)cur.pn * tstep + (size_t)cur.k0t * kstep;
    S.a_ready(cur);
    if constexpr (SP2) {
        PG8_STAGE(PG8_SB(0, 0), cB, voffB); PG8_STAGE(PG8_SB(0, 1), cB + hstep, voffB); PG8_STAGE(PG8_SA(0, 0), cA, voffA); PG8_STAGE(PG8_SA(0, 1), cA + hstep, voffA);
        if (wr == 1) PG8_BAR;
        PG8_WAIT_V(2); PG8_BAR;
        PG8_STAGE(PG8_SB(1, 0), cB + kstep, voffB); PG8_STAGE(PG8_SA(1, 0), cA + kstep, voffA); PG8_STAGE(PG8_SB(1, 1), cB + hstep + kstep, voffB);
        PG8_WAIT_V(6); PG8_BAR;
    } else {
        PG8_STAGE(PG8_SB(0, 0), cB, voffB); PG8_STAGE(PG8_SA(0, 0), cA, voffA); PG8_STAGE(PG8_SB(0, 1), cB + hstep, voffB); PG8_STAGE(PG8_SA(0, 1), cA + hstep, voffA);
        if (wr == 1) PG8_BAR;
        PG8_WAIT_V(4); PG8_BAR;
        PG8_STAGE(PG8_SB(1, 0), cB + kstep, voffB); PG8_STAGE(PG8_SA(1, 0), cA + kstep, voffA); PG8_STAGE(PG8_SB(1, 1), cB + hstep + kstep, voffB);
        PG8_WAIT_V(6); PG8_BAR;
    }
    for (;;) {
        const bool has_next = S.next(ui + 1, nxt);
        const char* nA = has_next ? (const char*)g.A + (size_t)nxt.pm * tstep + (size_t)nxt.k0t * kstep : cA; const char* nB = has_next ? (const char*)g.Bt + (size_t)nxt.pn * tstep + (size_t)nxt.k0t * kstep : cB;
        const int nt = cur.nt;
        for (int t = 0; t < nt; t += 2) {
            const bool last = (t == nt - 2);
            const char* a1 = cA + (size_t)(t + 1) * kstep;
            const char* a2 = last ? nA : cA + (size_t)(t + 2) * kstep; const char* b2 = last ? nB : cB + (size_t)(t + 2) * kstep;
            const char* a3 = a2 + kstep; const char* b3 = b2 + kstep;
            if (last && has_next) S.a_ready(nxt);
            if constexpr (SP2) {
            PG8_LDB(B0, 0, 0); PG8_LDB(B1, 0, 1); PG8_SCHED; PG8_LDA(At, 0, 0); PG8_STAGE(PG8_SA(1, 1), a1 + hstep, voffA);
            PG8_WAIT_V(8); PG8_WAIT_L(0); PG8_BAR; PG8_MMA(0, 0, At, B0); PG8_MMA(0, 1, At, B1); PG8_BAR; PG8_SCHED;
            PG8_LDA(At, 0, 1); PG8_STAGE(PG8_SB(0, 0), b2, voffB); PG8_STAGE(PG8_SB(0, 1), b2 + hstep, voffB); PG8_STAGE(PG8_SA(0, 0), a2, voffA);
            PG8_WAIT_V(8); PG8_WAIT_L(0); PG8_BAR; PG8_MMA(1, 0, At, B0); PG8_MMA(1, 1, At, B1); PG8_BAR; PG8_SCHED;
            PG8_LDB(B0, 1, 0); PG8_LDB(B1, 1, 1); PG8_SCHED; PG8_LDA(At, 1, 0); PG8_STAGE(PG8_SA(0, 1), a2 + hstep, voffA);
            PG8_WAIT_V(8); PG8_WAIT_L(0); PG8_BAR; PG8_MMA(0, 0, At, B0); PG8_MMA(0, 1, At, B1); PG8_BAR; PG8_SCHED;
            PG8_LDA(At, 1, 1); PG8_STAGE(PG8_SB(1, 0), b3, voffB); PG8_STAGE(PG8_SB(1, 1), b3 + hstep, voffB); PG8_STAGE(PG8_SA(1, 0), a3, voffA);
            PG8_WAIT_V(8); PG8_WAIT_L(0); PG8_BAR; PG8_MMA(1, 0, At, B0); PG8_MMA(1, 1, At, B1); PG8_BAR; PG8_SCHED;
            } else {
            PG8_LDB(B0, 0, 0); PG8_SCHED; PG8_LDA(At, 0, 0); PG8_STAGE(PG8_SA(1, 1), a1 + hstep, voffA);
            PG8_WAIT_L(8); PG8_BAR; PG8_WAIT_L(0); PG8_MMA(0, 0, At, B0); PG8_BAR; PG8_SCHED;
            PG8_LDB(B1, 0, 1); PG8_STAGE(PG8_SB(0, 0), b2, voffB);
            PG8_BAR; PG8_WAIT_L(0); PG8_MMA(0, 1, At, B1); PG8_BAR;
            PG8_LDA(At, 0, 1); PG8_STAGE(PG8_SA(0, 0), a2, voffA);
            PG8_BAR; PG8_WAIT_L(0); PG8_MMA(1, 0, At, B0); PG8_BAR; PG8_SCHED;
            PG8_STAGE(PG8_SB(0, 1), b2 + hstep, voffB);
            PG8_WAIT_V(6); PG8_BAR; PG8_MMA(1, 1, At, B1); PG8_BAR;
            PG8_LDB(B0, 1, 0); PG8_SCHED; PG8_LDA(At, 1, 0); PG8_STAGE(PG8_SA(0, 1), a2 + hstep, voffA);
            PG8_WAIT_L(8); PG8_BAR; PG8_WAIT_L(0); PG8_MMA(0, 0, At, B0); PG8_BAR; PG8_SCHED;
            PG8_LDB(B1, 1, 1); PG8_STAGE(PG8_SB(1, 0), b3, voffB);
            PG8_BAR; PG8_WAIT_L(0); PG8_MMA(0, 1, At, B1); PG8_BAR;
            PG8_LDA(At, 1, 1); PG8_STAGE(PG8_SA(1, 0), a3, voffA);
            PG8_BAR; PG8_WAIT_L(0); PG8_MMA(1, 0, At, B0); PG8_BAR; PG8_SCHED;
            PG8_STAGE(PG8_SB(1, 1), b3 + hstep, voffB);
            PG8_WAIT_V(6); PG8_BAR; PG8_MMA(1, 1, At, B1); PG8_BAR;
            }
        }
        if constexpr (ALIGN_EPI) { if (wr == 0) PG8_BAR; }
        if constexpr (!Epi::AFTER_DRAIN) { E(acc, cur, wr, wc, fr, fq); S.done(cur); }
        if (!has_next) break;
#pragma unroll
        for (int a = 0; a < 2; ++a)
#pragma unroll
            for (int b = 0; b < 2; ++b)
#pragma unroll
                for (int m = 0; m < 4; ++m)
#pragma unroll
                    for (int n = 0; n < 2; ++n) acc[a][b][m][n] = (f32x4){0.f, 0.f, 0.f, 0.f};
        cur = nxt; cA = nA; cB = nB; ++ui;
        if constexpr (ALIGN_EPI) { if (wr == 1) PG8_BAR; }
    }
    PG8_WAIT_V(0);
    if constexpr (!ALIGN_EPI) { if (wr == 0) PG8_BAR; }
    PG8_BAR;
    if constexpr (Epi::AFTER_DRAIN) { E.fused(acc, cur, wr, wc, fr, fq, lds, wid, lane); S.done(cur); }
#undef PG8_SA
#undef PG8_SB
#undef PG8_STAGE
#undef PG8_LDA
#undef PG8_LDB
#undef PG8_MMA
#undef PG8_WAIT_V
#undef PG8_WAIT_L
#undef PG8_BAR
#undef PG8_SCHED
}
}

#ifndef ATTN_FAST
#define ATTN_FAST 1
#endif
#ifndef SCAN_FAST
#define SCAN_FAST 1
#endif
#ifndef PROBE_MASK
#define PROBE_MASK 0
#endif
#ifndef PROBE_AMP
#define PROBE_AMP 8
#endif
#ifndef PROBE_SUB
#define PROBE_SUB -1
#endif
#if PROBE_SUB >= 0
#define SUBT(k) do { if (F.bid == 0 && F.wave == 0) { volatile __attribute__((address_space(3))) unsigned* a_ = (volatile __attribute__((address_space(3))) unsigned*)(F.lds + 131072 + 2048); \
        const unsigned n_ = (unsigned)__builtin_amdgcn_s_memrealtime(); a_[(k)] += n_ - a_[31]; a_[31] = n_; } } while (0)
#else
#define SUBT(k) do { } while (0)
#endif
#ifndef SCAN_CHUNKED
#define SCAN_CHUNKED 1
#endif
#ifndef PREP_REP
#define PREP_REP 0
#endif
#ifndef SCANA_REP
#define SCANA_REP 0
#endif
#ifndef SCAN_DEBUG
#define SCAN_DEBUG 0
#endif
#ifndef ONE_LAUNCH
#define ONE_LAUNCH 1
#endif
constexpr int NWAVES = 8, NTHR = 512;
constexpr int D = 1024, NB = 4, TL = 4096, CT = 256, SB = CT + TL  , NL = 4;
constexpr int M = NB * SB;
constexpr int NIN = 2688, NINP = 2816, DFF = 2816, DFF2 = 5632;
constexpr int R_IN = 1152, R_OFF = 768, C_OFF = 1920, K_OFF = 512, V_OFF = 640;
constexpr float NORM_EPS = 1e-6f, GN_EPS = 64e-5f, DECAY_SCALE = 0.606531f;
constexpr float C2 = 0.125f * 1.4426950408889634f;

typedef unsigned short bf16;
typedef unsigned v4u __attribute__((ext_vector_type(4)));
typedef unsigned v2u __attribute__((ext_vector_type(2)));
typedef float f32x4 __attribute__((ext_vector_type(4)));
#define LAS __attribute__((address_space(3)))
#define GAS __attribute__((address_space(1)))
typedef GAS unsigned gu32;
#define RLX_AGENT __ATOMIC_RELAXED, __HIP_MEMORY_SCOPE_AGENT

constexpr size_t MiB = 1u << 20;
constexpr size_t WS_CTL = 0, CTL_ZERO_BYTES = 1 * MiB;
constexpr size_t WS_MODS = 1 * MiB;
constexpr size_t WS_ROPE = WS_MODS + 512 * 1024;
constexpr size_t WS_LR = WS_ROPE + 1 * MiB;
constexpr size_t WS_XCUR = 3 * MiB;
constexpr size_t SZ_XCUR = (size_t)M * D * 4;
constexpr size_t WS_WIN = WS_XCUR + SZ_XCUR;
constexpr size_t WS_WOUT = WS_WIN + (size_t)NINP * D * 2;
constexpr size_t WS_WUP = WS_WOUT + (size_t)D * D * 2;
constexpr size_t WS_WDN = WS_WUP + (size_t)DFF2 * D * 2;
constexpr size_t WS_AR = WS_WDN + (size_t)D * DFF * 2;
constexpr size_t SZ_BF_MD = (size_t)M * D * 2;
constexpr size_t SZ_BF_M256 = (size_t)M * 256 * 2;
constexpr size_t AR_XN = 0;
constexpr size_t AR_Y = 0;
constexpr size_t AR_U = AR_XN + SZ_BF_MD;
constexpr size_t AR_MIXO = AR_U;
constexpr size_t AR_R = AR_U + (size_t)M * NINP * 2;
constexpr size_t AR_V = AR_R + SZ_BF_M256;
constexpr size_t AR_KK = AR_V + SZ_BF_M256;
constexpr size_t AR_G = AR_KK + SZ_BF_M256;
constexpr size_t AR_KE = AR_G + SZ_BF_M256;
constexpr size_t AR_KKA = AR_KE + 2 * SZ_BF_M256;
constexpr size_t AR_W = AR_KKA + 2 * SZ_BF_M256;
constexpr size_t AR_MIX = AR_W + (size_t)2 * M * 256 * 4;
constexpr size_t AR_QKV = AR_MIX + SZ_BF_MD;
constexpr int QKVP = 768;
constexpr size_t AR_END1 = AR_QKV + (size_t)M * QKVP * 2;
constexpr size_t AR_ACT = 0;
constexpr size_t AR_H = AR_ACT + (size_t)M * DFF * 2;
constexpr size_t AR_FO = AR_H;
constexpr size_t AR_PART = AR_H + (size_t)M * D * 4;
constexpr size_t AR_END2 = AR_H + (size_t)M * DFF2 * 2;
constexpr size_t WS_END = WS_AR + (AR_END1 > AR_END2 ? AR_END1 : AR_END2);
static_assert(WS_END <= 384 * MiB, "workspace budget");
constexpr int CW_BAR = 4096;

constexpr int LDS_BYTES = 147456;
constexpr int RING_BYTES = 131072, LDSCTL_OFF = RING_BYTES, MISC_OFF = LDSCTL_OFF + 320;

typedef float cvt_f32x2 __attribute__((ext_vector_type(2))); typedef __bf16 cvt_bf16x2 __attribute__((ext_vector_type(2)));
__device__ __forceinline__ unsigned pk2(float lo, float hi) { cvt_f32x2 v = {lo, hi}; cvt_bf16x2 b = __builtin_convertvector(v, cvt_bf16x2); return __builtin_bit_cast(unsigned, b); }
__device__ __forceinline__ unsigned f2bf(float f) { return pk2(f, f) & 0xffffu; }
__device__ __forceinline__ float bf2f(unsigned short b) { return __builtin_bit_cast(float, ((unsigned)b) << 16); }
__device__ __forceinline__ float bflo(unsigned w) { return __builtin_bit_cast(float, w << 16); }
__device__ __forceinline__ float bfhi(unsigned w) { return __builtin_bit_cast(float, w & 0xffff0000u); }
__device__ __forceinline__ float sigm(float x) { return __builtin_amdgcn_rcpf(1.f + __expf(-x)); }
#define LDS_WAIT() asm volatile("s_waitcnt lgkmcnt(0)" ::: "memory")
#define LDS_BARRIER() do { asm volatile("s_waitcnt lgkmcnt(0)" ::: "memory"); __builtin_amdgcn_s_barrier(); asm volatile("" ::: "memory"); } while (0)
__device__ __forceinline__ float red16(float x) {
    float r;
    asm("s_nop 1\n\tv_add_f32_dpp %0, %1, %1 quad_perm:[1,0,3,2] row_mask:0xf bank_mask:0xf\n\ts_nop 1\n\t"
        "v_add_f32_dpp %0, %0, %0 quad_perm:[2,3,0,1] row_mask:0xf bank_mask:0xf\n\ts_nop 1\n\t"
        "v_add_f32_dpp %0, %0, %0 row_half_mirror row_mask:0xf bank_mask:0xf\n\ts_nop 1\n\t"
        "v_add_f32_dpp %0, %0, %0 row_mirror row_mask:0xf bank_mask:0xf\n\ts_nop 0" : "=&v"(r) : "v"(x));
    return r;
}
__device__ __forceinline__ float sum8(float x) {
    float r;
    asm("s_nop 1\n\tv_add_f32_dpp %0, %1, %1 quad_perm:[1,0,3,2] row_mask:0xf bank_mask:0xf\n\ts_nop 1\n\t"
        "v_add_f32_dpp %0, %0, %0 quad_perm:[2,3,0,1] row_mask:0xf bank_mask:0xf\n\ts_nop 1\n\t"
        "v_add_f32_dpp %0, %0, %0 row_half_mirror row_mask:0xf bank_mask:0xf\n\ts_nop 0" : "=&v"(r) : "v"(x));
    return r;
}
__device__ __forceinline__ float wave_sum(float v) { v = red16(v); v += __shfl_xor(v, 16); v += __shfl_xor(v, 32); return v; }

#define XB_TMO      128
#define XB_XCNT(j)  (256  + 64 * (j))
#define XB_XSUB(j)  (1280 + 64 * (j))
#define XB_XGEN(j)  (2304 + 64 * (j))
#define XB_TOP      3328
#define XB_TOPGEN   3392
#define XCD_BAR_WORDS 3456
#define XB_SPIN_CAP (1u << 18)
__device__ __forceinline__ unsigned xb_ld(unsigned* p)              { return __hip_atomic_load(p, __ATOMIC_RELAXED, __HIP_MEMORY_SCOPE_AGENT); }
__device__ __forceinline__ unsigned xb_add(unsigned* p, unsigned v) { return __hip_atomic_fetch_add(p, v, __ATOMIC_RELAXED, __HIP_MEMORY_SCOPE_AGENT); }
__device__ __forceinline__ unsigned xb_xcc_id() { return (unsigned)__builtin_amdgcn_s_getreg((3 << 11) | 20) & 0xFu; }
#define XB_SPIN(cond, bar) do { unsigned _sp = 0; while (cond) { __builtin_amdgcn_s_sleep(1); \
    if ((++_sp & 255u) == 0u) { if (xb_ld(&(bar)[XB_TMO])) break; if (_sp > XB_SPIN_CAP) { atomicAdd(&(bar)[XB_TMO], 1u); break; } } } } while (0)
struct XcdBarrier { unsigned* bar; unsigned x; volatile LAS unsigned* st; };
__device__ __forceinline__ XcdBarrier xcd_barrier_post(unsigned* bar, volatile LAS unsigned* st) {
    XcdBarrier b; b.bar = bar; b.x = xb_xcc_id(); b.st = st;
    if (threadIdx.x == 0) (void)xb_add(&bar[XB_XCNT(b.x)], 1u);
    return b;
}
__device__ __forceinline__ void xcd_barrier_complete(unsigned* bar, unsigned x, unsigned& nloc, unsigned& nx) {
    const unsigned G = gridDim.x * gridDim.y * gridDim.z;
    unsigned sum, cnt, mine, sp = 0u;
    for (;;) {
        sum = 0u; cnt = 0u; mine = 0u;
#pragma unroll
        for (unsigned j = 0; j < 16; ++j) { const unsigned c = xb_ld(&bar[XB_XCNT(j)]); sum += c; cnt += (c > 0u) ? 1u : 0u; mine = (j == x) ? c : mine; }
        if (sum == G) break;
        __builtin_amdgcn_s_sleep(1);
        if ((++sp & 255u) == 0u) { if (xb_ld(&bar[XB_TMO])) break; if (sp > XB_SPIN_CAP) { atomicAdd(&bar[XB_TMO], 1u); break; } }
    }
    nloc = mine > 0u ? mine : 1u; nx = cnt > 0u ? cnt : 1u;
}
__device__ __forceinline__ void xcd_barrier(const XcdBarrier& b) {
    asm volatile("s_waitcnt vmcnt(0)" ::: "memory");
    __syncthreads();
    if (threadIdx.x == 0) {
        unsigned* bar = b.bar;
        __builtin_amdgcn_s_waitcnt(0);
        unsigned nloc = b.st[0], nx = b.st[1];
        if (nloc == 0u) { xcd_barrier_complete(bar, b.x, nloc, nx); b.st[0] = nloc; b.st[1] = nx; }
        const unsigned old = xb_add(&bar[XB_XSUB(b.x)], 1u);
        const unsigned gen = old / nloc;
        if (old + 1u == (gen + 1u) * nloc) {
            __builtin_amdgcn_fence(__ATOMIC_RELEASE, "agent");
            asm volatile("s_waitcnt vmcnt(0)" ::: "memory");
            const unsigned og = xb_add(&bar[XB_TOP], 1u);
            const unsigned tg = og / nx;
            if (og + 1u == (tg + 1u) * nx) xb_add(&bar[XB_TOPGEN], 1u);
            else XB_SPIN(xb_ld(&bar[XB_TOPGEN]) == tg, bar);
            __builtin_amdgcn_fence(__ATOMIC_ACQUIRE, "agent");
            xb_add(&bar[XB_XGEN(b.x)], 1u);
            asm volatile("s_waitcnt vmcnt(0)" ::: "memory");
        } else {
            XB_SPIN(xb_ld(&bar[XB_XGEN(b.x)]) == gen, bar);
            __builtin_amdgcn_fence(__ATOMIC_ACQUIRE, "agent");
            asm volatile("s_waitcnt vmcnt(0)" ::: "memory");
        }
    }
    __syncthreads();
}

struct Args {
    const float* in[29];
    float* out; unsigned char* ws;
    int ph_lo, ph_hi;
};
enum { I_X = 0, I_C, I_CTX, I_CCTX, I_ADAW, I_ADAB, I_NMPRE, I_NMPOST, I_NFPRE, I_NFPOST, I_WIN, I_WOUT, I_QN, I_KN, I_MU, I_W0, I_WUP, I_A0, I_AUP, I_GUP,
       I_KK, I_KA, I_RK, I_LNW, I_LNB, I_SCW, I_FUP, I_FCONV, I_FDN };

struct Frame {
    LAS unsigned char* lds;
    int tid, lane, wave, bid, G;
    unsigned char* ws;
    float* out;
};
constexpr int PTR_OFF = LDSCTL_OFF + 1024;
#define INP(i) ((const float*)(const GAS float*)(((const unsigned long long LAS*)(F.lds + PTR_OFF))[i]))

__device__ __forceinline__ void transpose_item(const float* W, int K, int N, bf16* WT, LAS float* scr, int item, int lane) {
    const int nblk = N / 32, kb = item / nblk, nb = item % nblk, k0 = 64 * kb, n0 = 32 * nb;
#pragma unroll 8
    for (int i = 0; i < 32; ++i) { const int kk = 2 * i + (lane >> 5); scr[kk * 33 + (lane & 31)] = W[(size_t)(k0 + kk) * N + n0 + (lane & 31)]; }
    LDS_WAIT(); asm volatile("" ::: "memory");
    const int c = lane & 7;
#pragma unroll
    for (int j = 0; j < 4; ++j) { const int n = (lane >> 3) + 8 * j; const LAS float* s = scr + (8 * c) * 33 + n;
        v4u o; o.x = pk2(s[0 * 33], s[1 * 33]); o.y = pk2(s[2 * 33], s[3 * 33]); o.z = pk2(s[4 * 33], s[5 * 33]); o.w = pk2(s[6 * 33], s[7 * 33]);
        *(v4u*)(WT + (size_t)(n0 + n) * K + k0 + 8 * c) = o; }
    LDS_WAIT(); asm volatile("" ::: "memory");
}
__device__ __forceinline__ void convert_weights(const Frame& F, int l) {
    LAS float* scr = (LAS float*)(F.lds + F.wave * 8448);
    const int gw = F.bid * NWAVES + F.wave, NGW = F.G * NWAVES;
    const float* w_in = INP(I_WIN) + (size_t)l * D * NIN; const float* w_out = INP(I_WOUT) + (size_t)l * D * D;
    const float* w_up = INP(I_FUP) + (size_t)l * D * DFF2; const float* w_dn = INP(I_FDN) + (size_t)l * DFF * D;
    bf16* t_in = (bf16*)(F.ws + WS_WIN); bf16* t_out = (bf16*)(F.ws + WS_WOUT); bf16* t_up = (bf16*)(F.ws + WS_WUP); bf16* t_dn = (bf16*)(F.ws + WS_WDN);
    constexpr int I_1 = (D / 64) * (NIN / 32), I_2 = (D / 64) * (D / 32), I_3 = (D / 64) * (DFF2 / 32), I_4 = (DFF / 64) * (D / 32);
    for (int it = gw; it < I_1 + I_2 + I_3 + I_4; it += NGW) {
        int r = it;
        if (r < I_1) { transpose_item(w_in, D, NIN, t_in, scr, r, F.lane); continue; } r -= I_1;
        if (r < I_2) { transpose_item(w_out, D, D, t_out, scr, r, F.lane); continue; } r -= I_2;
        if (r < I_3) { transpose_item(w_up, D, DFF2, t_up, scr, r, F.lane); continue; } r -= I_3;
        transpose_item(w_dn, DFF, D, t_dn, scr, r, F.lane);
    }
    {
        const float* wup = INP(I_WUP) + (size_t)l * 2 * 64 * 256; const float* aup = INP(I_AUP) + (size_t)l * 2 * 64 * 256; const float* gup = INP(I_GUP) + (size_t)l * 128 * 256;
        bf16* lr = (bf16*)(F.ws + WS_LR);
        for (int it = gw; it < 48; it += NGW) {
            if (it < 16) transpose_item(wup + (size_t)(it >> 3) * 64 * 256, 64, 256, lr + (size_t)(it >> 3) * 256 * 64, scr, it & 7, F.lane);
            else if (it < 32) transpose_item(aup + (size_t)((it - 16) >> 3) * 64 * 256, 64, 256, lr + 2 * 256 * 64 + (size_t)((it - 16) >> 3) * 256 * 64, scr, it & 7, F.lane);
            else transpose_item(gup, 128, 256, lr + 4 * 256 * 64, scr, it - 32, F.lane);
        }
    }
    v4u z = {0u, 0u, 0u, 0u};
    for (int i = F.bid * NTHR + F.tid; i < (NINP - NIN) * D / 8; i += F.G * NTHR) *(v4u*)(t_in + (size_t)NIN * D + (size_t)i * 8) = z;
}

__device__ __forceinline__ void phase_pro_a(const Frame& F) {
    convert_weights(F, 0);
    __syncthreads();
    float* rope = (float*)(F.ws + WS_ROPE);
    for (int e = F.bid * NTHR + F.tid; e < TL * 32; e += F.G * NTHR) {
        const int pos = e >> 5, i = e & 31;
        const float inv = powf(10000.0f, -(float)(i & 15) / 16.0f);
        const float p = (i < 16) ? (float)(pos / 64) : (float)(pos % 64);
        const float ang = p * inv;
        rope[2 * e] = cosf(ang); rope[2 * e + 1] = sinf(ang);
    }
    LAS float* sc = (LAS float*)F.lds;
    LAS float* red = (LAS float*)(F.lds + 20480);
    for (int i = F.tid; i < 5 * 1024; i += NTHR) { const int r = i >> 10, k = i & 1023; const float v = r < 4 ? INP(I_C)[r * 1024 + k] : INP(I_CCTX)[k]; sc[i] = v / (1.f + expf(-v)); }
    __syncthreads();
    float* mods = (float*)(F.ws + WS_MODS);
    for (int item = F.bid; item < NL * 96; item += F.G) {
        const int l = item / 96, jg = item % 96;
        const int c4 = (F.lane & 15) * 4, kq = F.lane >> 4;
        const float* w = INP(I_ADAW) + (size_t)l * 1024 * 6144 + jg * 64 + c4;
        f32x4 a0 = {0.f, 0.f, 0.f, 0.f}, a1 = a0, a2 = a0, a3 = a0, a4 = a0;
        const int kb = F.wave * 128;
#pragma unroll 8
        for (int i = 0; i < 32; ++i) { const int k = kb + 4 * i + kq; const f32x4 wv = *(const f32x4*)(w + (size_t)k * 6144);
            a0 += wv * sc[k]; a1 += wv * sc[1024 + k]; a2 += wv * sc[2048 + k]; a3 += wv * sc[3072 + k]; a4 += wv * sc[4096 + k]; }
#pragma unroll
        for (int e = 0; e < 4; ++e) {
            a0[e] += __shfl_xor(a0[e], 16); a0[e] += __shfl_xor(a0[e], 32); a1[e] += __shfl_xor(a1[e], 16); a1[e] += __shfl_xor(a1[e], 32);
            a2[e] += __shfl_xor(a2[e], 16); a2[e] += __shfl_xor(a2[e], 32); a3[e] += __shfl_xor(a3[e], 16); a3[e] += __shfl_xor(a3[e], 32);
            a4[e] += __shfl_xor(a4[e], 16); a4[e] += __shfl_xor(a4[e], 32); }
        if (kq == 0) {
            *(LAS f32x4*)(red + (F.wave * 5 + 0) * 64 + c4) = a0; *(LAS f32x4*)(red + (F.wave * 5 + 1) * 64 + c4) = a1; *(LAS f32x4*)(red + (F.wave * 5 + 2) * 64 + c4) = a2;
            *(LAS f32x4*)(red + (F.wave * 5 + 3) * 64 + c4) = a3; *(LAS f32x4*)(red + (F.wave * 5 + 4) * 64 + c4) = a4; }
        __syncthreads();
        if (F.tid < 320) { const int r = F.tid >> 6, j = F.tid & 63; float s_ = 0.f;
#pragma unroll
            for (int w8 = 0; w8 < 8; ++w8) s_ += red[(w8 * 5 + r) * 64 + j];
            mods[((size_t)l * 5 + r) * 6144 + jg * 64 + j] = s_ + INP(I_ADAB)[l * 6144 + jg * 64 + j]; }
        __syncthreads();
    }
}

__device__ __forceinline__ void norm_phase(const Frame& F, int mode, const float* o, const float* g_post, int lmod_gate, int i_gate,
                                           const float* g_next, int lmod_next, int i_shift, int i_scale, int nks  ) {
    const int gw = F.bid * NWAVES + F.wave, NGW = F.G * NWAVES;
    float* xcur = (float*)(F.ws + WS_XCUR); bf16* xn = (bf16*)(F.ws + WS_AR + AR_XN);
    const float* mods = (const float*)(F.ws + WS_MODS);
    const int b = gw & 3, w4 = gw >> 2, NW4 = NGW >> 2;
    f32x4 c_gp[4], c_gt[4], c_gn[4], c_sh[4], c_sc[4];
#pragma unroll
    for (int j = 0; j < 4; ++j) { const int c0 = 4 * F.lane + 256 * j; const f32x4 z4 = {0.f, 0.f, 0.f, 0.f};
        c_gp[j] = mode >= 1 ? *(const f32x4*)(g_post + c0) : z4; c_gt[j] = mode >= 1 ? *(const f32x4*)(mods + ((size_t)lmod_gate * 5 + b) * 6144 + i_gate * 1024 + c0) : z4;
        c_gn[j] = mode <= 1 ? *(const f32x4*)(g_next + c0) : z4;
        c_sh[j] = mode <= 1 ? *(const f32x4*)(mods + ((size_t)lmod_next * 5 + b) * 6144 + i_shift * 1024 + c0) : z4;
        c_sc[j] = mode <= 1 ? *(const f32x4*)(mods + ((size_t)lmod_next * 5 + b) * 6144 + i_scale * 1024 + c0) : z4; }
    for (int s0_ = w4; s0_ < SB; s0_ += 2 * NW4) {
        f32x4 x[2][4]; bool val[2], ctxr[2]; int mrow[2], srow[2];
#pragma unroll
        for (int u = 0; u < 2; ++u) { srow[u] = s0_ + u * NW4; val[u] = srow[u] < SB; if (!val[u]) srow[u] = s0_; mrow[u] = b * SB + srow[u]; ctxr[u] = srow[u] < CT; }
        if (mode == 0) {
#pragma unroll
            for (int u = 0; u < 2; ++u) { const int s = srow[u];
                const float* src = ctxr[u] ? INP(I_CTX) + ((size_t)b * CT + s) * D : INP(I_X) + ((size_t)b * TL + (s - CT)) * D;
#pragma unroll
                for (int j = 0; j < 4; ++j) x[u][j] = *(const f32x4*)(src + 4 * F.lane + 256 * j); }
        } else {
            f32x4 ov[2][4], xv[2][4]; float ss[2] = {0.f, 0.f};
#pragma unroll
            for (int u = 0; u < 2; ++u)
#pragma unroll
                for (int j = 0; j < 4; ++j) xv[u][j] = *(const f32x4*)(xcur + (size_t)mrow[u] * D + 4 * F.lane + 256 * j);
#pragma unroll
            for (int u = 0; u < 2; ++u)
#pragma unroll
                for (int j = 0; j < 4; ++j) {
                    if (ctxr[u]) { const float* pp = (const float*)(F.ws + WS_AR + AR_PART) + ((size_t)b * 256 + srow[u]) * D + 4 * F.lane + 256 * j; f32x4 a = {0.f, 0.f, 0.f, 0.f};
                        for (int ks = 0; ks < nks; ++ks) a += *(const f32x4*)(pp + (size_t)ks * 4 * 256 * D);
                        ov[u][j] = a; }
                    else { const v2u w_ = *(const v2u*)((const bf16*)o + (size_t)mrow[u] * D + 4 * F.lane + 256 * j); ov[u][j] = (f32x4){bflo(w_.x), bfhi(w_.x), bflo(w_.y), bfhi(w_.y)}; }
                    ss[u] += ov[u][j][0] * ov[u][j][0] + ov[u][j][1] * ov[u][j][1] + ov[u][j][2] * ov[u][j][2] + ov[u][j][3] * ov[u][j][3]; }
#pragma unroll
            for (int u = 0; u < 2; ++u) { ss[u] = wave_sum(ss[u]);
                const float rs = rsqrtf(ss[u] * (1.f / D) + NORM_EPS);
#pragma unroll
                for (int j = 0; j < 4; ++j) { const int c0 = 4 * F.lane + 256 * j;
                    const f32x4 gt = ctxr[u] ? *(const f32x4*)(mods + ((size_t)lmod_gate * 5 + 4) * 6144 + i_gate * 1024 + c0) : c_gt[j];
                    x[u][j] = xv[u][j] + gt * (ov[u][j] * rs * c_gp[j]); } }
        }
        if (mode == 2) {
#pragma unroll
            for (int u = 0; u < 2; ++u) if (val[u] && !ctxr[u]) {
#pragma unroll
                for (int j = 0; j < 4; ++j) *(f32x4*)(F.out + ((size_t)b * TL + (srow[u] - CT)) * D + 4 * F.lane + 256 * j) = x[u][j]; }
            continue;
        }
#pragma unroll
        for (int u = 0; u < 2; ++u) {
            float ss = 0.f;
#pragma unroll
            for (int j = 0; j < 4; ++j) { if (val[u]) *(f32x4*)(xcur + (size_t)mrow[u] * D + 4 * F.lane + 256 * j) = x[u][j]; ss += x[u][j][0] * x[u][j][0] + x[u][j][1] * x[u][j][1] + x[u][j][2] * x[u][j][2] + x[u][j][3] * x[u][j][3]; }
            ss = wave_sum(ss);
            const float rs = rsqrtf(ss * (1.f / D) + NORM_EPS);
#pragma unroll
            for (int j = 0; j < 4; ++j) { const int c0 = 4 * F.lane + 256 * j;
                const f32x4 sh = ctxr[u] ? *(const f32x4*)(mods + ((size_t)lmod_next * 5 + 4) * 6144 + i_shift * 1024 + c0) : c_sh[j];
                const f32x4 scl = ctxr[u] ? *(const f32x4*)(mods + ((size_t)lmod_next * 5 + 4) * 6144 + i_scale * 1024 + c0) : c_sc[j];
                const f32x4 y = x[u][j] * rs * c_gn[j] * (scl + 1.f) + sh;
                v2u w; w.x = pk2(y[0], y[1]); w.y = pk2(y[2], y[3]);
                if (val[u]) *(v2u*)(xn + (size_t)mrow[u] * D + c0) = w; }
        }
    }
}

typedef short pbf16x8 __attribute__((ext_vector_type(8)));
constexpr int PZ_LD = 1156  , PA_LD = 136, P_TH = 16 * PZ_LD * 4, P_AD = P_TH + 16 * PA_LD * 2, P_SG = P_AD + 16 * PA_LD * 2, P_KN = P_SG + 16 * PA_LD * 2;
__device__ __forceinline__ void unpack8(const v4u& w, float (&x)[8]) {
#pragma unroll
    for (int q = 0; q < 4; ++q) { x[2 * q] = bflo(w[q]); x[2 * q + 1] = bfhi(w[q]); }
}
__device__ __forceinline__ v4u pack8(const float (&x)[8]) { v4u w;
#pragma unroll
    for (int q = 0; q < 4; ++q) w[q] = pk2(x[2 * q], x[2 * q + 1]);
    return w; }
__device__ __forceinline__ void prep_phase(const Frame& F, int l) {
    LAS float* ZS = (LAS float*)F.lds;
    LAS bf16* TH = (LAS bf16*)(F.lds + P_TH); LAS bf16* AD = (LAS bf16*)(F.lds + P_AD); LAS bf16* SG = (LAS bf16*)(F.lds + P_SG);
    LAS float* KN = (LAS float*)(F.lds + P_KN);
    const bf16* U = (const bf16*)(F.ws + WS_AR + AR_U);
    bf16* QKV = (bf16*)(F.ws + WS_AR + AR_QKV);
    const float* rope = (const float*)(F.ws + WS_ROPE);
    const float* qn = INP(I_QN) + l * 64; const float* kn = INP(I_KN) + l * 64;
    const float* mu = INP(I_MU) + (size_t)l * 2 * R_IN;
    const float* w0 = INP(I_W0) + l * 512; const float* a0 = INP(I_A0) + l * 512;
    const float* k_k = INP(I_KK) + l * 256; const float* k_a = INP(I_KA) + l * 256;
    const float* scw = INP(I_SCW) + (size_t)l * 3 * 256;
    const bf16* lr = (const bf16*)(F.ws + WS_LR);
    bf16* R_o = (bf16*)(F.ws + WS_AR + AR_R); bf16* V_o = (bf16*)(F.ws + WS_AR + AR_V); bf16* KK_o = (bf16*)(F.ws + WS_AR + AR_KK); bf16* G_o = (bf16*)(F.ws + WS_AR + AR_G);
    bf16* KE_o = (bf16*)(F.ws + WS_AR + AR_KE); bf16* KKA_o = (bf16*)(F.ws + WS_AR + AR_KKA); float* W_o = (float*)(F.ws + WS_AR + AR_W);
    bf16* MIX = (bf16*)(F.ws + WS_AR + AR_MIX);
    const int lane = F.lane, wv = F.wave, tid = F.tid, fr = lane & 15, fq = lane >> 4;
    LAS float* CM = (LAS float*)(F.lds + P_KN + 256); LAS float* CP = CM + 2 * R_IN; LAS float* CS = CP + 6 * 256; LAS float* CG = CS + 3 * 256;
    for (int i = tid; i < 2 * R_IN; i += NTHR) CM[i] = mu[i];
    for (int i = tid; i < 256; i += NTHR) { CP[i] = k_k[i]; CP[256 + i] = k_a[i]; CP[512 + i] = w0[i]; CP[768 + i] = w0[256 + i]; CP[1024 + i] = a0[i]; CP[1280 + i] = a0[256 + i]; }
    for (int i = tid; i < 768; i += NTHR) CS[i] = scw[i];
    if (tid < 64) { CG[tid] = qn[tid]; CG[64 + tid] = kn[tid]; }
    __syncthreads();
    const bool bact = tid < 432; const int bch = bact ? tid % 144 : 0, btq = bact ? tid / 144 : 0, bc0 = bch * 8;
    const bool bisk = bact && bc0 >= 256 && bc0 < 512;
    const int ad0 = (lane & 7) * 8;
    const int dc0 = (tid & 31) * 8;
    pbf16x8 bwf[2][2][2], bgf[2][4];
#pragma unroll
    for (int nt = 0; nt < 2; ++nt) { const int cw = 32 * wv + 16 * nt + fr;
#pragma unroll
        for (int d = 0; d < 2; ++d)
#pragma unroll
            for (int kb = 0; kb < 2; ++kb) bwf[nt][d][kb] = *(const pbf16x8*)(lr + (size_t)d * 256 * 64 + (size_t)cw * 64 + kb * 32 + fq * 8);
#pragma unroll
        for (int kb = 0; kb < 4; ++kb) bgf[nt][kb] = *(const pbf16x8*)(lr + 4 * 256 * 64 + (size_t)cw * 128 + kb * 32 + fq * 8); }
    const bool xaff = F.G == 256;
    for (int it_ = xaff ? ((F.bid >> 3) + 32 * (F.bid & 1)) : F.bid; it_ < (xaff ? SB / 16 : M / 16); it_ += (xaff ? 64 : F.G)) {
        const int item = xaff ? ((F.bid & 7) >> 1) * (SB / 16) + it_ : it_;
        const int m0 = item * 16, s0 = m0 % SB;
        const bool isctx = s0 < CT; const int seq_lo = isctx ? 0 : CT, seq_hi = isctx ? CT : SB;
        SUBT(0);
        v4u araw[2][2], avc[2]; f32x4 arp[2][4];
#pragma unroll
        for (int rr = 0; rr < 2; ++rr) { const int t = 2 * wv + rr; const bf16* ur = U + (size_t)(m0 + t) * NINP;
            araw[rr][0] = *(const v4u*)(ur + 8 * lane); araw[rr][1] = *(const v4u*)(ur + K_OFF + 8 * (lane & 15)); avc[rr] = *(const v4u*)(ur + V_OFF + 8 * (lane & 15));
            const int pos = isctx ? 0 : (s0 + t - CT); const float* rp = rope + ((size_t)pos * 32 + (ad0 & 31)) * 2;
#pragma unroll
            for (int e = 0; e < 4; ++e) arp[rr][e] = *(const f32x4*)(rp + 4 * e); }
        v4u dbg, dcg[3], dxc[3];
        { const int t = tid >> 5, s = s0 + t; const bf16* u = U + (size_t)(m0 + t) * NINP + C_OFF + dc0;
          const int dp = s > seq_lo ? -NINP : 0, dn = s < seq_hi - 1 ? NINP : 0;
          dbg = *(const v4u*)u; dcg[1] = *(const v4u*)(u + 256); dxc[1] = *(const v4u*)(u + 512);
          dcg[0] = *(const v4u*)(u + dp + 256); dxc[0] = *(const v4u*)(u + dp + 512); dcg[2] = *(const v4u*)(u + dn + 256); dxc[2] = *(const v4u*)(u + dn + 512); }
#pragma unroll
        for (int rr = 0; rr < 2; ++rr) {
            const int t = 2 * wv + rr, m = m0 + t;
            bf16* orow = QKV + (size_t)m * QKVP;
#pragma unroll
            for (int pass = 0; pass < 2; ++pass) {
                const bool act = pass == 0 || lane < 16;
                const int col = (pass == 0 ? 0 : K_OFF) + 8 * lane;
                float x[8]; unpack8(araw[rr][pass], x);
                float ss = 0.f;
#pragma unroll
                for (int e = 0; e < 8; ++e) ss += x[e] * x[e];
                ss = sum8(ss);
                const float rs = rsqrtf(ss * (1.f / 64.f) + NORM_EPS);
                const f32x4 g0 = *(const LAS f32x4*)(CG + pass * 64 + ad0), g1 = *(const LAS f32x4*)(CG + pass * 64 + ad0 + 4);
                float y[8];
#pragma unroll
                for (int e = 0; e < 4; ++e) { y[e] = x[e] * rs * g0[e]; y[4 + e] = x[4 + e] * rs * g1[e]; }
                float yp[8];
#pragma unroll
                for (int e = 0; e < 8; ++e) yp[e] = __shfl_xor(y[e], 4);
                if (!isctx) {
                    const bool lo_half = ad0 < 32;
#pragma unroll
                    for (int e = 0; e < 8; e += 2) { const f32x4 cs = arp[rr][e >> 1];
                        y[e] = lo_half ? (y[e] * cs[0] - yp[e] * cs[1]) : (y[e] * cs[0] + yp[e] * cs[1]);
                        y[e + 1] = lo_half ? (y[e + 1] * cs[2] - yp[e + 1] * cs[3]) : (y[e + 1] * cs[2] + yp[e + 1] * cs[3]); }
                }
                if (pass == 0) {
#pragma unroll
                    for (int e = 0; e < 8; ++e) y[e] *= C2;
                }
                if (act) *(v4u*)(orow + col) = pack8(y);
            }
            if (lane < 16) *(v4u*)(orow + V_OFF + 8 * lane) = avc[rr];
        }
        SUBT(1);
        { const int t = tid >> 5, s = s0 + t;
          float bg[8], c1[8], x1[8], p[8], pp[8], pn[8];
          unpack8(dbg, bg); unpack8(dcg[1], c1); unpack8(dxc[1], x1);
#pragma unroll
          for (int e = 0; e < 8; ++e) p[e] = c1[e] * x1[e];
          unpack8(dcg[0], c1); unpack8(dxc[0], x1);
          const float mp = s > seq_lo ? 1.f : 0.f, mn = s < seq_hi - 1 ? 1.f : 0.f;
#pragma unroll
          for (int e = 0; e < 8; ++e) pp[e] = c1[e] * x1[e] * mp;
          unpack8(dcg[2], c1); unpack8(dxc[2], x1);
#pragma unroll
          for (int e = 0; e < 8; ++e) pn[e] = c1[e] * x1[e] * mn;
          float o[8];
#pragma unroll
          for (int e = 0; e < 8; ++e) o[e] = bg[e] * (pp[e] * CS[dc0 + e] + p[e] * CS[256 + dc0 + e] + pn[e] * CS[512 + dc0 + e]);
          *(v4u*)(MIX + (size_t)(m0 + t) * D + 768 + dc0) = pack8(o); }
        SUBT(2);
#pragma unroll 1
        for (int hb = 0; hb < 2; ++hb)
        { const int t0 = 6 * btq + 3 * hb, ntok = btq == 2 ? (hb == 0 ? 3 : 1) : 3;
          const f32x4 mu0a = *(const LAS f32x4*)(CM + bc0), mu0b = *(const LAS f32x4*)(CM + bc0 + 4), mu1a = *(const LAS f32x4*)(CM + R_IN + bc0), mu1b = *(const LAS f32x4*)(CM + R_IN + bc0 + 4);
          const f32x4 bkka = bisk ? *(const LAS f32x4*)(CP + bc0 - 256) : (f32x4){0.f, 0.f, 0.f, 0.f}, bkkb = bisk ? *(const LAS f32x4*)(CP + bc0 - 252) : (f32x4){0.f, 0.f, 0.f, 0.f};
          v4u rw[5];
#pragma unroll
          for (int jj = 0; jj < 5; ++jj) { int sr_ = s0 + t0 - 1 + jj; sr_ = sr_ < seq_lo ? seq_lo : (sr_ > seq_hi - 1 ? seq_hi - 1 : sr_);
              const int tt = sr_ - s0; const int tcl = tt > 16 ? 16 : tt;
              rw[jj] = *(const v4u*)(U + (unsigned)(m0 + tcl) * (unsigned)NINP + (unsigned)(R_OFF + bc0)); }
#pragma unroll
          for (int jj = 1; jj <= 3; ++jj) {
              const int t = t0 + jj - 1, s = s0 + t; const bool tv = bact && jj <= ntok;
              float z[8], pv[8], nx[8];
              unpack8(rw[jj], z); unpack8(rw[jj - 1], pv); unpack8(rw[jj + 1], nx);
              const float mp = s > seq_lo ? 1.f : 0.f, mn = s < seq_hi - 1 ? 1.f : 0.f;
#pragma unroll
              for (int e = 0; e < 4; ++e) { z[e] = z[e] + mu0a[e] * (pv[e] * mp - z[e]) + mu1a[e] * (nx[e] * mn - z[e]); z[4 + e] = z[4 + e] + mu0b[e] * (pv[4 + e] * mp - z[4 + e]) + mu1b[e] * (nx[4 + e] * mn - z[4 + e]); }
              if (tv) { *(LAS f32x4*)(ZS + t * PZ_LD + bc0) = (f32x4){z[0], z[1], z[2], z[3]}; *(LAS f32x4*)(ZS + t * PZ_LD + bc0 + 4) = (f32x4){z[4], z[5], z[6], z[7]}; }
              float ss = 0.f;
#pragma unroll
              for (int e = 0; e < 4; ++e) { const float u0 = z[e] * bkka[e], u1 = z[4 + e] * bkkb[e]; ss += u0 * u0 + u1 * u1; }
              ss = sum8(ss);
              if (tv && bisk && (bch & 7) == 0) KN[t * 4 + ((bc0 - 256) >> 6)] = rsqrtf(fmaxf(ss, 1e-12f));
              if (tv && bc0 >= 768) {
                  float q[8];
                  if (bc0 < 896) {
#pragma unroll
                      for (int e = 0; e < 8; ++e) q[e] = 1.f - 2.f * __builtin_amdgcn_rcpf(1.f + __expf(2.f * z[e]));
                      *(LAS v4u*)(TH + t * PA_LD + (bc0 - 768)) = pack8(q);
                  } else if (bc0 < 1024) { *(LAS v4u*)(AD + t * PA_LD + (bc0 - 896)) = pack8(z); }
                  else {
#pragma unroll
                      for (int e = 0; e < 8; ++e) q[e] = sigm(z[e]);
                      *(LAS v4u*)(SG + t * PA_LD + (bc0 - 1024)) = pack8(q);
                  }
              }
          } }
        SUBT(3);
        LDS_BARRIER();
        SUBT(4);
        pbf16x8 baf[2][2][2];
#pragma unroll
        for (int nt = 0; nt < 2; ++nt)
#pragma unroll
            for (int d = 0; d < 2; ++d)
#pragma unroll
                for (int kb = 0; kb < 2; ++kb) baf[nt][d][kb] = *(const pbf16x8*)(lr + 2 * 256 * 64 + (size_t)d * 256 * 64 + (size_t)(32 * wv + 16 * nt + fr) * 64 + kb * 32 + fq * 8);
        { pbf16x8 tha[2][2], ada[2][2], sga[4];
#pragma unroll
          for (int d = 0; d < 2; ++d)
#pragma unroll
              for (int kb = 0; kb < 2; ++kb) { tha[d][kb] = *(const LAS pbf16x8*)(TH + fr * PA_LD + d * 64 + kb * 32 + fq * 8); ada[d][kb] = *(const LAS pbf16x8*)(AD + fr * PA_LD + d * 64 + kb * 32 + fq * 8); }
#pragma unroll
          for (int kb = 0; kb < 4; ++kb) sga[kb] = *(const LAS pbf16x8*)(SG + fr * PA_LD + kb * 32 + fq * 8);
#pragma unroll
          for (int nt = 0; nt < 2; ++nt) {
              const int n0 = 32 * wv + 16 * nt;
              f32x4 accW[2], accA[2], accG = {0.f, 0.f, 0.f, 0.f};
#pragma unroll
              for (int d = 0; d < 2; ++d) { accW[d] = (f32x4){0.f, 0.f, 0.f, 0.f}; accA[d] = (f32x4){0.f, 0.f, 0.f, 0.f};
#pragma unroll
                  for (int kb = 0; kb < 2; ++kb) {
                      accW[d] = __builtin_amdgcn_mfma_f32_16x16x32_bf16(bwf[nt][d][kb], tha[d][kb], accW[d], 0, 0, 0);
                      accA[d] = __builtin_amdgcn_mfma_f32_16x16x32_bf16(baf[nt][d][kb], ada[d][kb], accA[d], 0, 0, 0);
                  } }
#pragma unroll
              for (int kb = 0; kb < 4; ++kb) accG = __builtin_amdgcn_mfma_f32_16x16x32_bf16(bgf[nt][kb], sga[kb], accG, 0, 0, 0);
              const int t = fr, c0 = n0 + 4 * fq; const unsigned o = (unsigned)(m0 + t) * 256u + (unsigned)c0;
              const f32x4 kv = *(const LAS f32x4*)(ZS + t * PZ_LD + 256 + c0), rv = *(const LAS f32x4*)(ZS + t * PZ_LD + c0), vv = *(const LAS f32x4*)(ZS + t * PZ_LD + 512 + c0);
              const f32x4 kkc = *(const LAS f32x4*)(CP + c0), kac = *(const LAS f32x4*)(CP + 256 + c0), w00 = *(const LAS f32x4*)(CP + 512 + c0), w01 = *(const LAS f32x4*)(CP + 768 + c0), a00 = *(const LAS f32x4*)(CP + 1024 + c0), a01 = *(const LAS f32x4*)(CP + 1280 + c0);
              const float knv = KN[t * 4 + (c0 >> 6)];
              f32x4 kk4, lw0, lw1, ke0, ke1, ka0, ka1;
#pragma unroll
              for (int e = 0; e < 4; ++e) { kk4[e] = kv[e] * kkc[e] * knv;
                  lw0[e] = -DECAY_SCALE * sigm(accW[0][e] + w00[e]); lw1[e] = -DECAY_SCALE * sigm(accW[1][e] + w01[e]);
                  const float av0 = sigm(accA[0][e] + a00[e]), av1 = sigm(accA[1][e] + a01[e]);
                  ke0[e] = kv[e] * (1.f + (av0 - 1.f) * kac[e]); ke1[e] = kv[e] * (1.f + (av1 - 1.f) * kac[e]); ka0[e] = kk4[e] * av0; ka1[e] = kk4[e] * av1; }
#define ST4(P, V) do { v2u w_; w_.x = pk2((V)[0], (V)[1]); w_.y = pk2((V)[2], (V)[3]); *(v2u*)(P) = w_; } while (0)
              ST4(R_o + o, rv); ST4(V_o + o, vv); ST4(KK_o + o, kk4); ST4(G_o + o, accG);
              *(f32x4*)(W_o + o) = lw0; *(f32x4*)(W_o + (unsigned)(M * 256) + o) = lw1;
              ST4(KE_o + o, ke0); ST4(KE_o + (unsigned)(M * 256) + o, ke1); ST4(KKA_o + o, ka0); ST4(KKA_o + (unsigned)(M * 256) + o, ka1);
#undef ST4
          } }
        SUBT(5);
        LDS_BARRIER();
        SUBT(6);
    }
}

__device__ __forceinline__ void rwkv_out_phase(const Frame& F, int l) {
    const float* Y = (const float*)(F.ws + WS_AR + AR_Y);
    const bf16* R_i = (const bf16*)(F.ws + WS_AR + AR_R); const bf16* V_i = (const bf16*)(F.ws + WS_AR + AR_V); const bf16* G_i = (const bf16*)(F.ws + WS_AR + AR_G);
    const bf16* KE_i = (const bf16*)(F.ws + WS_AR + AR_KE);
    bf16* MIX = (bf16*)(F.ws + WS_AR + AR_MIX);
    const int gw = F.bid * NWAVES + F.wave, NGW = F.G * NWAVES;
    const int c0 = 4 * F.lane;
    const f32x4 rk = *(const f32x4*)(INP(I_RK) + l * 256 + c0), lw = *(const f32x4*)(INP(I_LNW) + l * 256 + c0), lb = *(const f32x4*)(INP(I_LNB) + l * 256 + c0);
    for (int m = gw; m < M; m += NGW) {
        const unsigned o = (unsigned)m * 256u + (unsigned)c0;
        const f32x4 y0 = *(const f32x4*)(Y + o), y1 = *(const f32x4*)(Y + (unsigned)(M * 256) + o);
        const v2u rw_ = *(const v2u*)(R_i + o), vw = *(const v2u*)(V_i + o), gw_ = *(const v2u*)(G_i + o), k0 = *(const v2u*)(KE_i + o), k1 = *(const v2u*)(KE_i + (unsigned)(M * 256) + o);
        const f32x4 y = y0 + y1;
        const float mean = red16((y[0] + y[1]) + (y[2] + y[3])) * (1.f / 64.f);
        const f32x4 dl = y - mean;
        const float var = red16((dl[0] * dl[0] + dl[1] * dl[1]) + (dl[2] * dl[2] + dl[3] * dl[3])) * (1.f / 64.f);
        const float rs = rsqrtf(var + GN_EPS);
        const f32x4 rr = {bflo(rw_.x), bfhi(rw_.x), bflo(rw_.y), bfhi(rw_.y)}, vv = {bflo(vw.x), bfhi(vw.x), bflo(vw.y), bfhi(vw.y)}, gg = {bflo(gw_.x), bfhi(gw_.x), bflo(gw_.y), bfhi(gw_.y)};
        const f32x4 ke = (f32x4){bflo(k0.x), bfhi(k0.x), bflo(k0.y), bfhi(k0.y)} + (f32x4){bflo(k1.x), bfhi(k1.x), bflo(k1.y), bfhi(k1.y)};
        const f32x4 tt = rr * ke * rk;
        const float bon = red16((tt[0] + tt[1]) + (tt[2] + tt[3]));
        const f32x4 ov = (dl * rs * lw + lb + vv * bon) * gg;
        v2u w; w.x = pk2(ov[0], ov[1]); w.y = pk2(ov[2], ov[3]);
        *(v2u*)(MIX + (size_t)m * D + 512 + c0) = w;
    }
}

__device__ __forceinline__ void act_phase(const Frame& F, int l) {
    const bf16* H = (const bf16*)(F.ws + WS_AR + AR_H); bf16* ACT = (bf16*)(F.ws + WS_AR + AR_ACT);
    const float* wc = INP(I_FCONV) + (size_t)l * 3 * DFF2;
    constexpr int NCH = DFF / 8;
    const int nitems = (M / 8) * NCH;
    for (int it = F.bid * NTHR + F.tid; it < nitems; it += F.G * NTHR) {
        const int rg = it / NCH, ch = it % NCH, j0 = ch * 8, m0 = rg * 8, s0 = m0 % SB;
        const bool isctx = s0 < CT; const int seq_lo = isctx ? 0 : CT, seq_hi = isctx ? CT : SB;
        v4u gr[10], ur[10];
#pragma unroll
        for (int r = 0; r < 10; ++r) { int s = s0 - 1 + r; s = s < seq_lo ? seq_lo : (s > seq_hi - 1 ? seq_hi - 1 : s);
            const bf16* hr = H + (size_t)(m0 - s0 + s) * DFF2 + j0; gr[r] = *(const v4u*)hr; ur[r] = *(const v4u*)(hr + DFF); }
        { const v4u z4 = {0u, 0u, 0u, 0u};
          if (s0 <= seq_lo) { gr[0] = z4; ur[0] = z4; } if (s0 + 8 >= seq_hi) { gr[9] = z4; ur[9] = z4; } }
        float wg[3][8], wu[3][8];
#pragma unroll
        for (int tp = 0; tp < 3; ++tp) { const f32x4 a0 = *(const f32x4*)(wc + tp * DFF2 + j0), a1 = *(const f32x4*)(wc + tp * DFF2 + j0 + 4), b0 = *(const f32x4*)(wc + tp * DFF2 + DFF + j0), b1 = *(const f32x4*)(wc + tp * DFF2 + DFF + j0 + 4);
#pragma unroll
            for (int e = 0; e < 4; ++e) { wg[tp][e] = a0[e]; wg[tp][4 + e] = a1[e]; wu[tp][e] = b0[e]; wu[tp][4 + e] = b1[e]; } }
#pragma unroll
        for (int r = 0; r < 8; ++r) {
            const int s = s0 + r;
            v4u o;
#pragma unroll
            for (int q = 0; q < 4; ++q) {
                const float ga0 = bflo(gr[r][q]) * wg[0][2 * q] + bflo(gr[r + 1][q]) * wg[1][2 * q] + bflo(gr[r + 2][q]) * wg[2][2 * q];
                const float ga1 = bfhi(gr[r][q]) * wg[0][2 * q + 1] + bfhi(gr[r + 1][q]) * wg[1][2 * q + 1] + bfhi(gr[r + 2][q]) * wg[2][2 * q + 1];
                const float u0 = bflo(ur[r][q]) * wu[0][2 * q] + bflo(ur[r + 1][q]) * wu[1][2 * q] + bflo(ur[r + 2][q]) * wu[2][2 * q];
                const float u1 = bfhi(ur[r][q]) * wu[0][2 * q + 1] + bfhi(ur[r + 1][q]) * wu[1][2 * q + 1] + bfhi(ur[r + 2][q]) * wu[2][2 * q + 1];
                o[q] = pk2(ga0 * __builtin_amdgcn_rcpf(1.f + __expf(-ga0)) * u0, ga1 * __builtin_amdgcn_rcpf(1.f + __expf(-ga1)) * u1);
            }
            *(v4u*)(ACT + (size_t)(m0 + r) * DFF + j0) = o;
        }
    }
}

namespace attn_body {
using bf16=__hip_bfloat16;
using bf16x8=__attribute__((ext_vector_type(8)))short;
using s16x4=__attribute__((ext_vector_type(4)))short;
using f32x16=__attribute__((ext_vector_type(16)))float;
using u32x4=__attribute__((ext_vector_type(4)))unsigned;
constexpr int D=64,QP=768,OP=1024;
constexpr int NW=8,QBLK=32,QB=QBLK*NW,KVBLK=64;
constexpr int ATTN_UNIT_ROWS=QB;
__device__ __forceinline__ int crow(int r,int hi){return (r&3)+8*(r>>2)+4*hi;}
#define SBAR() __builtin_amdgcn_sched_barrier(0)
constexpr int NSLOT=3, SLOTB=8192;
constexpr int LDS_K=0, LDS_V=NSLOT*SLOTB, LDS_WS=2*NSLOT*SLOTB, LDS_OST=LDS_WS+NW*64*4, LDS_BYTES=LDS_OST+NW*4096;
__device__ __forceinline__ void glds16(const void*gsrc,unsigned lds_dst){unsigned keep;
  asm volatile("s_mov_b32 %0, m0\n\ts_mov_b32 m0, %2\n\ts_nop 0\n\tglobal_load_lds_dwordx4 %1, off\n\ts_mov_b32 m0, %0":"=&s"(keep):"v"(gsrc),"s"(lds_dst):"memory");}
__device__ __forceinline__ float max3f(float a,float b,float c){float r;asm("v_max3_f32 %0, %1, %2, %3":"=v"(r):"v"(a),"v"(b),"v"(c));return r;}
__device__ __forceinline__ float max2f(float a,float b){float r;asm("v_max_f32_e32 %0, %1, %2":"=v"(r):"v"(a),"v"(b));return r;}
__device__ __forceinline__ float fadd_s(float a,float b){float r;asm("v_add_f32_e32 %0, %1, %2":"=v"(r):"v"(a),"v"(b));return r;}
__device__ __forceinline__ float fsub_s(float a,float b){float r;asm("v_sub_f32_e32 %0, %1, %2":"=v"(r):"v"(a),"v"(b));return r;}
typedef float f32x2_t __attribute__((ext_vector_type(2))); typedef __bf16 bf16x2_t __attribute__((ext_vector_type(2)));
__device__ __forceinline__ unsigned cvtpk_s(float lo,float hi){f32x2_t v={lo,hi};bf16x2_t b=__builtin_convertvector(v,bf16x2_t);return __builtin_bit_cast(unsigned,b);}
#define WAIT_BAR(N) asm volatile("s_waitcnt vmcnt(" #N ") lgkmcnt(0)\n\ts_barrier":::"memory")

__device__ __forceinline__ void qkt(f32x16&p0,f32x16&p1,const char*Kslot,const bf16x8*qr,const f32x16&negm,int r32,int hi){
  const char*kb=Kslot+hi*1024+r32*16;
  #pragma unroll
  for(int d0=0;d0<4;++d0){
    const bf16x8 b0=*reinterpret_cast<const bf16x8*>(kb+d0*2048);
    const bf16x8 b1=*reinterpret_cast<const bf16x8*>(kb+d0*2048+512);
    if(d0==0){p0=__builtin_amdgcn_mfma_f32_32x32x16_bf16(b0,qr[0],negm,0,0,0);p1=__builtin_amdgcn_mfma_f32_32x32x16_bf16(b1,qr[0],negm,0,0,0);}
    else{p0=__builtin_amdgcn_mfma_f32_32x32x16_bf16(b0,qr[d0],p0,0,0,0);p1=__builtin_amdgcn_mfma_f32_32x32x16_bf16(b1,qr[d0],p1,0,0,0);}}
}
typedef __attribute__((address_space(3))) const char* lds_cptr;
typedef short v4i16_t __attribute__((ext_vector_type(4)));
__device__ __forceinline__ void kload8(bf16x8*kf,lds_cptr kp){
  kf[0]=*(const __attribute__((address_space(3))) bf16x8*)(kp);      kf[1]=*(const __attribute__((address_space(3))) bf16x8*)(kp+512);
  kf[2]=*(const __attribute__((address_space(3))) bf16x8*)(kp+2048); kf[3]=*(const __attribute__((address_space(3))) bf16x8*)(kp+2560);
  kf[4]=*(const __attribute__((address_space(3))) bf16x8*)(kp+4096); kf[5]=*(const __attribute__((address_space(3))) bf16x8*)(kp+4608);
  kf[6]=*(const __attribute__((address_space(3))) bf16x8*)(kp+6144); kf[7]=*(const __attribute__((address_space(3))) bf16x8*)(kp+6656);
}
__device__ __forceinline__ void kload2(bf16x8*kf,lds_cptr kp,int j){ kf[2*j]=*(const __attribute__((address_space(3))) bf16x8*)(kp+j*2048); kf[2*j+1]=*(const __attribute__((address_space(3))) bf16x8*)(kp+j*2048+512); }
__device__ __forceinline__ s16x4 vtr(lds_cptr p){ return __builtin_bit_cast(s16x4,__builtin_amdgcn_ds_read_tr16_b64_v4i16((__attribute__((address_space(3))) v4i16_t*)p)); }
__device__ __forceinline__ float rowmax(const f32x16&p0,const f32x16&p1){
  float a=max3f(p0[0],p0[1],p1[0]),b=max3f(p0[2],p0[3],p1[1]);a=max3f(a,p1[2],p1[3]);
  #pragma unroll
  for(int r=4;r<16;r+=4){a=max3f(a,p0[r],p0[r+1]);b=max3f(b,p0[r+2],p0[r+3]);a=max3f(a,p1[r],p1[r+1]);b=max3f(b,p1[r+2],p1[r+3]);}
  const float m=max2f(a,b);
  auto rr=__builtin_amdgcn_permlane32_swap(__float_as_uint(m),__float_as_uint(m),false,false);
  return max2f(__uint_as_float(rr[0]),__uint_as_float(rr[1]));
}
__device__ __forceinline__ void pv(f32x16*o,int vb,bf16x8 pa0,bf16x8 pa1,bf16x8 pa2,bf16x8 pa3){
  #pragma unroll
  for(int d0=0;d0<2;++d0){s16x4 lo[4],hi[4];
    #pragma unroll
    for(int ks=0;ks<4;++ks){
      asm volatile("ds_read_b64_tr_b16 %0,%1 offset:%c2":"=&v"(lo[ks]):"v"(vb),"i"(d0*4096+ks*1024):"memory");
      asm volatile("ds_read_b64_tr_b16 %0,%1 offset:%c2":"=&v"(hi[ks]):"v"(vb),"i"(d0*4096+ks*1024+512):"memory");}
    asm volatile("s_waitcnt lgkmcnt(0)":::"memory");SBAR();
    #define PK(k) (bf16x8){lo[k][0],lo[k][1],lo[k][2],lo[k][3],hi[k][0],hi[k][1],hi[k][2],hi[k][3]}
    o[d0]=__builtin_amdgcn_mfma_f32_32x32x16_bf16(pa0,PK(0),o[d0],0,0,0);
    o[d0]=__builtin_amdgcn_mfma_f32_32x32x16_bf16(pa1,PK(1),o[d0],0,0,0);
    o[d0]=__builtin_amdgcn_mfma_f32_32x32x16_bf16(pa2,PK(2),o[d0],0,0,0);
    o[d0]=__builtin_amdgcn_mfma_f32_32x32x16_bf16(pa3,PK(3),o[d0],0,0,0);
    #undef PK
  }
}

#ifndef ATTN_STORE16
#define ATTN_STORE16(p,v) (*(u32x4*)(p)=(v))
#endif
template<int THRL> __device__ __forceinline__ void attn_unit(const bf16*Qu,const bf16*__restrict__ Kh,const bf16*__restrict__ Vh,bf16*Ou,const int NT,char*shm){
  const int tid=threadIdx.x,lane=tid&63,r32=lane&31,hi=lane>>5; const int wid=__builtin_amdgcn_readfirstlane(tid>>6);
  const bf16*Qw=Qu+(long)(wid*QBLK)*QP;
  const unsigned lds0=(unsigned)(uintptr_t)shm;
  float*wsf=(float*)(shm+LDS_WS)+wid*64;
  const bf16*ksrc=Kh+(long)lane*QP+wid*8;
  const bf16*vsrc=Vh+(long)(16*(wid&3)+(lane>>2))*QP+(wid>>2)*32+(lane&3)*8;
  const unsigned kdst=lds0+LDS_K+wid*1024, vdst=lds0+LDS_V+wid*1024;
  #define DMA_K(t,slot) glds16(ksrc+(long)(t)*KVBLK*QP,(unsigned)__builtin_amdgcn_readfirstlane(kdst+(slot)))
  #define DMA_V(t,slot) glds16(vsrc+(long)(t)*KVBLK*QP,(unsigned)__builtin_amdgcn_readfirstlane(vdst+(slot)))
  const int vb0=(int)(lds0+LDS_V)+((lane>>4)&1)*32+(lane&3)*8+(4*hi+((lane&15)>>2))*64;
  const char*Kbase=shm+LDS_K; bf16x8 kf[8];
  const lds_cptr shm3=(lds_cptr)shm; const lds_cptr kp0=shm3+LDS_K+hi*1024+r32*16; const lds_cptr vp0=shm3+LDS_V+((lane>>4)&1)*32+(lane&3)*8+(4*hi+((lane&15)>>2))*64;
  DMA_K(0,0);DMA_V(0,0);DMA_K(1,SLOTB);
  bf16x8 qr[4];
  #pragma unroll
  for(int d0=0;d0<4;++d0)qr[d0]=*reinterpret_cast<const bf16x8*>(&Qw[(long)r32*QP+d0*16+hi*8]);
  float mhat=0.f,l_reg=0.f;f32x16 o[2];o[0]=f32x16{};o[1]=f32x16{};f32x16 negm=f32x16{};asm volatile("":"+v"(negm));
  #define CMASK(P0,P1,t) do{}while(0)
  bool resc=false;
  #define START(P0,P1) do{ const float rm=rowmax(P0,P1); resc=false; \
    { const float dl=rm; mhat=fadd_s(mhat,dl); \
      _Pragma("unroll") for(int r=0;r<16;++r){P0[r]=fsub_s(P0[r],dl);P1[r]=fsub_s(P1[r],dl);} \
      _Pragma("unroll") for(int r=0;r<16;++r)negm[r]=-mhat; asm volatile("":"+v"(negm)); } \
    _Pragma("unroll") for(int r=0;r<16;++r)P0[r]=__builtin_amdgcn_exp2f(P0[r]); }while(0)
  #define RESC() do{ if(resc){ asm volatile("s_waitcnt lgkmcnt(0)":::"memory"); \
      _Pragma("unroll") for(int d_=0;d_<2;++d_) _Pragma("unroll") for(int r=0;r<16;++r)o[d_][r]*=wsf[crow(r,hi)]; } }while(0)
  f32x16 pA0,pA1,pB0,pB1;
  int sl_prev=0,sl_cur=0,sl_next=SLOTB;
  #define ROT() do{sl_prev=sl_cur;sl_cur=sl_next;sl_next=(sl_next==(NSLOT-1)*SLOTB)?0:sl_next+SLOTB;}while(0)
  DMA_K(2,2*SLOTB);
  WAIT_BAR(3);
  qkt(pA0,pA1,Kbase,qr,negm,r32,hi);asm volatile("s_nop 15\n\ts_nop 7":"+v"(pA0),"+v"(pA1));CMASK(pA0,pA1,0);
  START(pA0,pA1);
  _Pragma("unroll") for(int r=0;r<16;++r)pA1[r]=__builtin_amdgcn_exp2f(pA1[r]);
  WAIT_BAR(0);
  DMA_K(3,0);DMA_V(1,SLOTB);
  ROT();
  kload8(kf,kp0+sl_cur);
  WAIT_BAR(2);
  s16x4 vlo[8],vhi[8]; u32x4 pw0,pw1,pw2,pw3;
  #define PKW(P,B) cvtpk_s(P[B],P[B+1])
  #define PAF(k) __builtin_bit_cast(bf16x8,pw##k)
  #define VFR(i) (bf16x8){vlo[i][0],vlo[i][1],vlo[i][2],vlo[i][3],vhi[i][0],vhi[i][1],vhi[i][2],vhi[i][3]}
  #define PIN(x) asm volatile("":"+v"(x))
  #define MX3(a,b,c) __builtin_fmaxf(__builtin_fmaxf((a),(b)),(c))
  #define GAPA(MF,A0,A1,A2,A3,W0,W1,PW) do{ MF; sacc+=A0; sacc+=A1; sacc+=A2; sacc+=A3; PIN(sacc); W0; W1; PIN(PW); SBAR(); }while(0)
  #define EX(v) __builtin_amdgcn_exp2f(v)
  #define GAPB(MF,X,B) do{ MF; X[B]=EX(X[B]); X[B+1]=EX(X[B+1]); X[B+2]=EX(X[B+2]); X[B+3]=EX(X[B+3]); PIN(X); SBAR(); }while(0)
  #define VRD(i) do{ vlo[i]=vtr(vp_+(((i)>>2)*4096+((i)&3)*1024)); vhi[i]=vtr(vp_+(((i)>>2)*4096+((i)&3)*1024+512)); }while(0)
  #define KRD(G,j) do{ if(G){ kload2(kf,kp0+sl_next,j); SBAR(); } }while(0)
  #define STEP(C0,C1,P0,P1,t,GK,GV,GL) do{ SBAR(); \
    const lds_cptr vp_=vp0+sl_prev; \
    VRD(0); SBAR(); float sacc=(P0[0]+P0[1]); \
    GAPA(C0=__builtin_amdgcn_mfma_f32_32x32x16_bf16(kf[0],qr[0],negm,0,0,0), P0[2],P0[3],P0[4],P0[5],     pw0[0]=PKW(P0,0), pw0[1]=PKW(P0,2), pw0); \
    VRD(4); SBAR(); GAPA(C1=__builtin_amdgcn_mfma_f32_32x32x16_bf16(kf[1],qr[0],negm,0,0,0), P0[6],P0[7],P0[8],P0[9],     pw0[2]=PKW(P0,4), pw0[3]=PKW(P0,6), pw0); \
    VRD(1); SBAR(); GAPA(C0=__builtin_amdgcn_mfma_f32_32x32x16_bf16(kf[2],qr[1],C0,0,0,0),   P0[10],P0[11],P0[12],P0[13], pw1[0]=PKW(P0,8), pw1[1]=PKW(P0,10), pw1); \
    VRD(5); SBAR(); GAPA(C1=__builtin_amdgcn_mfma_f32_32x32x16_bf16(kf[3],qr[1],C1,0,0,0),   P0[14],P0[15],P1[0],P1[1],   pw1[2]=PKW(P0,12),pw1[3]=PKW(P0,14), pw1); \
    VRD(2); SBAR(); GAPA(C0=__builtin_amdgcn_mfma_f32_32x32x16_bf16(kf[4],qr[2],C0,0,0,0),   P1[2],P1[3],P1[4],P1[5],     pw2[0]=PKW(P1,0), pw2[1]=PKW(P1,2), pw2); \
    VRD(6); SBAR(); GAPA(C1=__builtin_amdgcn_mfma_f32_32x32x16_bf16(kf[5],qr[2],C1,0,0,0),   P1[6],P1[7],P1[8],P1[9],     pw2[2]=PKW(P1,4), pw2[3]=PKW(P1,6), pw2); \
    VRD(3); SBAR(); GAPA(C0=__builtin_amdgcn_mfma_f32_32x32x16_bf16(kf[6],qr[3],C0,0,0,0),   P1[10],P1[11],P1[12],P1[13], pw3[0]=PKW(P1,8), pw3[1]=PKW(P1,10), pw3); \
    VRD(7); SBAR(); GAPA(C1=__builtin_amdgcn_mfma_f32_32x32x16_bf16(kf[7],qr[3],C1,0,0,0),   P1[14],P1[15],0.f,0.f,       pw3[2]=PKW(P1,12),pw3[3]=PKW(P1,14), pw3); \
    l_reg+=sacc; \
    if(GK){DMA_K((t)+3,sl_cur);} if(GV){DMA_V((t)+1,sl_next);} \
    CMASK(C0,C1,t); \
    { float a=MX3(C0[0],C0[1],C1[0]),b=MX3(C0[2],C0[3],C1[1]); a=MX3(a,C1[2],C1[3]); \
      _Pragma("unroll") for(int r=4;r<16;r+=4){a=MX3(a,C0[r],C0[r+1]);b=MX3(b,C0[r+2],C0[r+3]);a=MX3(a,C1[r],C1[r+1]);b=MX3(b,C1[r+2],C1[r+3]);} \
      float rm=__builtin_fmaxf(a,b); { auto rr=__builtin_amdgcn_permlane32_swap(__float_as_uint(rm),__float_as_uint(rm),false,false); rm=__builtin_fmaxf(__uint_as_float(rr[0]),__uint_as_float(rr[1])); } \
      resc=false; \
      if(__builtin_expect(__any(rm>(float)THRL),0)){ const float dl=__builtin_fmaxf(rm,0.f); mhat+=dl; \
        _Pragma("unroll") for(int r=0;r<16;++r){C0[r]-=dl;C1[r]-=dl;} \
        _Pragma("unroll") for(int r=0;r<16;++r)negm[r]=-mhat; asm volatile("":"+v"(negm)); \
        const float f=__builtin_amdgcn_exp2f(-dl); l_reg*=f; if(hi==0)wsf[r32]=f; resc=true; } } \
    SBAR(); \
    GAPB(o[0]=__builtin_amdgcn_mfma_f32_32x32x16_bf16(PAF(0),VFR(0),o[0],0,0,0), C0,0); \
    GAPB(o[1]=__builtin_amdgcn_mfma_f32_32x32x16_bf16(PAF(0),VFR(4),o[1],0,0,0), C0,4); \
    KRD(GL,0); GAPB(o[0]=__builtin_amdgcn_mfma_f32_32x32x16_bf16(PAF(1),VFR(1),o[0],0,0,0), C0,8); \
    KRD(GL,1); GAPB(o[1]=__builtin_amdgcn_mfma_f32_32x32x16_bf16(PAF(1),VFR(5),o[1],0,0,0), C0,12); \
    KRD(GL,2); GAPB(o[0]=__builtin_amdgcn_mfma_f32_32x32x16_bf16(PAF(2),VFR(2),o[0],0,0,0), C1,0); \
    KRD(GL,3); GAPB(o[1]=__builtin_amdgcn_mfma_f32_32x32x16_bf16(PAF(2),VFR(6),o[1],0,0,0), C1,4); \
    GAPB(o[0]=__builtin_amdgcn_mfma_f32_32x32x16_bf16(PAF(3),VFR(3),o[0],0,0,0), C1,8); \
    GAPB(o[1]=__builtin_amdgcn_mfma_f32_32x32x16_bf16(PAF(3),VFR(7),o[1],0,0,0), C1,12); \
    }while(0)
  int t=1;
  for(;t+5<NT;t+=2){
    STEP(pB0,pB1,pA0,pA1,t,true,true,true);     WAIT_BAR(2); RESC(); ROT();
    STEP(pA0,pA1,pB0,pB1,t+1,true,true,true);   WAIT_BAR(2); RESC(); ROT();
  }
  #define ENDW(tt) do{ if((tt)+3<NT){WAIT_BAR(2);} else if((tt)+2<NT){WAIT_BAR(1);} else {WAIT_BAR(0);} }while(0)
  for(;t+1<NT;t+=2){
    STEP(pB0,pB1,pA0,pA1,t,(t+3<NT),(t+1<NT),(t+1<NT));       ENDW(t);   RESC(); ROT();
    STEP(pA0,pA1,pB0,pB1,t+1,(t+4<NT),(t+2<NT),(t+2<NT));     ENDW(t+1); RESC(); ROT();
  }
  STEP(pB0,pB1,pA0,pA1,NT-1,false,false,false); RESC();
  { float sacc=pB0[0]+pB0[1]; _Pragma("unroll") for(int r=2;r<16;++r)sacc+=pB0[r]; _Pragma("unroll") for(int r=0;r<16;++r)sacc+=pB1[r]; l_reg+=sacc;
    pw0=(u32x4){PKW(pB0,0),PKW(pB0,2),PKW(pB0,4),PKW(pB0,6)};pw1=(u32x4){PKW(pB0,8),PKW(pB0,10),PKW(pB0,12),PKW(pB0,14)};pw2=(u32x4){PKW(pB1,0),PKW(pB1,2),PKW(pB1,4),PKW(pB1,6)};pw3=(u32x4){PKW(pB1,8),PKW(pB1,10),PKW(pB1,12),PKW(pB1,14)};
    SBAR(); pv(o,vb0+sl_cur,PAF(0),PAF(1),PAF(2),PAF(3)); }
  #undef PKW
  #undef PAF
  #undef VFR
  #undef PIN
  #undef MX3
  #undef GAPA
  #undef GAPB
  #undef EX
  #undef VRD
  #undef KRD
  #undef STEP
  #undef ENDW
  {auto rr=__builtin_amdgcn_permlane32_swap(__float_as_uint(l_reg),__float_as_uint(l_reg),false,false);l_reg=__uint_as_float(rr[0])+__uint_as_float(rr[1]);}
  if(hi==0)wsf[32+r32]=l_reg;asm volatile("s_waitcnt lgkmcnt(0)":::"memory");
  float rli[16];
  #pragma unroll
  for(int r=0;r<16;++r)rli[r]=__builtin_amdgcn_rcpf(wsf[32+crow(r,hi)]);
  bf16*Ow=Ou+(long)(wid*QBLK)*OP;
  { bf16*stg=(bf16*)(shm+LDS_OST)+wid*2048;
    #pragma unroll
    for(int r=0;r<16;++r){const int orow=crow(r,hi);
      #pragma unroll
      for(int d0=0;d0<2;++d0)stg[orow*64+d0*32+r32]=__float2bfloat16(o[d0][r]*rli[r]);}
    asm volatile("s_waitcnt lgkmcnt(0)":::"memory");
    #pragma unroll
    for(int i=0;i<4;++i){const int row=i*8+(lane>>3),ch=lane&7; const u32x4 v=*(const u32x4*)(stg+row*64+ch*8); ATTN_STORE16(Ow+(long)row*OP+ch*8,v);} }
  asm volatile("s_waitcnt lgkmcnt(0)\n\ts_barrier":::"memory");
  #undef DMA_K
  #undef DMA_V
  #undef CMASK
  #undef START
  #undef RESC
  #undef ROT
}
constexpr int ATTN_LDS_BYTES=LDS_BYTES;
#undef SBAR
#undef WAIT_BAR
}

__device__ __forceinline__ int scan_row(int s, int dir) { return s < CT ? (dir ? CT - 1 - s : s) : (dir ? CT + (TL - 1 - (s - CT)) : s); }
typedef short sbf8 __attribute__((ext_vector_type(8)));
constexpr int CH_LD = 72;
constexpr int CA_LL = 0, CA_GT = 16384, CA_GC = 129536, CA_MA = 18944, CA_NKV = CA_MA + 18432, CA_MT = 55808, CA_MN = 83456, CA_MW = 111104;
constexpr int NA_LD = 68, TB_LD = 17;
constexpr int NCHUNK = SB / 64;
constexpr size_t SCA_PT = 0, SCA_RY = (size_t)32 * NCHUNK * 4096 * 2, SCA_Q = 2 * SCA_RY, SCA_END = SCA_Q + (size_t)32 * NCHUNK * 4096 * 4;
static_assert(SCA_END <= (size_t)M * NINP * 2, "stage-A outputs fit the U region");
__device__ __forceinline__ f32x4 mma_nt64(const LAS bf16* A, const LAS bf16* B, int ti, int tj, int fr, int fq, f32x4 acc) {
#pragma unroll
    for (int kb = 0; kb < 2; ++kb) {
        const sbf8 a = *(const LAS sbf8*)(A + (16 * ti + fr) * CH_LD + kb * 32 + 8 * fq);
        const sbf8 b = *(const LAS sbf8*)(B + (16 * tj + fr) * CH_LD + kb * 32 + 8 * fq);
        acc = __builtin_amdgcn_mfma_f32_16x16x32_bf16(a, b, acc, 0, 0, 0);
    }
    return acc;
}
__device__ __forceinline__ float quad_sum(float x) {
    float r;
    asm("s_nop 1\n\tv_add_f32_dpp %0, %1, %1 quad_perm:[1,0,3,2] row_mask:0xf bank_mask:0xf\n\ts_nop 1\n\t"
        "v_add_f32_dpp %0, %0, %0 quad_perm:[2,3,0,1] row_mask:0xf bank_mask:0xf\n\ts_nop 0" : "=&v"(r) : "v"(x));
    return r;
}
struct AIn { f32x4 lw0, lw1; v4u kk, ka, ke, rr, vv; };
__device__ __forceinline__ void scanA_issue(const Frame& F, int ch, int c, AIn& in) {
    const int dir = ch >> 4, b = (ch >> 2) & 3, h = ch & 3;
    const size_t rb = (size_t)b * SB, dofs = (size_t)dir * M * 256; const int col0 = h * 64, s_base = c * 64, tid = F.tid;
    size_t z_ = 0; asm volatile("" : "+s"(z_));
    unsigned char* wsb = F.ws + z_;
    const float* LWg = (const float*)(wsb + WS_AR + AR_W) + dofs;
    const bf16* KKg = (const bf16*)(wsb + WS_AR + AR_KK); const bf16* KAg = (const bf16*)(wsb + WS_AR + AR_KKA) + dofs; const bf16* KEg = (const bf16*)(wsb + WS_AR + AR_KE) + dofs;
    const bf16* Rg = (const bf16*)(wsb + WS_AR + AR_R); const bf16* Vg = (const bf16*)(wsb + WS_AR + AR_V);
    { const int t = tid >> 3, k0 = (tid & 7) * 8; const size_t g = (rb + scan_row(s_base + t, dir)) * 256 + col0 + k0;
      in.lw0 = *(const f32x4*)(LWg + g); in.lw1 = *(const f32x4*)(LWg + g + 4);
      in.kk = *(const v4u*)(KKg + g); in.ka = *(const v4u*)(KAg + g); in.ke = *(const v4u*)(KEg + g); in.rr = *(const v4u*)(Rg + g); in.vv = *(const v4u*)(Vg + g); }
}
__device__ __forceinline__ void scanA_task(const Frame& F, int ch, int c, float* Y0dst, size_t y0_row_stride_sel  , AIn& in, bool has_next, int nch, int nc) {
    const int dir = ch >> 4, b = (ch >> 2) & 3, h = ch & 3;
    const size_t rb = (size_t)b * SB, dofs = (size_t)dir * M * 256; const int col0 = h * 64;
    const float* LWg = (const float*)(F.ws + WS_AR + AR_W) + dofs;
    const bf16* KKg = (const bf16*)(F.ws + WS_AR + AR_KK); const bf16* KAg = (const bf16*)(F.ws + WS_AR + AR_KKA) + dofs; const bf16* KEg = (const bf16*)(F.ws + WS_AR + AR_KE) + dofs;
    const bf16* Rg = (const bf16*)(F.ws + WS_AR + AR_R); const bf16* Vg = (const bf16*)(F.ws + WS_AR + AR_V);
    unsigned char* ob = F.ws + WS_AR + AR_U; const size_t tsk = (size_t)ch * NCHUNK + c;
    bf16* PTg = (bf16*)(ob + SCA_PT) + tsk * 4096; bf16* RYg = (bf16*)(ob + SCA_RY) + tsk * 4096; float* Qg = (float*)(ob + SCA_Q) + tsk * 4096;
    LAS float* LL = (LAS float*)(F.lds + CA_LL); LAS float* GT = (LAS float*)(F.lds + CA_GT); LAS float* GC = (LAS float*)(F.lds + CA_GC);
    LAS bf16* KKG = (LAS bf16*)(F.lds + CA_MA); LAS bf16* RG = KKG + 64 * CH_LD; LAS bf16* AG = RG + 64 * CH_LD; LAS bf16* KG = AG + 64 * CH_LD;
    LAS float* NKV = (LAS float*)(F.lds + CA_NKV);
    LAS bf16* AHT = (LAS bf16*)(F.lds + CA_MT); LAS bf16* KHT = AHT + 64 * CH_LD; LAS bf16* VT = KHT + 64 * CH_LD;
    LAS bf16* NK = (LAS bf16*)(F.lds + CA_MN); LAS bf16* MA = NK + 64 * CH_LD; LAS bf16* MK = MA + 64 * CH_LD;
    LAS bf16* W1T = (LAS bf16*)(F.lds + CA_MW); LAS bf16* W2T = W1T + 64 * CH_LD;
    int tid_ = F.tid; asm volatile("" : "+v"(tid_));
    const int tid = tid_, lane = tid & 63, wv = F.wave, fr = lane & 15, fq = lane >> 4;
    const int s_base = c * 64;
    SUBT(8);
    for (int rep1 = 0; rep1 < (SCANA_REP == 1 ? 2 : 1); ++rep1) {
    { const int t = tid >> 3, k0 = (tid & 7) * 8;
      *(LAS f32x4*)(LL + t * 64 + k0) = in.lw0; *(LAS f32x4*)(LL + t * 64 + k0 + 4) = in.lw1; }
    LDS_BARRIER();
    { const int k = tid & 63, g = tid >> 6; float v[8];
#pragma unroll
      for (int j = 0; j < 8; ++j) v[j] = LL[(8 * g + j) * 64 + k];
#pragma unroll
      for (int j = 1; j < 8; ++j) v[j] += v[j - 1];
      GT[g * 64 + k] = v[7];
      LDS_BARRIER();
      float off = 0.f;
#pragma unroll
      for (int g2 = 0; g2 < 7; ++g2) off += (g2 < g) ? GT[g2 * 64 + k] : 0.f;
#pragma unroll
      for (int j = 0; j < 8; ++j) LL[(8 * g + j) * 64 + k] = v[j] + off; }
    LDS_BARRIER();
    }
    SUBT(9);
    for (int rep2 = 0; rep2 < (SCANA_REP == 2 ? 2 : 1); ++rep2) {
    { const int t = tid >> 3, k0 = (tid & 7) * 8;
      float kk[8], ka[8], ke[8], rr[8], o1[8], o2[8], o3[8], o4[8];
      unpack8(in.kk, kk); unpack8(in.ka, ka); unpack8(in.ke, ke); unpack8(in.rr, rr);
#pragma unroll
      for (int e = 0; e < 8; ++e) { const float Lt = LL[t * 64 + k0 + e], Lp = t > 0 ? LL[(t - 1) * 64 + k0 + e] : 0.f;
          const float e3 = __expf(-Lt);
          o1[e] = kk[e] * __expf(Lp); o2[e] = rr[e] * __expf(Lt); o3[e] = ka[e] * e3; o4[e] = ke[e] * e3; }
      *(LAS v4u*)(KKG + t * CH_LD + k0) = pack8(o1); *(LAS v4u*)(RG + t * CH_LD + k0) = pack8(o2); *(LAS v4u*)(AG + t * CH_LD + k0) = pack8(o3); *(LAS v4u*)(KG + t * CH_LD + k0) = pack8(o4);
      LAS bf16* RAW = (LAS bf16*)(F.lds + CA_MN);
      *(LAS v4u*)(RAW + t * 64 + k0) = in.ka; *(LAS v4u*)(RAW + 4096 + t * 64 + k0) = in.ke; *(LAS v4u*)(RAW + 8192 + t * 64 + k0) = in.vv; }
    LDS_BARRIER();
    { const int k = tid & 63, t0 = (tid >> 6) * 8; const float LC = LL[63 * 64 + k];
      float o1[8], o2[8], o3[8];
#pragma unroll
      for (int j = 0; j < 8; ++j) { const LAS bf16* RAW = (const LAS bf16*)(F.lds + CA_MN);
          const float e4 = __expf(LC - LL[(t0 + j) * 64 + k]);
          o1[j] = bf2f(RAW[(t0 + j) * 64 + k]) * e4; o2[j] = bf2f(RAW[4096 + (t0 + j) * 64 + k]) * e4; o3[j] = bf2f(RAW[8192 + (t0 + j) * 64 + k]); }
      *(LAS v4u*)(AHT + k * CH_LD + t0) = pack8(o1); *(LAS v4u*)(KHT + k * CH_LD + t0) = pack8(o2); *(LAS v4u*)(VT + k * CH_LD + t0) = pack8(o3);
      if (t0 == 0) GC[k] = __expf(LC); }
    }
    LDS_BARRIER();
    if (has_next) scanA_issue(F, nch, nc, in);
    SUBT(10);
    const int ti = wv & 3;
    for (int rep3 = 0; rep3 < (SCANA_REP == 3 ? 2 : 1); ++rep3)
#pragma unroll
    for (int jj = 0; jj < 2; ++jj) {
        const int tj = 2 * (wv >> 2) + jj;
        const f32x4 z4 = {0.f, 0.f, 0.f, 0.f};
        f32x4 na = z4, nk = z4, ma = z4, mk = z4;
        if (tj <= ti) { na = mma_nt64(KKG, AG, ti, tj, fr, fq, z4); nk = mma_nt64(KKG, KG, ti, tj, fr, fq, z4); ma = mma_nt64(RG, AG, ti, tj, fr, fq, z4); mk = mma_nt64(RG, KG, ti, tj, fr, fq, z4); }
        const int i = 16 * tj + fr;
#pragma unroll
        for (int rg = 0; rg < 4; ++rg) { const int t = 16 * ti + 4 * fq + rg;
            const bool lo = i < t, le = i <= t;
            LL[t * NA_LD + i] = lo ? na[rg] : 0.f;
            NK[t * CH_LD + i] = (bf16)f2bf(lo ? nk[rg] : 0.f); MA[t * CH_LD + i] = (bf16)f2bf(le ? ma[rg] : 0.f); MK[t * CH_LD + i] = (bf16)f2bf(le ? mk[rg] : 0.f); }
    }
    LDS_BARRIER();
    SUBT(11);
    f32x4 mkv[2];
#pragma unroll
    for (int jj = 0; jj < 2; ++jj) {
        const int tj = 2 * (wv >> 2) + jj; const f32x4 z4 = {0.f, 0.f, 0.f, 0.f};
        const f32x4 nkv = mma_nt64(NK, VT, ti, tj, fr, fq, z4); mkv[jj] = mma_nt64(MK, VT, ti, tj, fr, fq, z4);
#pragma unroll
        for (int rg = 0; rg < 4; ++rg) NKV[(16 * ti + 4 * fq + rg) * 64 + 16 * tj + fr] = nkv[rg];
    }
    LDS_BARRIER();
    SUBT(12);
    { LAS float* NaR = LL;
      LAS float* TB = (LAS float*)(F.lds + CA_MN + 18432);
      LAS float* XW = wv < 5 ? (LAS float*)(F.lds + CA_NKV) + wv * 768 : (LAS float*)(F.lds + CA_MN) + (wv - 5) * 768;
      const int col = 16 * wv + fr;
      float Rr[4][4];
#pragma unroll
      for (int bb = 0; bb < 4; ++bb)
#pragma unroll
          for (int rg = 0; rg < 4; ++rg) { const int t = 16 * bb + 4 * fq + rg; Rr[bb][rg] = wv < 4 ? bf2f(KKG[t * CH_LD + col]) : NKV[t * 64 + (col - 64)]; }
      if (wv < 4 && lane < 16) {
          const int bb = wv, c = lane; float Tc[16];
#pragma unroll
          for (int r = 0; r < 16; ++r) {
              float acc = (r == c) ? 1.f : 0.f;
#pragma unroll
              for (int i4 = 0; i4 < r; i4 += 4) { const f32x4 dv = *(const LAS f32x4*)(NaR + (16 * bb + r) * NA_LD + 16 * bb + i4);
#pragma unroll
                  for (int e = 0; e < 4; ++e) if (i4 + e < r) acc -= dv[e] * Tc[i4 + e]; }
              Tc[r] = acc; TB[(bb * 16 + r) * TB_LD + c] = acc;
          }
      }
      LDS_BARRIER();
      LAS bf16* WT = wv < 4 ? (W1T + col * CH_LD) : (W2T + (col - 64) * CH_LD);
#pragma unroll
      for (int bb = 0; bb < 4; ++bb) {
          f32x4 z = {0.f, 0.f, 0.f, 0.f};
#pragma unroll
          for (int st = 0; st < 4 * bb; ++st) z = __builtin_amdgcn_mfma_f32_16x16x4f32(NaR[(16 * bb + fr) * NA_LD + 4 * st + fq], XW[(4 * st + fq) * 16 + fr], z, 0, 0, 0);
          LAS float* RW = XW + (bb < 3 ? 16 * bb : 0) * 16;
#pragma unroll
          for (int rg = 0; rg < 4; ++rg) RW[(4 * fq + rg) * 16 + fr] = Rr[bb][rg] - z[rg];
          asm volatile("s_waitcnt lgkmcnt(0)" ::: "memory");
          f32x4 xb = {0.f, 0.f, 0.f, 0.f};
#pragma unroll
          for (int st = 0; st < 4; ++st) xb = __builtin_amdgcn_mfma_f32_16x16x4f32(TB[(bb * 16 + fr) * TB_LD + 4 * st + fq], RW[(4 * st + fq) * 16 + fr], xb, 0, 0, 0);
          asm volatile("s_waitcnt lgkmcnt(0)" ::: "memory");
          if (bb < 3) {
#pragma unroll
              for (int rg = 0; rg < 4; ++rg) XW[(16 * bb + 4 * fq + rg) * 16 + fr] = xb[rg];
          }
          v2u w_; w_.x = pk2(xb[0], xb[1]); w_.y = pk2(xb[2], xb[3]);
          *(LAS v2u*)(WT + 16 * bb + 4 * fq) = w_;
          asm volatile("s_waitcnt lgkmcnt(0)" ::: "memory");
      } }
    LDS_BARRIER();
    SUBT(13);
#pragma unroll
    for (int jj = 0; jj < 2; ++jj) {
        const int tj = 2 * (wv >> 2) + jj; const f32x4 z4 = {0.f, 0.f, 0.f, 0.f};
        const f32x4 a1 = mma_nt64(MA, W1T, ti, tj, fr, fq, z4), a2 = mma_nt64(MA, W2T, ti, tj, fr, fq, z4);
        const f32x4 a3 = mma_nt64(AHT, W1T, ti, tj, fr, fq, z4);
        const f32x4 a4 = mma_nt64(VT, KHT, ti, tj, fr, fq, z4), a5 = mma_nt64(W2T, AHT, ti, tj, fr, fq, z4);
        const int cc = 16 * tj + fr;
#pragma unroll
        for (int rg = 0; rg < 4; ++rg) { const int r_ = 16 * ti + 4 * fq + rg;
            RYg[r_ * 64 + cc] = (bf16)f2bf(bf2f(RG[r_ * CH_LD + cc]) - a1[rg]);
            const size_t yrow = y0_row_stride_sel ? (size_t)(s_base + r_) : (rb + scan_row(s_base + r_, dir));
            Y0dst[((size_t)dir * (y0_row_stride_sel ? (size_t)SB : (size_t)M) + yrow) * 256 + col0 + cc] = mkv[jj][rg] - a2[rg];
            PTg[r_ * 64 + cc] = (bf16)f2bf((r_ == cc ? GC[cc] : 0.f) - a3[rg]);
            Qg[r_ * 64 + cc] = a4[rg] - a5[rg]; }
    }
    SUBT(14);
    LDS_BARRIER();
    SUBT(15);
}

constexpr int BC_RY = 0, BC_PT = 9216, BC_Q = 18432, BC_QLD = 68, BC_Y = BC_Q + 32 * BC_QLD * 4, BC_BUF = BC_Y + 64 * 32 * 4  , BC_S = 2 * BC_BUF;
__device__ __forceinline__ void scanBC_task(const Frame& F, int ch, int half, float* Ybuf, int ydebug, const float* cmp, unsigned* dmax) {
    const int dir = ch >> 4, b = (ch >> 2) & 3, h = ch & 3;
    const size_t rb = (size_t)b * SB; const int col0 = h * 64;
    unsigned char* ob = F.ws + WS_AR + AR_U;
    const bf16* PTg = (const bf16*)(ob + SCA_PT) + (size_t)ch * NCHUNK * 4096; const bf16* RYg = (const bf16*)(ob + SCA_RY) + (size_t)ch * NCHUNK * 4096;
    const float* Qg = (const float*)(ob + SCA_Q) + (size_t)ch * NCHUNK * 4096;
    LAS bf16* SB0 = (LAS bf16*)(F.lds + BC_S);
    const int tid = F.tid, lane = F.lane, wv = F.wave, fr = lane & 15, fq = lane >> 4;
    const int srb = wv & 1, scb = wv >> 1, ytb = wv & 3, yrb = wv >> 2;
    for (int i = tid; i < 2 * 32 * CH_LD / 2; i += NTHR) ((LAS unsigned*)SB0)[i] = 0u;
    float dm = 0.f;
    const int g_rp = (tid >> 3) * 64 + (tid & 7) * 8, l_rp = (tid >> 3) * CH_LD + (tid & 7) * 8;
    const int g_q = (half * 32 + (tid >> 4)) * 64 + (tid & 15) * 4, l_q = (tid >> 4) * BC_QLD + (tid & 15) * 4;
    const int y_t = tid >> 3, y_r4 = (tid & 7) * 4;
    const size_t ydir = (size_t)dir * (ydebug ? (size_t)SB : (size_t)M);
    v4u a_ry, a_pt, b_ry, b_pt; f32x4 a_q, a_y, b_q, b_y;
#define BC_LOAD(c, RYv, PTv, Qv, Yv) do { const size_t o_ = (size_t)(c) * 4096; RYv = *(const v4u*)(RYg + o_ + g_rp); PTv = *(const v4u*)(PTg + o_ + g_rp); Qv = *(const f32x4*)(Qg + o_ + g_q); \
        const int s_ = (c) * 64 + y_t; const size_t yrow_ = ydebug ? (size_t)s_ : (rb + scan_row(s_, dir)); Yv = *(const f32x4*)(Ybuf + (ydir + yrow_) * 256 + col0 + half * 32 + y_r4); } while (0)
#define BC_PARK(c, RYv, PTv, Qv, Yv) do { LAS unsigned char* d_ = F.lds + ((c) & 1) * BC_BUF; *(LAS v4u*)((LAS bf16*)(d_ + BC_RY) + l_rp) = RYv; *(LAS v4u*)((LAS bf16*)(d_ + BC_PT) + l_rp) = PTv; \
        *(LAS f32x4*)((LAS float*)(d_ + BC_Q) + l_q) = Qv; *(LAS f32x4*)((LAS float*)(d_ + BC_Y) + y_t * 32 + y_r4) = Yv; } while (0)
#define BC_STEP(c, RYv, PTv, Qv, Yv) do { \
        const LAS unsigned char* o_ = F.lds + ((c) & 1) * BC_BUF; const LAS bf16* Sc = SB0 + ((c) & 1) * 32 * CH_LD; LAS bf16* Sn = SB0 + (((c) + 1) & 1) * 32 * CH_LD; \
        const LAS bf16* RYs = (const LAS bf16*)(o_ + BC_RY); const LAS bf16* PTs = (const LAS bf16*)(o_ + BC_PT); const LAS float* Qs = (const LAS float*)(o_ + BC_Q); const LAS float* Ys = (const LAS float*)(o_ + BC_Y); \
        f32x4 yacc, sacc; \
        _Pragma("unroll") for (int rg = 0; rg < 4; ++rg) { yacc[rg] = Ys[(16 * ytb + 4 * fq + rg) * 32 + 16 * yrb + fr]; sacc[rg] = Qs[(16 * srb + 4 * fq + rg) * BC_QLD + 16 * scb + fr]; } \
        _Pragma("unroll") for (int kb = 0; kb < 2; ++kb) { \
            const sbf8 ya = *(const LAS sbf8*)(RYs + (16 * ytb + fr) * CH_LD + kb * 32 + 8 * fq), yb = *(const LAS sbf8*)(Sc + (16 * yrb + fr) * CH_LD + kb * 32 + 8 * fq); \
            const sbf8 sa = *(const LAS sbf8*)(Sc + (16 * srb + fr) * CH_LD + kb * 32 + 8 * fq), sb_ = *(const LAS sbf8*)(PTs + (16 * scb + fr) * CH_LD + kb * 32 + 8 * fq); \
            yacc = __builtin_amdgcn_mfma_f32_16x16x32_bf16(ya, yb, yacc, 0, 0, 0); sacc = __builtin_amdgcn_mfma_f32_16x16x32_bf16(sa, sb_, sacc, 0, 0, 0); } \
        _Pragma("unroll") for (int rg = 0; rg < 4; ++rg) Sn[(16 * srb + 4 * fq + rg) * CH_LD + 16 * scb + fr] = (bf16)f2bf(sacc[rg]); \
        _Pragma("unroll") for (int rg = 0; rg < 4; ++rg) { const int s_ = (c) * 64 + 16 * ytb + 4 * fq + rg; \
            if (cmp) { const float ref_ = cmp[((size_t)dir * M + rb + scan_row(s_, dir)) * 256 + col0 + half * 32 + 16 * yrb + fr]; dm = fmaxf(dm, fabsf(yacc[rg] - ref_)); } \
            else { const size_t yrow_ = ydebug ? (size_t)s_ : (rb + scan_row(s_, dir)); Ybuf[(ydir + yrow_) * 256 + col0 + half * 32 + 16 * yrb + fr] = yacc[rg]; } } \
        if ((c) + 1 < NCHUNK) BC_PARK((c) + 1, RYv, PTv, Qv, Yv); \
        if ((c) + 3 < NCHUNK) BC_LOAD((c) + 3, RYv, PTv, Qv, Yv); \
        LDS_BARRIER(); } while (0)
    BC_LOAD(0, a_ry, a_pt, a_q, a_y); BC_LOAD(1, b_ry, b_pt, b_q, b_y);
    BC_PARK(0, a_ry, a_pt, a_q, a_y);
    BC_LOAD(2, a_ry, a_pt, a_q, a_y);
    LDS_BARRIER();
    for (int c = 0; c < NCHUNK; c += 2) {
        BC_STEP(c, b_ry, b_pt, b_q, b_y);
        BC_STEP(c + 1, a_ry, a_pt, a_q, a_y);
    }
#undef BC_LOAD
#undef BC_PARK
#undef BC_STEP
    if (cmp) { dm = fmaxf(dm, __shfl_xor(dm, 1)); dm = fmaxf(dm, __shfl_xor(dm, 2)); dm = fmaxf(dm, __shfl_xor(dm, 4)); dm = fmaxf(dm, __shfl_xor(dm, 8)); dm = fmaxf(dm, __shfl_xor(dm, 16)); dm = fmaxf(dm, __shfl_xor(dm, 32));
        if (lane == 0) atomicMax(dmax, __builtin_bit_cast(unsigned, dm)); }
    __syncthreads();
}

__device__ __forceinline__ void scan_mixer_phase(const Frame& F, int l) {
    typedef attn_body::bf16 abf;
    const abf* U = (const abf*)(F.ws + WS_AR + AR_QKV); abf* MIX = (abf*)(F.ws + WS_AR + AR_MIX);
    char* shm = (char*)F.lds;
    float* Y = (float*)(F.ws + WS_AR + AR_Y);
    const int g = F.bid >> 3, x = F.bid & 7;
    const bool scan_cu = (g & 3) == 3;
    SUBT(16);
    { int t0, nt_;
      if (scan_cu) { t0 = 5 * (g >> 2); nt_ = 5; } else { const int a = g - (g >> 2); t0 = 40 + (a < 16 ? 10 * a : 160 + 9 * (a - 16)); nt_ = a < 16 ? 10 : 9; }
      AIn ain;
      { const int cl = t0 / NCHUNK, bh = 2 * x + (cl >> 1), dir = cl & 1; scanA_issue(F, (dir * 4 + (bh >> 2)) * 4 + (bh & 3), t0 % NCHUNK, ain); }
      for (int lt = t0; lt < t0 + nt_; ++lt) { const int cl = lt / NCHUNK, bh = 2 * x + (cl >> 1), dir = cl & 1;
          const int l2 = lt + 1, cl2 = l2 / NCHUNK, bh2 = 2 * x + (cl2 >> 1), dir2 = cl2 & 1;
          scanA_task(F, (dir * 4 + (bh >> 2)) * 4 + (bh & 3), lt % NCHUNK, Y, 0, ain, l2 < t0 + nt_, (dir2 * 4 + (bh2 >> 2)) * 4 + (bh2 & 3), l2 % NCHUNK); } }
    SUBT(17);
    unsigned* arrive = (unsigned*)(F.ws + WS_CTL) + 9600 + l * 64;
    asm volatile("s_waitcnt vmcnt(0)" ::: "memory");
    __syncthreads();
    if (F.tid == 0) { __builtin_amdgcn_fence(__ATOMIC_RELEASE, "agent"); asm volatile("s_waitcnt vmcnt(0)" ::: "memory"); __hip_atomic_fetch_add(arrive + 32 + x, 1u, __ATOMIC_RELAXED, __HIP_MEMORY_SCOPE_AGENT); }
    SUBT(18);
    const int a_ns = g - (g >> 2);
    if (l + 1 < NL && !scan_cu && a_ns >= 16 && a_ns < 20) {
        const int hh = a_ns - 16;
        const int b = x >> 1, kvh = x & 1, h = kvh * 4 + hh; const size_t r0 = (size_t)b * SB;
        attn_body::attn_unit<8>(U + r0 * QKVP + h * 64, U + r0 * QKVP + K_OFF + kvh * 64, U + r0 * QKVP + V_OFF + kvh * 64, MIX + r0 * D + h * 64, CT / 64, shm);
    }
    SUBT(19);
    unsigned* ctr = (unsigned*)(F.ws + WS_CTL) + 9216 + l * 64 + x * 8;
    volatile LAS unsigned* qw = (volatile LAS unsigned*)(F.lds + MISC_OFF + 64);
    const int b = x >> 1, kvh = x & 1; const size_t r0 = (size_t)b * SB;
#define AQ_TAKE(jv) do { if (F.tid == 0) qw[0] = __hip_atomic_fetch_add(ctr, 1u, __ATOMIC_RELAXED, __HIP_MEMORY_SCOPE_AGENT); __syncthreads(); jv = (int)qw[0]; __syncthreads(); } while (0)
#define AQ_UNIT(jv) do { const int h_ = kvh * 4 + ((jv) >> 4), qb_ = (jv) & 15; const size_t q0_ = r0 + CT + (size_t)qb_ * 256; \
        attn_body::attn_unit<8>(U + q0_ * QKVP + h_ * 64, U + r0 * QKVP + K_OFF + kvh * 64, U + r0 * QKVP + V_OFF + kvh * 64, MIX + q0_ * D + h_ * 64, SB / 64, shm); } while (0)
    int j0; AQ_TAKE(j0);
    if (j0 < 64) AQ_UNIT(j0);
    if (scan_cu) {
        if (F.tid == 0) { unsigned sp = 0;
            while (__hip_atomic_load(arrive + 32 + x, __ATOMIC_RELAXED, __HIP_MEMORY_SCOPE_AGENT) < 32u) { __builtin_amdgcn_s_sleep(2); if (++sp > (1u << 22)) break; }
            __builtin_amdgcn_fence(__ATOMIC_ACQUIRE, "agent"); asm volatile("s_waitcnt vmcnt(0)" ::: "memory"); }
        __syncthreads();
        const int sc = (g >> 2) * 8 + x, t = sc >> 3, bh = 2 * x + (t >> 2);
        scanBC_task(F, (((t >> 1) & 1) * 4 + (bh >> 2)) * 4 + (bh & 3), t & 1, Y, 0, nullptr, nullptr);
        asm volatile("s_waitcnt vmcnt(0)" ::: "memory");
        __syncthreads();
        if (F.tid == 0) { __builtin_amdgcn_fence(__ATOMIC_RELEASE, "agent"); asm volatile("s_waitcnt vmcnt(0)" ::: "memory"); __hip_atomic_fetch_add(arrive + 16, 1u, __ATOMIC_RELAXED, __HIP_MEMORY_SCOPE_AGENT); }
    }
    if (j0 < 64) for (;;) { int j; AQ_TAKE(j); if (j >= 64) break; AQ_UNIT(j); }
#undef AQ_TAKE
#undef AQ_UNIT
    SUBT(20);
    if (F.tid == 0) { unsigned sp = 0;
        while (__hip_atomic_load(arrive + 16, __ATOMIC_RELAXED, __HIP_MEMORY_SCOPE_AGENT) < 64u) { __builtin_amdgcn_s_sleep(2); if (++sp > (1u << 22)) break; }
        __builtin_amdgcn_fence(__ATOMIC_ACQUIRE, "agent"); asm volatile("s_waitcnt vmcnt(0)" ::: "memory"); }
    __syncthreads();
    SUBT(21);
    rwkv_out_phase(F, l);
    SUBT(22);
}

struct CtxSplitOrder {
    int G, c, ntk, nks, nsub;
    __device__ void init(int G_, int c_, int ntk_, int nctx) { G = G_; c = c_; ntk = ntk_; nks = ntk_ / 4; nsub = nctx * 4 * nks; }
    __device__ bool next(int i, pg8::Unit& u) const {
        const int Lx = i * G + c;
        if (Lx < 256) {
            int wgid = Lx; { const int q = 256 / 8, xcd = wgid % 8, off = wgid / 8; wgid = xcd * q + off; }
            const int nig = 8 * 4, gid = wgid / nig, fm = gid * 8;
            const int pm64 = fm + ((wgid % nig) % 8); u.pn = (wgid % nig) / 8;
            u.pm = pm64 + pm64 / 16 + 1; u.k0t = 0; u.nt = ntk; u.slot = -1; return true;
        }
        const int sub = Lx - 256; if (sub >= nsub) return false;
        const int ks = sub % nks, ct = sub / nks;
        u.pm = (ct >> 2) * 17; u.pn = ct & 3; u.k0t = ks * 4; u.nt = 4; u.slot = ks; return true;
    }
    __device__ __forceinline__ void a_ready(const pg8::Unit&) const {}
    __device__ __forceinline__ void done(const pg8::Unit&) const {}
};

constexpr int NPL = 11, NPHASE = 2 + NPL * NL;
#define PH_IN(k) (lo <= (k) && (k) < hi)
#if PROBE_MASK
#define PH_STAMP(k) do { if (blockIdx.x == 0 && threadIdx.x == 0) ((unsigned long long*)(F.ws + WS_CTL + 32768))[(k) + 1] = __builtin_amdgcn_s_memrealtime(); } while (0)
#else
#define PH_STAMP(k) do { } while (0)
#endif
#define PH_SEAM(k) do { if (PH_IN(k) && PH_IN((k) + 1)) xcd_barrier(bar); PH_STAMP(k); } while (0)
template <int L> __device__ __forceinline__ void layer_phases(const Frame& F, const int lo, const int hi, const XcdBarrier& bar) {
    constexpr int pb = 2 + NPL * L;
    bf16* XN = (bf16*)(F.ws + WS_AR + AR_XN); bf16* U = (bf16*)(F.ws + WS_AR + AR_U); bf16* MIX = (bf16*)(F.ws + WS_AR + AR_MIX);
    float* MIXO = (float*)(F.ws + WS_AR + AR_MIXO); bf16* H = (bf16*)(F.ws + WS_AR + AR_H); bf16* ACT = (bf16*)(F.ws + WS_AR + AR_ACT); float* FO = (float*)(F.ws + WS_AR + AR_FO);
    bf16* t_in = (bf16*)(F.ws + WS_WIN); bf16* t_out = (bf16*)(F.ws + WS_WOUT); bf16* t_up = (bf16*)(F.ws + WS_WUP); bf16* t_dn = (bf16*)(F.ws + WS_WDN);
    if (PH_IN(pb + 0)) { pg8::Gemm g{XN, t_in, M, NINP, D}; pg8::StaticOrder S; S.init(M, NINP, F.G, F.bid, D);
        pg8::EpiBf16<0> E{U, NINP, nullptr, 0, 0, 1.f};
        pg8::gemm_phase<pg8::EpiBf16<0>, pg8::StaticOrder, true, true>(F.lds, g, S, E); }
    PH_SEAM(pb + 0);
    if (PH_IN(pb + 1)) prep_phase(F, L);
    PH_SEAM(pb + 1);
    if (PH_IN(pb + 2)) scan_mixer_phase(F, L);
    PH_STAMP(pb + 2); PH_STAMP(pb + 3);
    PH_SEAM(pb + 4);
    if (PH_IN(pb + 5)) { pg8::Gemm g{MIX, t_out, M, D, D}; CtxSplitOrder S; S.init(F.G, F.bid, D / 64, L + 1 < NL ? 4 : 0);
        pg8::EpiBf16P E{(bf16*)MIXO, D, (float*)(F.ws + WS_AR + AR_PART)};
        pg8::gemm_phase<pg8::EpiBf16P, CtxSplitOrder, true, true>(F.lds, g, S, E); }
    PH_SEAM(pb + 5);
    if (PH_IN(pb + 6)) norm_phase(F, 1, MIXO, INP(I_NMPOST) + L * D, L, 2, INP(I_NFPRE) + L * D, L, 3, 4, L + 1 < NL ? D / 256 : 0);
    PH_SEAM(pb + 6);
    if (PH_IN(pb + 7)) { pg8::Gemm g{XN, t_up, M, DFF2, D}; pg8::StaticOrder S; S.init(M, DFF2, F.G, F.bid, D);
        pg8::EpiBf16<0> E{H, DFF2, nullptr, 0, 0, 1.f};
        pg8::gemm_phase<pg8::EpiBf16<0>, pg8::StaticOrder, true, true>(F.lds, g, S, E); }
    PH_SEAM(pb + 7);
    if (PH_IN(pb + 8)) act_phase(F, L);
    PH_SEAM(pb + 8);
    if (PH_IN(pb + 9)) { pg8::Gemm g{ACT, t_dn, M, D, DFF}; CtxSplitOrder S; S.init(F.G, F.bid, DFF / 64, L + 1 < NL ? 4 : 0);
        pg8::EpiBf16P E{(bf16*)FO, D, (float*)(F.ws + WS_AR + AR_PART)};
        pg8::gemm_phase<pg8::EpiBf16P, CtxSplitOrder, true, true>(F.lds, g, S, E); }
    PH_SEAM(pb + 9);
    if (PH_IN(pb + 10)) {
        if (L + 1 < NL) { norm_phase(F, 1, FO, INP(I_NFPOST) + L * D, L, 5, INP(I_NMPRE) + (L + 1 < NL ? L + 1 : L) * D, L + 1, 0, 1, DFF / 256); __syncthreads(); convert_weights(F, L + 1); }
        else norm_phase(F, 2, FO, INP(I_NFPOST) + L * D, L, 5, nullptr, 0, 0, 0, 0);
    }
    if (L + 1 < NL) PH_SEAM(pb + 10); else PH_STAMP(pb + 10);
}
__global__ void __launch_bounds__(NTHR, 2) mk_fwd(Args args) {
    extern __shared__ __attribute__((aligned(16))) unsigned char lds_raw[];
    Frame F;
    F.lds = (LAS unsigned char*)lds_raw;
    F.tid = threadIdx.x; F.lane = F.tid & 63; F.wave = __builtin_amdgcn_readfirstlane(F.tid >> 6);
    F.bid = blockIdx.x; F.G = gridDim.x; F.ws = args.ws; F.out = args.out;
    volatile LAS unsigned* MISC = (volatile LAS unsigned*)(F.lds + MISC_OFF);
    for (int u = F.tid; u < (LDS_BYTES - LDSCTL_OFF) / 4; u += NTHR) ((LAS unsigned*)(F.lds + LDSCTL_OFF))[u] = 0u;
    __syncthreads();
    if (F.tid == 0) {
#pragma unroll
        for (int i = 0; i < 29; ++i) ((unsigned long long LAS*)(F.lds + PTR_OFF))[i] = (unsigned long long)args.in[i];
    }
    __syncthreads();
    const int lo = args.ph_lo, hi = args.ph_hi;
    XcdBarrier bar; bar.bar = (unsigned*)(F.ws + WS_CTL) + CW_BAR; bar.x = 0; bar.st = nullptr;
    if (hi - lo > 1) bar = xcd_barrier_post((unsigned*)(F.ws + WS_CTL) + CW_BAR, MISC + 8);
#if PROBE_MASK
    if (blockIdx.x == 0 && threadIdx.x == 0) ((unsigned long long*)(F.ws + WS_CTL + 32768))[0] = __builtin_amdgcn_s_memrealtime();
#endif
    if (PH_IN(0)) phase_pro_a(F);
#if ONE_LAUNCH
    if (PH_IN(0) && PH_IN(1)) cg::this_grid().sync();
    PH_STAMP(0);
#else
    PH_SEAM(0);
#endif
    if (PH_IN(1)) norm_phase(F, 0, nullptr, nullptr, 0, 0, INP(I_NMPRE), 0, 0, 1, 0);
    PH_SEAM(1);
    layer_phases<0>(F, lo, hi, bar);
    layer_phases<1>(F, lo, hi, bar);
    layer_phases<2>(F, lo, hi, bar);
    layer_phases<3>(F, lo, hi, bar);
#if PROBE_SUB >= 0
    if (blockIdx.x == 0 && threadIdx.x == 0) {
        const unsigned long long tot = ((volatile LAS unsigned*)(F.lds + 131072 + 2048))[PROBE_SUB];
        const unsigned long long t0 = __builtin_amdgcn_s_memrealtime();
        while (__builtin_amdgcn_s_memrealtime() - t0 < tot * PROBE_AMP) __builtin_amdgcn_s_sleep(8);
    }
#endif
#if PROBE_MASK
    if (blockIdx.x == 0 && threadIdx.x == 0) {
        asm volatile("s_waitcnt vmcnt(0)" ::: "memory");
        volatile unsigned long long* ts = (volatile unsigned long long*)(F.ws + WS_CTL + 32768);
        unsigned long long tot = 0;
        for (int k = 0; k < NPHASE; ++k) {
            const int bit = k == 0 ? 12 : k == 1 ? 13 : (k - 2) % NPL;
            if ((PROBE_MASK >> bit) & 1) tot += ts[k + 1] - ts[k];
        }
        const unsigned long long t0 = __builtin_amdgcn_s_memrealtime();
        while (__builtin_amdgcn_s_memrealtime() - t0 < tot * PROBE_AMP) __builtin_amdgcn_s_sleep(8);
    }
#endif
}

extern "C" void kernel_launch(void* const* d_in, const int* in_sizes, int n_in, void* d_out, int out_size, void* d_ws, size_t ws_size, hipStream_t stream) {
    static int grid = 0;
    if (grid == 0) {
        if (n_in != 29 || ws_size < WS_END) { fprintf(stderr, "kernel_launch: unexpected n_in %d or ws %zu < %zu\n", n_in, ws_size, (size_t)WS_END); grid = -1; return; }
        int dev = 0, cus = 0, per_cu = 0;
        hipGetDevice(&dev); hipDeviceGetAttribute(&cus, hipDeviceAttributeMultiprocessorCount, dev);
        hipFuncSetAttribute((const void*)mk_fwd, hipFuncAttributeMaxDynamicSharedMemorySize, LDS_BYTES);
        hipOccupancyMaxActiveBlocksPerMultiprocessor(&per_cu, (const void*)mk_fwd, NTHR, LDS_BYTES);
        if (per_cu < 1) { fprintf(stderr, "kernel_launch: occupancy query says %d blocks per CU\n", per_cu); grid = -1; return; }
        grid = cus;
        if (grid != 256) { fprintf(stderr, "kernel_launch: built for a 256-CU device (the phase program's work maps assume 256 workgroups), found %d CUs\n", cus); grid = -1; return; }
    }
    if (grid < 0) return;
    hipMemsetAsync((char*)d_ws + WS_CTL, 0, CTL_ZERO_BYTES, stream);
    Args a{};
    for (int i = 0; i < 29; ++i) a.in[i] = (const float*)d_in[i];
    a.out = (float*)d_out; a.ws = (unsigned char*)d_ws;
    { a.ph_lo = 0; a.ph_hi = NPHASE; void* kargs[] = {&a};
      hipLaunchCooperativeKernel((const void*)mk_fwd, dim3(grid), dim3(NTHR), kargs, LDS_BYTES, stream); }
}
```
